# Optimizing an MI355X kernel written in HIP

```python
import math
import jax
import jax.numpy as jnp
from jax import lax
import numpy as np

D_MODEL = 2048
BATCH = 4
SEQ = 4096
DEPTH = 1

HEAD_DIM = 128
N_FOX_HEADS = 8
N_MOBA_HEADS = 8
FOX_WIDTH = N_FOX_HEADS * HEAD_DIM
MOBA_WIDTH = N_MOBA_HEADS * HEAD_DIM
MIX_WIDTH = FOX_WIDTH + MOBA_WIDTH
FOX_Q_BLOCK = 128
MOBA_BLOCK = 256
MOBA_TOPK = 3
MOBA_Q_CHUNK = 32
REL_BUCKETS = 32
REL_MAX_DIST = 128
N_GROUPS = 4
EXPERTS_PER_GROUP = 4
N_EXPERTS = N_GROUPS * EXPERTS_PER_GROUP
EXPERT_TOPK = 2
D_EXPERT = 512
EPS = 1e-6
NEG = -1e30

kernel_name = 'hymba_fox_moba_hmoe_layer'


def rmsnorm(x, g):
    xf = x.astype(jnp.float32)
    y = xf * lax.rsqrt(jnp.mean(xf * xf, axis=-1, keepdims=True) + EPS)
    return (y * g.astype(jnp.float32)).astype(x.dtype)


def rel_bucket(dist):
    max_exact = REL_BUCKETS // 2
    d = jnp.maximum(dist, 0)
    log_ratio = jnp.log(jnp.maximum(d, 1).astype(jnp.float32) / max_exact) / math.log(REL_MAX_DIST / max_exact)
    large = max_exact + (log_ratio * (REL_BUCKETS - max_exact)).astype(jnp.int32)
    large = jnp.minimum(large, REL_BUCKETS - 1)
    return jnp.where(d < max_exact, d, large)


def fox_attention(q, k, v, log_f):
    B, H, S, dh = q.shape
    c = jnp.cumsum(log_f, axis=-1)
    key_pos = jnp.arange(S)
    scale = dh ** -0.5

    def block(qb):
        start = qb * FOX_Q_BLOCK
        q_blk = lax.dynamic_slice_in_dim(q, start, FOX_Q_BLOCK, axis=2)
        c_blk = lax.dynamic_slice_in_dim(c, start, FOX_Q_BLOCK, axis=2)
        q_pos = start + jnp.arange(FOX_Q_BLOCK)
        s = jnp.einsum('bhqd,bhkd->bhqk', q_blk, k).astype(jnp.float32) * scale
        s = s + (c_blk[..., :, None] - c[..., None, :])
        s = jnp.where(key_pos[None, :] <= q_pos[:, None], s, NEG)
        p = jax.nn.softmax(s, axis=-1)
        return jnp.einsum('bhqk,bhkd->bhqd', p.astype(v.dtype), v)

    out = lax.map(block, jnp.arange(S // FOX_Q_BLOCK))
    return jnp.moveaxis(out, 0, 2).reshape(B, H, S, dh)


def moba_attention(q, k, v, rel_table):
    B, H, S, dh = q.shape
    nb = -(-S // MOBA_BLOCK)
    pad = nb * MOBA_BLOCK - S
    k_blocks = jnp.pad(k, ((0, 0), (0, 0), (0, pad), (0, 0))).reshape(B, H, nb, MOBA_BLOCK, dh)
    v_blocks = jnp.pad(v, ((0, 0), (0, 0), (0, pad), (0, 0))).reshape(B, H, nb, MOBA_BLOCK, dh)
    k_mean = jnp.mean(k_blocks, axis=3)
    n_sel = min(MOBA_TOPK, nb)
    scale = dh ** -0.5
    blk_off = jnp.arange(MOBA_BLOCK)
    b_ix = jnp.arange(B)[:, None, None, None]
    h_ix = jnp.arange(H)[None, :, None, None]

    def chunk(ci):
        start = ci * MOBA_Q_CHUNK
        own = start // MOBA_BLOCK
        q_c = lax.dynamic_slice_in_dim(q, start, MOBA_Q_CHUNK, axis=2)
        q_pos = start + jnp.arange(MOBA_Q_CHUNK)
        gate = jnp.einsum('bhqd,bhnd->bhqn', q_c, k_mean).astype(jnp.float32)
        gate = jnp.where(jnp.arange(nb) < own, gate, NEG)
        _, idx = lax.top_k(gate, n_sel)
        valid = idx < own
        k_sel = k_blocks[b_ix, h_ix, idx]
        v_sel = v_blocks[b_ix, h_ix, idx]
        k_own = lax.dynamic_index_in_dim(k_blocks, own, axis=2, keepdims=False)
        v_own = lax.dynamic_index_in_dim(v_blocks, own, axis=2, keepdims=False)
        pos_sel = idx[..., None] * MOBA_BLOCK + blk_off
        pos_own = own * MOBA_BLOCK + blk_off
        s_sel = jnp.einsum('bhqd,bhqkld->bhqkl', q_c, k_sel).astype(jnp.float32) * scale
        s_sel = s_sel + rel_table[h_ix[..., None], rel_bucket(q_pos[:, None, None] - pos_sel)].astype(jnp.float32)
        s_sel = jnp.where(valid[..., None], s_sel, NEG)
        s_own = jnp.einsum('bhqd,bhld->bhql', q_c, k_own).astype(jnp.float32) * scale
        s_own = s_own + rel_table[:, rel_bucket(q_pos[:, None] - pos_own[None, :])][None].astype(jnp.float32)
        s_own = jnp.where(pos_own[None, :] <= q_pos[:, None], s_own, NEG)
        s_all = jnp.concatenate([s_sel.reshape(B, H, MOBA_Q_CHUNK, n_sel * MOBA_BLOCK), s_own], axis=-1)
        p = jax.nn.softmax(s_all, axis=-1).astype(v.dtype)
        p_sel = p[..., :n_sel * MOBA_BLOCK].reshape(B, H, MOBA_Q_CHUNK, n_sel, MOBA_BLOCK)
        p_own = p[..., n_sel * MOBA_BLOCK:]
        return (jnp.einsum('bhqkl,bhqkld->bhqd', p_sel, v_sel)
                + jnp.einsum('bhql,bhld->bhqd', p_own, v_own))

    out = lax.map(chunk, jnp.arange(S // MOBA_Q_CHUNK))
    return jnp.moveaxis(out, 0, 2).reshape(B, H, S, dh)


def hier_moe(h, w_group_router, b_group_router, w_expert_router, b_expert_router, w_gate, w_up, w_down):
    B, S, D = h.shape
    t = h.reshape(B * S, D)
    g_logits = (t @ w_group_router).astype(jnp.float32) + b_group_router.astype(jnp.float32)
    p_group = jax.nn.softmax(g_logits, axis=-1)
    group = jnp.argmax(g_logits, axis=-1)
    p_top_group = jnp.take_along_axis(p_group, group[:, None], axis=-1)
    e_logits = jnp.einsum('td,dge->tge', t, w_expert_router).astype(jnp.float32) + b_expert_router.astype(jnp.float32)
    e_logits = jnp.take_along_axis(e_logits, group[:, None, None], axis=1)[:, 0]
    p_exp = jax.nn.softmax(e_logits, axis=-1)
    top_p, top_i = lax.top_k(p_exp, EXPERT_TOPK)
    top_p = top_p / jnp.sum(top_p, axis=-1, keepdims=True)
    within = jnp.sum(jax.nn.one_hot(top_i, EXPERTS_PER_GROUP, dtype=jnp.float32) * top_p[..., None], axis=1)
    combine = jax.nn.one_hot(group, N_GROUPS, dtype=jnp.float32)[:, :, None] * within[:, None, :] * p_top_group[:, :, None]
    combine = combine.reshape(-1, N_EXPERTS).astype(h.dtype)
    hid = jax.nn.silu(jnp.einsum('td,edf->tef', t, w_gate)) * jnp.einsum('td,edf->tef', t, w_up)
    y = jnp.einsum('tef,efd->td', hid * combine[:, :, None], w_down)
    return y.reshape(B, S, D)


def setup_inputs(seed: int = 0) -> dict:
    key = jax.random.key(seed)
    ks = jax.random.split(key, 20)
    f32 = jnp.float32
    L = DEPTH
    nrm = jax.random.normal
    x = nrm(ks[0], (BATCH, SEQ, D_MODEL), f32)
    attn_norm_g = 1.0 + 0.02 * nrm(ks[1], (L, D_MODEL), f32)
    w_qkv = nrm(ks[2], (L, D_MODEL, 3 * MIX_WIDTH), f32) * D_MODEL ** -0.5
    w_fg = nrm(ks[3], (L, D_MODEL, N_FOX_HEADS), f32) * (0.1 * D_MODEL ** -0.5)
    w_in = jnp.concatenate([w_qkv, w_fg], axis=-1)
    b_forget = 4.0 + 0.5 * nrm(ks[4], (L, N_FOX_HEADS), f32)
    fox_out_norm_g = 1.0 + 0.02 * nrm(ks[5], (L, FOX_WIDTH), f32)
    moba_out_norm_g = 1.0 + 0.02 * nrm(ks[6], (L, MOBA_WIDTH), f32)
    rel_bias = 0.5 * nrm(ks[7], (N_MOBA_HEADS, REL_BUCKETS), f32)
    w_out = nrm(ks[8], (L, MIX_WIDTH, D_MODEL), f32) * MIX_WIDTH ** -0.5
    ffn_norm_g = 1.0 + 0.02 * nrm(ks[9], (L, D_MODEL), f32)
    w_group_router = nrm(ks[10], (L, D_MODEL, N_GROUPS), f32) * D_MODEL ** -0.5
    b_group_router = 0.01 * nrm(ks[11], (L, N_GROUPS), f32)
    w_expert_router = nrm(ks[12], (L, D_MODEL, N_GROUPS, EXPERTS_PER_GROUP), f32) * D_MODEL ** -0.5
    b_expert_router = 0.01 * nrm(ks[13], (L, N_GROUPS, EXPERTS_PER_GROUP), f32)
    w_gate = nrm(ks[14], (L, N_EXPERTS, D_MODEL, D_EXPERT), f32) * D_MODEL ** -0.5
    w_up = nrm(ks[15], (L, N_EXPERTS, D_MODEL, D_EXPERT), f32) * D_MODEL ** -0.5
    w_down = nrm(ks[16], (L, N_EXPERTS, D_EXPERT, D_MODEL), f32) * D_EXPERT ** -0.5
    final_norm_g = 1.0 + 0.02 * nrm(ks[17], (D_MODEL,), f32)
    return {'x': x, 'attn_norm_g': attn_norm_g, 'w_in': w_in, 'b_forget': b_forget,
            'fox_out_norm_g': fox_out_norm_g, 'moba_out_norm_g': moba_out_norm_g, 'rel_bias': rel_bias,
            'w_out': w_out, 'ffn_norm_g': ffn_norm_g, 'w_group_router': w_group_router,
            'b_group_router': b_group_router, 'w_expert_router': w_expert_router,
            'b_expert_router': b_expert_router, 'w_gate': w_gate, 'w_up': w_up, 'w_down': w_down,
            'final_norm_g': final_norm_g}


def reference(x, attn_norm_g, w_in, b_forget, fox_out_norm_g, moba_out_norm_g, rel_bias, w_out, ffn_norm_g,
              w_group_router, b_group_router, w_expert_router, b_expert_router, w_gate, w_up, w_down,
              final_norm_g):
    B, S, _ = x.shape

    def to_heads(t, n):
        return t.reshape(B, S, n, HEAD_DIM).transpose(0, 2, 1, 3)

    def from_heads(t):
        return t.transpose(0, 2, 1, 3).reshape(B, S, -1)

    for l in range(DEPTH):
        h = rmsnorm(x, attn_norm_g[l])
        proj = h @ w_in[l]
        fox_qkv = proj[..., :3 * FOX_WIDTH]
        moba_qkv = proj[..., 3 * FOX_WIDTH:3 * MIX_WIDTH]
        f_logit = proj[..., 3 * MIX_WIDTH:]
        fq, fk, fv = [to_heads(t, N_FOX_HEADS) for t in jnp.split(fox_qkv, 3, axis=-1)]
        mq, mk, mv = [to_heads(t, N_MOBA_HEADS) for t in jnp.split(moba_qkv, 3, axis=-1)]
        log_f = jax.nn.log_sigmoid(f_logit.astype(jnp.float32) + b_forget[l].astype(jnp.float32)).transpose(0, 2, 1)
        fo = rmsnorm(from_heads(fox_attention(fq, fk, fv, log_f)), fox_out_norm_g[l])
        mo = rmsnorm(from_heads(moba_attention(mq, mk, mv, rel_bias)), moba_out_norm_g[l])
        x = x + jnp.concatenate([fo, mo], axis=-1) @ w_out[l]
        x = x + hier_moe(rmsnorm(x, ffn_norm_g[l]), w_group_router[l], b_group_router[l], w_expert_router[l],
                         b_expert_router[l], w_gate[l], w_up[l], w_down[l])
    return rmsnorm(x, final_norm_g)
```

```cpp
#include <hip/hip_runtime.h>
#include <cstdio>
#include <cstdint>

#define GAS __attribute__((address_space(1)))
#define LAS __attribute__((address_space(3)))
typedef unsigned short bf16;
typedef short bf16x8 __attribute__((ext_vector_type(8)));
typedef float f32x4 __attribute__((ext_vector_type(4)));
typedef float f32x2 __attribute__((ext_vector_type(2)));
typedef unsigned u32x4 __attribute__((ext_vector_type(4)));
typedef unsigned u32x2 __attribute__((ext_vector_type(2)));

constexpr int BATCH = 4, SEQ = 4096, DM = 2048, T = BATCH * SEQ, NH = 8, HD = 128, GWID = 1024, NQKV = 6144, WIN_LD = 6152;
constexpr int NE = 16, DE = 512, ECAP = 16384, MAXTILES = 144, NRC = 32  ;
constexpr float EPS = 1e-6f;
constexpr int NWAVES = 8, NTHR = 512;

constexpr size_t MiB = 1u << 20, KiB = 1u << 10;
constexpr size_t WS_CTL = 0, CTL_ZERO_BYTES = 1 * MiB;
constexpr size_t WS_WQKV = 2 * MiB;
constexpr size_t WS_WO = 26 * MiB;
constexpr size_t WS_WGU = 34 * MiB;
constexpr size_t WS_WD = 98 * MiB;
constexpr size_t WS_WR = 130 * MiB;
constexpr size_t WS_LF = 130 * MiB + 256 * KiB;
constexpr size_t WS_C = 131 * MiB;
constexpr size_t WS_KMEAN = 131 * MiB + 512 * KiB;
constexpr size_t WS_TOKREC = 132 * MiB;
constexpr size_t WS_LIST = 133 * MiB;
constexpr size_t WS_RSR = 134 * MiB;
constexpr size_t WS_RSW = 135 * MiB;
constexpr size_t WS_A = 138 * MiB;
constexpr size_t WS_QKV = 202 * MiB;
constexpr size_t WS_XB = 202 * MiB;
constexpr size_t WS_Y = 266 * MiB;
constexpr size_t WS_END = 410 * MiB;
constexpr int CW_TMO = 0, CW_GCNT = 64, CW_BAR = 4096;

constexpr int LCTL_OFF = 0;
constexpr int RING_OFF = 1024, RING_BYTES = 131072;
constexpr int XTRA_OFF = RING_OFF + RING_BYTES;
constexpr int LDS_BYTES = 155648;

#define LDS_WAIT() asm volatile("s_waitcnt lgkmcnt(0)" ::: "memory")
#define VM_WAIT() asm volatile("s_waitcnt vmcnt(0)" ::: "memory")
__device__ __forceinline__ unsigned cvt_pk_bf16(float lo, float hi) { unsigned r; asm volatile("v_cvt_pk_bf16_f32 %0, %1, %2" : "=v"(r) : "v"(lo), "v"(hi)); return r; }
__device__ __forceinline__ float bf2f(unsigned short b) { return __uint_as_float((unsigned)b << 16); }
__device__ __forceinline__ float bflo(unsigned w) { return __uint_as_float(w << 16); }
__device__ __forceinline__ float bfhi(unsigned w) { return __uint_as_float(w & 0xffff0000u); }
__device__ __forceinline__ float wave_sum(float v) {
#pragma unroll
    for (int o = 1; o < 64; o <<= 1) v += __shfl_xor(v, o);
    return v;
}

namespace pg8 {
typedef unsigned short bf16_t;
constexpr int BM = 256, BK = 64, HALF = 128, HTB = HALF * BK * 2, STAGE_BYTES = 8 * HTB, NXCD = 8, WGM = 8;
__host__ __device__ __forceinline__ int lds_byte(int r, int c) { const int st = (r >> 4) * 2 + (c >> 5), rr = r & 15, cc = c & 31, ob = rr * 64 + cc * 2; return st * 1024 + (ob ^ (((ob >> 9) & 1) << 5)); }
__host__ __device__ __forceinline__ void stage_rc(int b, int& R, int& C) { const int st = b / 1024, sb = b % 1024, swz = sb ^ (((sb >> 9) & 1) << 5); R = (st >> 1) * 16 + swz / 64; C = (st & 1) * 32 + (swz % 64) / 2; }
__host__ __device__ __forceinline__ int perm32(int rho) { const int n = rho >> 4, i = rho & 15; return 8 * (i >> 2) + 4 * n + (i & 3); }

struct Unit { int pm, pn; };
struct Gemm { const bf16_t* A; const bf16_t* Bt; int M, N, K; };

struct StaticOrder {
    int nM, nN, nwg, G, c;
    __host__ __device__ void init(int M, int N, int G_, int c_) { nM = M / BM; nN = N / BM; nwg = nM * nN; G = G_; c = c_; }
    __host__ __device__ bool next(int i, Unit& u) const {
        const long L = (long)i * G + c; if (L >= nwg) return false;
        int wgid = (int)L; { const int q = nwg / NXCD, r = nwg % NXCD, xcd = wgid % NXCD, off = wgid / NXCD; wgid = (xcd < r ? xcd * (q + 1) : r * (q + 1) + (xcd - r) * q) + off; }
        const int nig = WGM * nN, gid = wgid / nig, fm = gid * WGM, gsz = (nM - fm) < WGM ? (nM - fm) : WGM;
        u.pm = fm + ((wgid % nig) % gsz); u.pn = (wgid % nig) / gsz; return true;
    }
    __device__ __forceinline__ int arow(const Unit&, int) const { return 0; }
};

template <class Epi, class Sched, bool ALIGN_EPI, bool GATHER>
__device__ __forceinline__ void gemm_phase(LAS unsigned char* lds, const Gemm g, const Sched& S, const Epi& E) {
    const int tid = threadIdx.x, wid = __builtin_amdgcn_readfirstlane(tid >> 6), lane = tid & 63, wr = wid >> 2, wc = wid & 3, fr = lane & 15, fq = lane >> 4;
    const int K = g.K, nt = K / BK;
    unsigned voffA[2], voffB[2]; int RA[2]; unsigned CA2[2];
#pragma unroll
    for (int i = 0; i < 2; ++i) { int R, C; stage_rc(tid * 16 + i * 8192, R, C); const int Rb = Epi::PERM ? ((R & ~31) + perm32(R & 31)) : R;
        voffA[i] = (unsigned)(R * K + C) * 2u; voffB[i] = (unsigned)(Rb * K + C) * 2u; RA[i] = R; CA2[i] = (unsigned)C * 2u; }
    const size_t kstep = (size_t)(BK * 2);
    const size_t hstep = (size_t)HALF * K * 2;
    const size_t tstep = 2 * hstep;
    const unsigned ldsw = (unsigned)wid * 1024u;
    const int aoff = lds_byte(wr * 64 + fr, fq * 8), boff = lds_byte(wc * 32 + fr, fq * 8);
#define PG8_SA(b, h) (((b) * 2 + (h)) * HTB)
#define PG8_SB(b, h) ((4 + (b) * 2 + (h)) * HTB)
#define PG8_STAGE(bufoff, gbase, voff) do { _Pragma("unroll") for (int _i = 0; _i < 2; ++_i) \
        __builtin_amdgcn_global_load_lds((const unsigned*)((const char*)(gbase) + (voff)[_i]), (LAS unsigned*)(lds + (bufoff) + ldsw + _i * 8192), 16, 0, 0); } while (0)
#define PG8_STAGE_A(bufoff, gbase, h, VV) do { if constexpr (GATHER) { PG8_STAGE(bufoff, gbase, (VV)[h]); } else { PG8_STAGE(bufoff, (gbase) + (h) * hstep, voffA); } } while (0)
#define PG8_LDA(dst, b, h) do { _Pragma("unroll") for (int m = 0; m < 4; ++m) _Pragma("unroll") for (int k = 0; k < 2; ++k) dst[m][k] = *(const LAS bf16x8*)(lds + PG8_SA(b, h) + aoff + m * 2048 + k * 1024); } while (0)
#define PG8_LDB(dst, b, h) do { _Pragma("unroll") for (int n = 0; n < 2; ++n) _Pragma("unroll") for (int k = 0; k < 2; ++k) dst[n][k] = *(const LAS bf16x8*)(lds + PG8_SB(b, h) + boff + n * 2048 + k * 1024); } while (0)
#define PG8_MMA(ai, bj, At, Bt) do { __builtin_amdgcn_s_setprio(1); _Pragma("unroll") for (int m = 0; m < 4; ++m) _Pragma("unroll") for (int n = 0; n < 2; ++n) _Pragma("unroll") for (int k = 0; k < 2; ++k) \
        acc[ai][bj][m][n] = __builtin_amdgcn_mfma_f32_16x16x32_bf16(Bt[n][k], At[m][k], acc[ai][bj][m][n], 0, 0, 0); __builtin_amdgcn_s_setprio(0); } while (0)
#define PG8_WAIT_V(n) asm volatile("s_waitcnt vmcnt(" #n ")" ::: "memory")
#define PG8_WAIT_L(n) asm volatile("s_waitcnt lgkmcnt(" #n ")" ::: "memory")
#define PG8_BAR __builtin_amdgcn_s_barrier()
#define PG8_SCHED __builtin_amdgcn_sched_barrier(0)
    Unit cur, nxt; int ui = 0;
    if (!S.next(0, cur)) return;
    f32x4 acc[2][2][4][2];
#pragma unroll
    for (int a = 0; a < 2; ++a)
#pragma unroll
        for (int b = 0; b < 2; ++b)
#pragma unroll
            for (int m = 0; m < 4; ++m)
#pragma unroll
                for (int n = 0; n < 2; ++n) acc[a][b][m][n] = (f32x4){0.f, 0.f, 0.f, 0.f};
    bf16x8 At[4][2], B0[2][2], B1[2][2];
    unsigned cv[2][2], nv[2][2];
    if constexpr (GATHER) {
#pragma unroll
        for (int h = 0; h < 2; ++h)
#pragma unroll
            for (int i = 0; i < 2; ++i) { cv[h][i] = (unsigned)S.arow(cur, h * HALF + RA[i]) * (unsigned)(K * 2) + CA2[i]; nv[h][i] = cv[h][i]; }
    } else {
#pragma unroll
        for (int h = 0; h < 2; ++h)
#pragma unroll
            for (int i = 0; i < 2; ++i) { cv[h][i] = 0u; nv[h][i] = 0u; }
    }
    const char* cA = GATHER ? (const char*)g.A : (const char*)g.A + (size_t)cur.pm * tstep; const char* cB = (const char*)g.Bt + (size_t)cur.pn * tstep;
    PG8_STAGE(PG8_SB(0, 0), cB, voffB); PG8_STAGE(PG8_SB(0, 1), cB + hstep, voffB); PG8_STAGE_A(PG8_SA(0, 0), cA, 0, cv); PG8_STAGE_A(PG8_SA(0, 1), cA, 1, cv);
    if (wr == 1) PG8_BAR;
    PG8_WAIT_V(2); PG8_BAR;
    PG8_STAGE(PG8_SB(1, 0), cB + kstep, voffB); PG8_STAGE_A(PG8_SA(1, 0), cA + kstep, 0, cv); PG8_STAGE(PG8_SB(1, 1), cB + hstep + kstep, voffB);
    PG8_WAIT_V(6); PG8_BAR;
    for (;;) {
        const bool has_next = S.next(ui + 1, nxt);
        const char* nA = GATHER ? (const char*)g.A : (has_next ? (const char*)g.A + (size_t)nxt.pm * tstep : cA); const char* nB = has_next ? (const char*)g.Bt + (size_t)nxt.pn * tstep : cB;
        if constexpr (GATHER) {
            if (has_next) {
#pragma unroll
                for (int h = 0; h < 2; ++h)
#pragma unroll
                    for (int i = 0; i < 2; ++i) nv[h][i] = (unsigned)S.arow(nxt, h * HALF + RA[i]) * (unsigned)(K * 2) + CA2[i];
            }
        }
        for (int t = 0; t < nt; t += 2) {
            const bool last = (t == nt - 2);
            const char* a1 = cA + (size_t)(t + 1) * kstep;
            const char* a2 = last ? nA : cA + (size_t)(t + 2) * kstep; const char* b2 = last ? nB : cB + (size_t)(t + 2) * kstep;
            const char* a3 = a2 + kstep; const char* b3 = b2 + kstep;
            unsigned v2[2][2];
#pragma unroll
            for (int h = 0; h < 2; ++h)
#pragma unroll
                for (int i = 0; i < 2; ++i) v2[h][i] = last ? nv[h][i] : cv[h][i];
            PG8_LDB(B0, 0, 0); PG8_LDB(B1, 0, 1); PG8_SCHED; PG8_LDA(At, 0, 0); PG8_STAGE_A(PG8_SA(1, 1), a1, 1, cv);
            PG8_WAIT_V(8); PG8_WAIT_L(0); PG8_BAR; PG8_MMA(0, 0, At, B0); PG8_MMA(0, 1, At, B1); PG8_BAR; PG8_SCHED;
            PG8_LDA(At, 0, 1); PG8_STAGE(PG8_SB(0, 0), b2, voffB); PG8_STAGE(PG8_SB(0, 1), b2 + hstep, voffB); PG8_STAGE_A(PG8_SA(0, 0), a2, 0, v2);
            PG8_WAIT_V(8); PG8_WAIT_L(0); PG8_BAR; PG8_MMA(1, 0, At, B0); PG8_MMA(1, 1, At, B1); PG8_BAR; PG8_SCHED;
            PG8_LDB(B0, 1, 0); PG8_LDB(B1, 1, 1); PG8_SCHED; PG8_LDA(At, 1, 0); PG8_STAGE_A(PG8_SA(0, 1), a2, 1, v2);
            PG8_WAIT_V(8); PG8_WAIT_L(0); PG8_BAR; PG8_MMA(0, 0, At, B0); PG8_MMA(0, 1, At, B1); PG8_BAR; PG8_SCHED;
            PG8_LDA(At, 1, 1); PG8_STAGE(PG8_SB(1, 0), b3, voffB); PG8_STAGE(PG8_SB(1, 1), b3 + hstep, voffB); PG8_STAGE_A(PG8_SA(1, 0), a3, 0, v2);
            PG8_WAIT_V(8); PG8_WAIT_L(0); PG8_BAR; PG8_MMA(1, 0, At, B0); PG8_MMA(1, 1, At, B1); PG8_BAR; PG8_SCHED;
        }
        if constexpr (ALIGN_EPI) { if (wr == 0) PG8_BAR; }
        E(acc, cur, wr, wc, fr, fq);
        if (!has_next) break;
#pragma unroll
        for (int a = 0; a < 2; ++a)
#pragma unroll
            for (int b = 0; b < 2; ++b)
#pragma unroll
                for (int m = 0; m < 4; ++m)
#pragma unroll
                    for (int n = 0; n < 2; ++n) acc[a][b][m][n] = (f32x4){0.f, 0.f, 0.f, 0.f};
        cur = nxt; cA = nA; cB = nB; ++ui;
#pragma unroll
        for (int h = 0; h < 2; ++h)
#pragma unroll
            for (int i = 0; i < 2; ++i) cv[h][i] = nv[h][i];
        if constexpr (ALIGN_EPI) { if (wr == 1) PG8_BAR; }
    }
    PG8_WAIT_V(0);
    if constexpr (!ALIGN_EPI) { if (wr == 0) PG8_BAR; }
    PG8_BAR;
#undef PG8_SA
#undef PG8_SB
#undef PG8_STAGE
#undef PG8_STAGE_A
#undef PG8_LDA
#undef PG8_LDB
#undef PG8_MMA
#undef PG8_WAIT_V
#undef PG8_WAIT_L
#undef PG8_BAR
#undef PG8_SCHED
}
}

#define XB_TMO      128
#define XB_XCNT(j)  (256  + 64 * (j))
#define XB_XSUB(j)  (1280 + 64 * (j))
#define XB_XGEN(j)  (2304 + 64 * (j))
#define XB_TOP      3328
#define XB_TOPGEN   3392
#define XCD_BAR_WORDS 3456
#define XB_SPIN_CAP (1u << 18)
__device__ __forceinline__ unsigned xb_ld(unsigned* p)              { return __hip_atomic_load(p, __ATOMIC_RELAXED, __HIP_MEMORY_SCOPE_AGENT); }
__device__ __forceinline__ unsigned xb_add(unsigned* p, unsigned v) { return __hip_atomic_fetch_add(p, v, __ATOMIC_RELAXED, __HIP_MEMORY_SCOPE_AGENT); }
__device__ __forceinline__ unsigned xb_xcc_id() { return (unsigned)__builtin_amdgcn_s_getreg((3 << 11) | 20) & 0xFu; }
#define XB_SPIN(cond, bar) do { unsigned _sp = 0; while (cond) { __builtin_amdgcn_s_sleep(1); \
    if ((++_sp & 255u) == 0u) { if (xb_ld(&(bar)[XB_TMO])) break; if (_sp > XB_SPIN_CAP) { atomicAdd(&(bar)[XB_TMO], 1u); break; } } } } while (0)
struct XcdBarrier { unsigned* bar; unsigned x; volatile LAS unsigned* st; };
__device__ __forceinline__ XcdBarrier xcd_barrier_post(unsigned* bar, volatile LAS unsigned* st) {
    XcdBarrier b; b.bar = bar; b.x = xb_xcc_id(); b.st = st;
    if (threadIdx.x == 0) (void)xb_add(&bar[XB_XCNT(b.x)], 1u);
    return b;
}
__device__ __forceinline__ void xcd_barrier_complete(unsigned* bar, unsigned x, unsigned& nloc, unsigned& nx) {
    const unsigned G = gridDim.x * gridDim.y * gridDim.z;
    unsigned sum, cnt, mine, sp = 0u;
    for (;;) {
        sum = 0u; cnt = 0u; mine = 0u;
#pragma unroll
        for (unsigned j = 0; j < 16; ++j) { const unsigned c = xb_ld(&bar[XB_XCNT(j)]); sum += c; cnt += (c > 0u) ? 1u : 0u; mine = (j == x) ? c : mine; }
        if (sum == G) break;
        __builtin_amdgcn_s_sleep(1);
        if ((++sp & 255u) == 0u) { if (xb_ld(&bar[XB_TMO])) break; if (sp > XB_SPIN_CAP) { atomicAdd(&bar[XB_TMO], 1u); break; } }
    }
    nloc = mine > 0u ? mine : 1u; nx = cnt > 0u ? cnt : 1u;
}
__device__ __forceinline__ void xcd_barrier(const XcdBarrier& b) {
    asm volatile("s_waitcnt vmcnt(0)" ::: "memory");
    __syncthreads();
    if (threadIdx.x == 0) {
        unsigned* bar = b.bar;
        __builtin_amdgcn_s_waitcnt(0);
        unsigned nloc = b.st[0], nx = b.st[1];
        if (nloc == 0u) { xcd_barrier_complete(bar, b.x, nloc, nx); b.st[0] = nloc; b.st[1] = nx; }
        const unsigned old = xb_add(&bar[XB_XSUB(b.x)], 1u);
        const unsigned gen = old / nloc;
        if (old + 1u == (gen + 1u) * nloc) {
            __builtin_amdgcn_fence(__ATOMIC_RELEASE, "agent");
            asm volatile("s_waitcnt vmcnt(0)" ::: "memory");
            const unsigned og = xb_add(&bar[XB_TOP], 1u);
            const unsigned tg = og / nx;
            if (og + 1u == (tg + 1u) * nx) xb_add(&bar[XB_TOPGEN], 1u);
            else XB_SPIN(xb_ld(&bar[XB_TOPGEN]) == tg, bar);
            __builtin_amdgcn_fence(__ATOMIC_ACQUIRE, "agent");
            xb_add(&bar[XB_XGEN(b.x)], 1u);
            asm volatile("s_waitcnt vmcnt(0)" ::: "memory");
        } else {
            XB_SPIN(xb_ld(&bar[XB_XGEN(b.x)]) == gen, bar);
            __builtin_amdgcn_fence(__ATOMIC_ACQUIRE, "agent");
            asm volatile("s_waitcnt vmcnt(0)" ::: "memory");
        }
    }
    __syncthreads();
}

struct Args { const float* in[17]; float* out; unsigned char* ws; int ph_lo, ph_hi; };
struct Frame {
    LAS unsigned char* lds; unsigned* ctl; unsigned char* ws;
    int tid, lane, wave, G, bx;
    const float* in[17]; float* out;
};

struct EpiQKV {
    static constexpr bool PERM = true;
    bf16* qkv;
    __device__ __forceinline__ void operator()(const f32x4 (&acc)[2][2][4][2], const pg8::Unit& u, int wr, int wc, int fr, int fq) const {
        const int which = u.pn >> 2, hp = u.pn & 3, b = (u.pm * 256) >> 12, s0 = (u.pm * 256) & 4095;
#pragma unroll
        for (int ai = 0; ai < 2; ++ai)
#pragma unroll
            for (int m = 0; m < 4; ++m) { const int s = s0 + ai * 128 + wr * 64 + m * 16 + fr;
#pragma unroll
                for (int bj = 0; bj < 2; ++bj) { const int head = hp * 2 + bj;
                    bf16* dst = qkv + ((((size_t)(which * 4 + b) * 8 + head) * 4096 + s) * 128 + wc * 32 + 8 * fq);
                    const f32x4 v0 = acc[ai][bj][m][0], v1 = acc[ai][bj][m][1];
                    u32x4 w; w.x = cvt_pk_bf16(v0[0], v0[1]); w.y = cvt_pk_bf16(v0[2], v0[3]); w.z = cvt_pk_bf16(v1[0], v1[1]); w.w = cvt_pk_bf16(v1[2], v1[3]);
                    *(u32x4*)dst = w; } }
    }
};
struct EpiRes {
    static constexpr bool PERM = false;
    const float* x; float* out; bf16* xb;
    __device__ __forceinline__ void operator()(const f32x4 (&acc)[2][2][4][2], const pg8::Unit& u, int wr, int wc, int fr, int fq) const {
        const int row0 = u.pm * 256 + wr * 64 + fr, col0 = u.pn * 256 + wc * 32 + 4 * fq;
#pragma unroll
        for (int ai = 0; ai < 2; ++ai)
#pragma unroll
            for (int m = 0; m < 4; ++m) { const size_t off = (size_t)(row0 + ai * 128 + m * 16) * DM + col0;
#pragma unroll
                for (int bj = 0; bj < 2; ++bj)
#pragma unroll
                    for (int n = 0; n < 2; ++n) { const size_t o = off + bj * 128 + n * 16; const f32x4 v = *(const f32x4*)(x + o) + acc[ai][bj][m][n];
                        *(f32x4*)(out + o) = v; u32x2 w; w.x = cvt_pk_bf16(v[0], v[1]); w.y = cvt_pk_bf16(v[2], v[3]); *(u32x2*)(xb + o) = w; } }
    }
};
struct MoeOrder {
    int G, c, ncol; const LAS int* tt;
    __device__ __forceinline__ bool next(int i, pg8::Unit& u) const {
        const int nt = __builtin_amdgcn_readfirstlane(tt[0]); const long L = (long)i * G + c; if (L >= (long)nt * ncol) return false;
        const int t = (int)(L / ncol), pnl = (int)(L % ncol); const int e = __builtin_amdgcn_readfirstlane(tt[16 + t]) & 0xff;
        u.pm = t; u.pn = e * ncol + pnl; return true;
    }
};
struct MoeGather : MoeOrder {
    const int* list;
    __device__ __forceinline__ int arow(const pg8::Unit& u, int r) const {
        const int w = __builtin_amdgcn_readfirstlane(tt[16 + u.pm]); const int e = w & 0xff, rb = w >> 8; const int cnt = __builtin_amdgcn_readfirstlane(tt[256 + e]);
        const int pos = rb * 256 + r; int tok = 0; if (pos < cnt) tok = list[e * ECAP + pos]; return tok;
    }
};
struct MoePlain : MoeOrder { __device__ __forceinline__ int arow(const pg8::Unit&, int) const { return 0; } };
struct EpiHid {
    static constexpr bool PERM = true;
    bf16* hid; const float* rsr; const float* rsw; const LAS int* tt;
    __device__ __forceinline__ void operator()(const f32x4 (&acc)[2][2][4][2], const pg8::Unit& u, int wr, int wc, int fr, int fq) const {
        const int w = __builtin_amdgcn_readfirstlane(tt[16 + u.pm]); const int e = w & 0xff, rb = w >> 8, pnl = u.pn & 3; const int cnt = __builtin_amdgcn_readfirstlane(tt[256 + e]);
#pragma unroll
        for (int ai = 0; ai < 2; ++ai)
#pragma unroll
            for (int m = 0; m < 4; ++m) { const int r = ai * 128 + wr * 64 + m * 16 + fr, pos = rb * 256 + r; float rs = 0.f, cw = 0.f;
                if (pos < cnt) { rs = rsr[e * ECAP + pos]; cw = rsw[e * ECAP + pos]; }
                float o[8];
#pragma unroll
                for (int n = 0; n < 2; ++n)
#pragma unroll
                    for (int j = 0; j < 4; ++j) { const float gv = acc[ai][0][m][n][j] * rs, uv = acc[ai][1][m][n][j] * rs; o[n * 4 + j] = gv / (1.f + __expf(-gv)) * uv * cw; }
                u32x4 pk; pk.x = cvt_pk_bf16(o[0], o[1]); pk.y = cvt_pk_bf16(o[2], o[3]); pk.z = cvt_pk_bf16(o[4], o[5]); pk.w = cvt_pk_bf16(o[6], o[7]);
                *(u32x4*)(hid + (size_t)(u.pm * 256 + r) * DE + pnl * 128 + wc * 32 + 8 * fq) = pk; }
    }
};
struct EpiY {
    static constexpr bool PERM = true;
    bf16* y;
    __device__ __forceinline__ void operator()(const f32x4 (&acc)[2][2][4][2], const pg8::Unit& u, int wr, int wc, int fr, int fq) const {
        const int pnl = u.pn & 7;
#pragma unroll
        for (int ai = 0; ai < 2; ++ai)
#pragma unroll
            for (int m = 0; m < 4; ++m) { bf16* rowp = y + (size_t)(u.pm * 256 + ai * 128 + wr * 64 + m * 16 + fr) * DM + pnl * 256 + wc * 32 + 8 * fq;
#pragma unroll
                for (int bj = 0; bj < 2; ++bj) { const f32x4 v0 = acc[ai][bj][m][0], v1 = acc[ai][bj][m][1];
                    u32x4 w; w.x = cvt_pk_bf16(v0[0], v0[1]); w.y = cvt_pk_bf16(v0[2], v0[3]); w.z = cvt_pk_bf16(v1[0], v1[1]); w.w = cvt_pk_bf16(v1[2], v1[3]);
                    *(u32x4*)(rowp + bj * 128) = w; } }
    }
};

__device__ __forceinline__ void tr_item(const float* src, int ldw, const float* gs, bf16* dst, int ldd, LAS float* scr, int lane) {
#pragma unroll 8
    for (int i = 0; i < 32; ++i) { const int kk = 2 * i + (lane >> 5); scr[kk * 33 + (lane & 31)] = src[(size_t)kk * ldw + (lane & 31)]; }
    const int c = lane & 7;
    f32x4 g0 = (f32x4){1.f, 1.f, 1.f, 1.f}, g1 = g0;
    if (gs) { g0 = *(const f32x4*)(gs + 8 * c); g1 = *(const f32x4*)(gs + 8 * c + 4); }
    LDS_WAIT(); asm volatile("" ::: "memory");
#pragma unroll
    for (int j = 0; j < 4; ++j) { const int n = (lane >> 3) + 8 * j; const LAS float* s = scr + (8 * c) * 33 + n;
        u32x4 o; o.x = cvt_pk_bf16(s[0 * 33] * g0[0], s[1 * 33] * g0[1]); o.y = cvt_pk_bf16(s[2 * 33] * g0[2], s[3 * 33] * g0[3]);
        o.z = cvt_pk_bf16(s[4 * 33] * g1[0], s[5 * 33] * g1[1]); o.w = cvt_pk_bf16(s[6 * 33] * g1[2], s[7 * 33] * g1[3]);
        *(u32x4*)(dst + (size_t)n * ldd + 8 * c) = o; }
    LDS_WAIT(); asm volatile("" ::: "memory");
}
__device__ __forceinline__ void p0_prologue(Frame& F) {
    const float* x = F.in[0]; const float* g_attn = F.in[1]; const float* w_in = F.in[2]; const float* b_forget = F.in[3];
    const float* g_fox = F.in[4]; const float* g_moba = F.in[5]; const float* w_out = F.in[7]; const float* g_ffn = F.in[8];
    const float* w_gr = F.in[9]; const float* w_er = F.in[11]; const float* w_gate = F.in[13]; const float* w_up = F.in[14]; const float* w_down = F.in[15];
    bf16* Wqkv = (bf16*)(F.ws + WS_WQKV); bf16* Wo = (bf16*)(F.ws + WS_WO); bf16* Wgu = (bf16*)(F.ws + WS_WGU); bf16* Wd = (bf16*)(F.ws + WS_WD); bf16* Wr = (bf16*)(F.ws + WS_WR);
    bf16* Hb = (bf16*)(F.ws + WS_A); float* lf = (float*)(F.ws + WS_LF);
    LAS float* scr = (LAS float*)(F.lds + RING_OFF + F.wave * 8704);
    LAS float* wfgT = (LAS float*)(F.lds + RING_OFF + 8 * 8704);
    const int gw = F.bx * NWAVES + F.wave, NGW = F.G * NWAVES;
    for (int idx = F.tid; idx < 2048 * 8; idx += NTHR) { const int k = idx >> 3, hh = idx & 7; wfgT[hh * 2048 + k] = w_in[(size_t)k * WIN_LD + NQKV + hh] * g_attn[k]; }
    constexpr int I_IN = 32 * 192, I_O = 32 * 64, I_G = 16 * 32 * 16, I_D = 16 * 8 * 64, NITEMS = I_IN + I_O + 2 * I_G + I_D;
    for (int it = gw; it < NITEMS; it += NGW) {
        int r = it;
        if (r < I_IN) { const int kb = r / 192, nb = r % 192; tr_item(w_in + (size_t)(64 * kb) * WIN_LD + 32 * nb, WIN_LD, g_attn + 64 * kb, Wqkv + (size_t)(32 * nb) * DM + 64 * kb, DM, scr, F.lane); continue; } r -= I_IN;
        if (r < I_O) { const int kb = r / 64, nb = r % 64; const int k0 = 64 * kb; const float* gs = (k0 < GWID) ? g_fox + k0 : g_moba + (k0 - GWID);
            tr_item(w_out + (size_t)k0 * DM + 32 * nb, DM, gs, Wo + (size_t)(32 * nb) * DM + k0, DM, scr, F.lane); continue; } r -= I_O;
        if (r < 2 * I_G) { const int up = r >= I_G; if (up) r -= I_G; const int e = r / 512, rr = r % 512, kb = rr / 16, nb = rr % 16; const int f0 = 32 * nb, tt = f0 >> 7, within = f0 & 127;
            const float* W = (up ? w_up : w_gate) + (size_t)e * DM * DE;
            tr_item(W + (size_t)(64 * kb) * DE + f0, DE, g_ffn + 64 * kb, Wgu + ((size_t)e * 1024 + tt * 256 + up * 128 + within) * DM + 64 * kb, DM, scr, F.lane); continue; } r -= 2 * I_G;
        { const int e = r / 512, rr = r % 512, kb = rr / 64, nb = rr % 64;
            tr_item(w_down + (size_t)e * DE * DM + (size_t)(64 * kb) * DM + 32 * nb, DM, nullptr, Wd + ((size_t)e * DM + 32 * nb) * DE + 64 * kb, DE, scr, F.lane); }
    }
    for (int idx = (F.bx * NTHR + F.tid); idx < NRC * DM; idx += F.G * NTHR) { const int n = idx >> 11, k = idx & 2047;
        float v = 0.f; if (n < 4) v = w_gr[k * 4 + n]; else if (n < 20) v = w_er[k * 16 + (n - 4)];
        Wr[idx] = (bf16)(cvt_pk_bf16(v * g_ffn[k], 0.f) & 0xffffu); }
    __syncthreads();
    for (int m = gw; m < T; m += NGW) {
        const f32x4* xr = (const f32x4*)(x + (size_t)m * DM) + F.lane;
        f32x4 v[8]; float ss = 0.f;
#pragma unroll
        for (int j = 0; j < 8; ++j) { v[j] = xr[64 * j]; ss += (v[j][0] * v[j][0] + v[j][1] * v[j][1]) + (v[j][2] * v[j][2] + v[j][3] * v[j][3]); }
        float fl[8];
#pragma unroll
        for (int hh = 0; hh < 8; ++hh) { float a = 0.f;
#pragma unroll
            for (int j = 0; j < 8; ++j) { const f32x4 w = *(const LAS f32x4*)(wfgT + hh * 2048 + 256 * j + 4 * F.lane); a += (v[j][0] * w[0] + v[j][1] * w[1]) + (v[j][2] * w[2] + v[j][3] * w[3]); }
            fl[hh] = a; }
        ss = wave_sum(ss); const float rstd = 1.0f / sqrtf(ss * (1.0f / DM) + EPS);
#pragma unroll
        for (int hh = 0; hh < 8; ++hh) fl[hh] = wave_sum(fl[hh]) * rstd;
        u32x2* o8 = (u32x2*)(Hb + (size_t)m * DM) + F.lane;
#pragma unroll
        for (int j = 0; j < 8; ++j) { u32x2 w; w.x = cvt_pk_bf16(v[j][0] * rstd, v[j][1] * rstd); w.y = cvt_pk_bf16(v[j][2] * rstd, v[j][3] * rstd); o8[64 * j] = w; }
        if (F.lane < 8) { float z = fl[0];
#pragma unroll
            for (int hh = 1; hh < 8; ++hh) z = (F.lane == hh) ? fl[hh] : z;
            z += b_forget[F.lane];
            const float ls = fminf(z, 0.f) - log1pf(expf(-fabsf(z)));
            const int b = m >> 12, s = m & 4095; lf[(size_t)(b * 8 + F.lane) * SEQ + s] = ls; }
    }
}

__device__ __forceinline__ void p2_kmean_cumsum(Frame& F) {
    const bf16* mk = (const bf16*)(F.ws + WS_QKV) + (size_t)4 * 32 * SEQ * HD;
    bf16* kmean = (bf16*)(F.ws + WS_KMEAN);
    LAS float* part = (LAS float*)(F.lds + RING_OFF);
    for (int item = F.bx; item < 512; item += F.G) {
        const bf16* base = mk + ((size_t)item * 256 + F.wave * 32) * HD + 2 * F.lane;
        float a0 = 0.f, a1 = 0.f;
#pragma unroll 8
        for (int r = 0; r < 32; ++r) { const unsigned w = *(const unsigned*)(base + (size_t)r * HD); a0 += bflo(w); a1 += bfhi(w); }
        part[F.wave * 128 + 2 * F.lane] = a0; part[F.wave * 128 + 2 * F.lane + 1] = a1;
        __syncthreads();
        if (F.tid < 128) { float s = 0.f;
#pragma unroll
            for (int w = 0; w < 8; ++w) s += part[w * 128 + F.tid];
            kmean[(size_t)item * 128 + F.tid] = (bf16)(cvt_pk_bf16(s * (1.0f / 256.0f), 0.f) & 0xffffu); }
        __syncthreads();
    }
    if (F.bx < 32 && F.wave == 0) {
        const float* src = (const float*)(F.ws + WS_LF) + (size_t)F.bx * SEQ + 64 * F.lane; float* dst = (float*)(F.ws + WS_C) + (size_t)F.bx * SEQ + 64 * F.lane;
        f32x4 v[16]; float run = 0.f;
#pragma unroll
        for (int j = 0; j < 16; ++j) { v[j] = *(const f32x4*)(src + 4 * j);
            v[j][0] += run; v[j][1] += v[j][0]; v[j][2] += v[j][1]; v[j][3] += v[j][2]; run = v[j][3]; }
        float incl = run;
#pragma unroll
        for (int o = 1; o < 64; o <<= 1) { const float t = __shfl_up(incl, o); if (F.lane >= o) incl += t; }
        const float excl = incl - run;
#pragma unroll
        for (int j = 0; j < 16; ++j) { f32x4 w = v[j]; w[0] += excl; w[1] += excl; w[2] += excl; w[3] += excl; *(f32x4*)(dst + 4 * j) = w; }
    }
}

__device__ __forceinline__ void p4_outnorm(Frame& F) {
    bf16* AO = (bf16*)(F.ws + WS_A);
    const int gw = F.bx * NWAVES + F.wave, NGW = F.G * NWAVES;
    for (int m = gw; m < T; m += NGW) {
        u32x4* rp = (u32x4*)(AO + (size_t)m * DM) + F.lane;
        u32x4 v[4]; float ss[2] = {0.f, 0.f};
#pragma unroll
        for (int j = 0; j < 4; ++j) { v[j] = rp[64 * j];
#pragma unroll
            for (int q = 0; q < 4; ++q) { const float a = bflo(v[j][q]), b = bfhi(v[j][q]); ss[j >> 1] += a * a + b * b; } }
        const float r0 = 1.0f / sqrtf(wave_sum(ss[0]) * (1.0f / GWID) + EPS), r1 = 1.0f / sqrtf(wave_sum(ss[1]) * (1.0f / GWID) + EPS);
#pragma unroll
        for (int j = 0; j < 4; ++j) { const float r = (j < 2) ? r0 : r1; u32x4 o;
#pragma unroll
            for (int q = 0; q < 4; ++q) o[q] = cvt_pk_bf16(bflo(v[j][q]) * r, bfhi(v[j][q]) * r);
            rp[64 * j] = o; }
    }
}

__device__ __forceinline__ void p6_route(Frame& F) {
    const bf16* xb = (const bf16*)(F.ws + WS_XB); const bf16* Wr = (const bf16*)(F.ws + WS_WR);
    const float* bg = F.in[10]; const float* be = F.in[12];
    int* tokrec = (int*)(F.ws + WS_TOKREC); int* list = (int*)(F.ws + WS_LIST); float* rsr = (float*)(F.ws + WS_RSR); float* rsw = (float*)(F.ws + WS_RSW);
    unsigned* gcnt = F.ctl + CW_GCNT;
    LAS float* part = (LAS float*)(F.lds + RING_OFF);
    LAS float* ssq = part + 2 * 64 * 32;
    LAS int* lcnt = (LAS int*)(ssq + 128);
    LAS int* lbase = lcnt + 16;
    const int fr = F.lane & 15, fq = F.lane >> 4, mt = F.wave & 3, kh = F.wave >> 2;
    for (int blk = F.bx; blk < T / 64; blk += F.G) {
        const int tok0 = blk * 64;
        if (F.tid < 16) lcnt[F.tid] = 0;
        const bf16* pa = xb + (size_t)(tok0 + 16 * mt + fr) * DM + 1024 * kh + 8 * fq;
        const bf16* pb0 = Wr + (size_t)fr * DM + 1024 * kh + 8 * fq; const bf16* pb1 = pb0 + (size_t)16 * DM;
        f32x4 acc0 = (f32x4){0.f, 0.f, 0.f, 0.f}, acc1 = acc0; float sq = 0.f;
#pragma unroll 4
        for (int s = 0; s < 32; ++s) { const bf16x8 a = *(const bf16x8*)(pa + 32 * s), b0 = *(const bf16x8*)(pb0 + 32 * s), b1 = *(const bf16x8*)(pb1 + 32 * s);
#pragma unroll
            for (int j = 0; j < 8; ++j) { const float f = bf2f((unsigned short)a[j]); sq += f * f; }
            acc0 = __builtin_amdgcn_mfma_f32_16x16x32_bf16(a, b0, acc0, 0, 0, 0); acc1 = __builtin_amdgcn_mfma_f32_16x16x32_bf16(a, b1, acc1, 0, 0, 0); }
        sq += __shfl_xor(sq, 16); sq += __shfl_xor(sq, 32);
#pragma unroll
        for (int i = 0; i < 4; ++i) { part[(kh * 64 + 16 * mt + 4 * fq + i) * 32 + fr] = acc0[i]; part[(kh * 64 + 16 * mt + 4 * fq + i) * 32 + 16 + fr] = acc1[i]; }
        if (fq == 0) ssq[kh * 64 + 16 * mt + fr] = sq;
        __syncthreads();
        int e1 = 0, e2 = 0, rk1 = 0, rk2 = 0; float w1 = 0.f, w2 = 0.f, rstd = 0.f;
        if (F.tid < 64) { const int t = F.tid;
            rstd = 1.0f / sqrtf((ssq[t] + ssq[64 + t]) * (1.0f / DM) + EPS);
            float gl[4]; int grp = 0;
#pragma unroll
            for (int j = 0; j < 4; ++j) gl[j] = (part[t * 32 + j] + part[(64 + t) * 32 + j]) * rstd + bg[j];
#pragma unroll
            for (int j = 1; j < 4; ++j) if (gl[j] > gl[grp]) grp = j;
            float gmax = gl[0];
#pragma unroll
            for (int j = 1; j < 4; ++j) gmax = fmaxf(gmax, gl[j]);
            float gden = 0.f;
#pragma unroll
            for (int j = 0; j < 4; ++j) gden += expf(gl[j] - gmax);
            const float pgrp = 1.0f / gden;
            float el[4];
#pragma unroll
            for (int j = 0; j < 4; ++j) el[j] = (part[t * 32 + 4 + 4 * grp + j] + part[(64 + t) * 32 + 4 + 4 * grp + j]) * rstd + be[4 * grp + j];
            int i1 = 0;
#pragma unroll
            for (int j = 1; j < 4; ++j) if (el[j] > el[i1]) i1 = j;
            int i2 = (i1 == 0) ? 1 : 0;
#pragma unroll
            for (int j = 0; j < 4; ++j) if (j != i1 && j != i2 && el[j] > el[i2]) i2 = j;
            const float p2 = expf(el[i2] - el[i1]);
            w1 = pgrp / (1.0f + p2); w2 = pgrp * p2 / (1.0f + p2);
            e1 = 4 * grp + i1; e2 = 4 * grp + i2;
            rk1 = __hip_atomic_fetch_add(&lcnt[e1], 1, __ATOMIC_RELAXED, __HIP_MEMORY_SCOPE_WORKGROUP); rk2 = __hip_atomic_fetch_add(&lcnt[e2], 1, __ATOMIC_RELAXED, __HIP_MEMORY_SCOPE_WORKGROUP);
        }
        __syncthreads();
        if (F.tid < 16) lbase[F.tid] = (int)__hip_atomic_fetch_add(gcnt + F.tid, (unsigned)lcnt[F.tid], __ATOMIC_RELAXED, __HIP_MEMORY_SCOPE_AGENT);
        __syncthreads();
        if (F.tid < 64) { const int tok = tok0 + F.tid; const int p1 = lbase[e1] + rk1, p2 = lbase[e2] + rk2;
            list[e1 * ECAP + p1] = tok; rsr[e1 * ECAP + p1] = rstd; rsw[e1 * ECAP + p1] = w1;
            list[e2 * ECAP + p2] = tok; rsr[e2 * ECAP + p2] = rstd; rsw[e2 * ECAP + p2] = w2;
            int4 rec; rec.x = e1; rec.y = p1; rec.z = e2; rec.w = p2; *(int4*)(tokrec + 4 * tok) = rec; }
        __syncthreads();
    }
}
__device__ __forceinline__ void moe_table(Frame& F) {
    LAS int* tt = (LAS int*)(F.lds + XTRA_OFF);
    if (F.tid == 0) { int t = 0;
        for (int e = 0; e < NE; ++e) { int c = (int)F.ctl[CW_GCNT + e]; if (c > ECAP) c = ECAP; if (c < 0) c = 0; tt[256 + e] = c; tt[288 + e] = t; const int n = (c + 255) >> 8;
            for (int rb = 0; rb < n && t < MAXTILES; ++rb) tt[16 + t++] = e | (rb << 8); }
        tt[0] = t; }
    __syncthreads();
}

__device__ __forceinline__ void p9_final(Frame& F) {
    const LAS int* tt = (const LAS int*)(F.lds + XTRA_OFF);
    const int* tokrec = (const int*)(F.ws + WS_TOKREC); const bf16* Y = (const bf16*)(F.ws + WS_Y); const float* gfin = F.in[16];
    const int gw = F.bx * NWAVES + F.wave, NGW = F.G * NWAVES;
    for (int m = gw; m < T; m += NGW) {
        const int4 rec = *(const int4*)(tokrec + 4 * m);
        const int e1 = __builtin_amdgcn_readfirstlane(rec.x), p1 = __builtin_amdgcn_readfirstlane(rec.y), e2 = __builtin_amdgcn_readfirstlane(rec.z), p2 = __builtin_amdgcn_readfirstlane(rec.w);
        const size_t r1 = (size_t)tt[288 + (e1 & 15)] * 256 + p1, r2 = (size_t)tt[288 + (e2 & 15)] * 256 + p2;
        f32x4* xr = (f32x4*)(F.out + (size_t)m * DM) + F.lane; const u32x2* y1 = (const u32x2*)(Y + r1 * DM) + F.lane; const u32x2* y2 = (const u32x2*)(Y + r2 * DM) + F.lane;
        f32x4 v[8]; float ss = 0.f;
#pragma unroll
        for (int j = 0; j < 8; ++j) { v[j] = xr[64 * j]; const u32x2 a = y1[64 * j], b = y2[64 * j];
            v[j][0] += bflo(a.x) + bflo(b.x); v[j][1] += bfhi(a.x) + bfhi(b.x); v[j][2] += bflo(a.y) + bflo(b.y); v[j][3] += bfhi(a.y) + bfhi(b.y);
            ss += (v[j][0] * v[j][0] + v[j][1] * v[j][1]) + (v[j][2] * v[j][2] + v[j][3] * v[j][3]); }
        const float rstd = 1.0f / sqrtf(wave_sum(ss) * (1.0f / DM) + EPS);
#pragma unroll
        for (int j = 0; j < 8; ++j) { const f32x4 g = *((const f32x4*)gfin + 64 * j + F.lane); f32x4 o; o[0] = v[j][0] * rstd * g[0]; o[1] = v[j][1] * rstd * g[1]; o[2] = v[j][2] * rstd * g[2]; o[3] = v[j][3] * rstd * g[3]; xr[64 * j] = o; }
    }
}

constexpr int NPHASE = 10;
__global__ void __launch_bounds__(NTHR, 2) fwd(Args args) {
    extern __shared__ __attribute__((aligned(16))) unsigned char lds_raw[];
    Frame F;
    F.lds = (LAS unsigned char*)lds_raw; F.ws = args.ws; F.ctl = (unsigned*)(args.ws + WS_CTL);
    F.tid = threadIdx.x; F.lane = F.tid & 63; F.wave = __builtin_amdgcn_readfirstlane(F.tid >> 6); F.G = gridDim.x; F.bx = blockIdx.x;
#pragma unroll
    for (int i = 0; i < 17; ++i) F.in[i] = args.in[i];
    F.out = args.out;
    for (int u = F.tid; u < 256; u += NTHR) ((LAS unsigned*)(F.lds + LCTL_OFF))[u] = 0u;
    __syncthreads();
    const int lo = args.ph_lo, hi = args.ph_hi;
    const bool multi = (hi - lo) > 1;
    XcdBarrier bar; bar.bar = F.ctl + CW_BAR; bar.x = 0; bar.st = (volatile LAS unsigned*)(F.lds + LCTL_OFF);
    if (multi) bar = xcd_barrier_post(F.ctl + CW_BAR, (volatile LAS unsigned*)(F.lds + LCTL_OFF));
#define IN(k) (lo <= (k) && (k) < hi)
#define SEAM(k) do { if (IN(k) && IN((k) + 1)) xcd_barrier(bar); } while (0)

    if (IN(0)) { p0_prologue(F); } SEAM(0);
    if (IN(1)) {
        pg8::Gemm g{(const bf16*)(F.ws + WS_A), (const bf16*)(F.ws + WS_WQKV), T, NQKV, DM}; pg8::StaticOrder S; S.init(T, NQKV, F.G, F.bx);
        EpiQKV E{(bf16*)(F.ws + WS_QKV)};
        pg8::gemm_phase<EpiQKV, pg8::StaticOrder, true, false>(F.lds + RING_OFF, g, S, E);
    } SEAM(1);
    if (IN(2)) { p2_kmean_cumsum(F); } SEAM(2);
    if (IN(3)) {   } SEAM(3);
    if (IN(4)) { p4_outnorm(F); } SEAM(4);
    if (IN(5)) {
        pg8::Gemm g{(const bf16*)(F.ws + WS_A), (const bf16*)(F.ws + WS_WO), T, DM, DM}; pg8::StaticOrder S; S.init(T, DM, F.G, F.bx);
        EpiRes E{F.in[0], F.out, (bf16*)(F.ws + WS_XB)};
        pg8::gemm_phase<EpiRes, pg8::StaticOrder, true, false>(F.lds + RING_OFF, g, S, E);
    } SEAM(5);
    if (IN(6)) { p6_route(F); } SEAM(6);
    if (IN(7)) {
        moe_table(F);
        const LAS int* tt = (const LAS int*)(F.lds + XTRA_OFF);
        pg8::Gemm g{(const bf16*)(F.ws + WS_XB), (const bf16*)(F.ws + WS_WGU), MAXTILES * 256, NE * 1024, DM};
        MoeGather S; S.G = F.G; S.c = F.bx; S.ncol = 4; S.tt = tt; S.list = (const int*)(F.ws + WS_LIST);
        EpiHid E{(bf16*)(F.ws + WS_A), (const float*)(F.ws + WS_RSR), (const float*)(F.ws + WS_RSW), tt};
        pg8::gemm_phase<EpiHid, MoeGather, true, true>(F.lds + RING_OFF, g, S, E);
    } SEAM(7);
    if (IN(8)) {
        moe_table(F);
        const LAS int* tt = (const LAS int*)(F.lds + XTRA_OFF);
        pg8::Gemm g{(const bf16*)(F.ws + WS_A), (const bf16*)(F.ws + WS_WD), MAXTILES * 256, NE * DM, DE};
        MoePlain S; S.G = F.G; S.c = F.bx; S.ncol = 8; S.tt = tt;
        EpiY E{(bf16*)(F.ws + WS_Y)};
        pg8::gemm_phase<EpiY, MoePlain, true, false>(F.lds + RING_OFF, g, S, E);
    } SEAM(8);
    if (IN(9)) { moe_table(F); p9_final(F); }
#undef IN
#undef SEAM
}

template <int MODE>
__global__ void __launch_bounds__(256) naive_attn(unsigned char* ws, const float* rel_bias) {
    const bf16* qkv = (const bf16*)(ws + WS_QKV); const float* cbuf = (const float*)(ws + WS_C); const bf16* kmean = (const bf16*)(ws + WS_KMEAN); bf16* AO = (bf16*)(ws + WS_A);
    __shared__ float qs[16][128]; __shared__ float sc[16][256]; __shared__ float gsc[16][16]; __shared__ unsigned selm[16]; __shared__ float lut[132];
    const int t = threadIdx.x, bh = blockIdx.y, b = bh >> 3, h = bh & 7, i0 = blockIdx.x * 16;
    const bf16* Q = qkv + ((size_t)(MODE * 3 + 0) * 32 + bh) * SEQ * HD; const bf16* Kp = qkv + ((size_t)(MODE * 3 + 1) * 32 + bh) * SEQ * HD; const bf16* Vp = qkv + ((size_t)(MODE * 3 + 2) * 32 + bh) * SEQ * HD;
    for (int i = t; i < 16 * 128; i += 256) qs[i >> 7][i & 127] = bf2f(Q[(size_t)(i0 + (i >> 7)) * HD + (i & 127)]);
    const int own = i0 >> 8;
    if (MODE == 1) { for (int d = t; d < 129; d += 256) { int bk; if (d < 16) bk = d; else { bk = 16 + (int)(logf((float)d / 16.0f) / 2.0794415416798357f * 16.0f); if (bk > 31) bk = 31; } lut[d] = rel_bias[h * 32 + bk]; } }
    __syncthreads();
    if (MODE == 1) {
        const int q = t >> 4, n = t & 15; float g = -1e30f;
        if (n < own) { g = 0.f; const bf16* km = kmean + ((size_t)bh * 16 + n) * 128; for (int d = 0; d < 128; ++d) g += qs[q][d] * bf2f(km[d]); }
        gsc[q][n] = g;
        __syncthreads();
        if (t < 16) { unsigned m = 0; const int nsel = own < 3 ? own : 3;
            for (int k = 0; k < nsel; ++k) { int best = -1; float bv = 0.f; for (int n2 = 0; n2 < own; ++n2) if (!((m >> n2) & 1u) && (best < 0 || gsc[t][n2] > bv)) { best = n2; bv = gsc[t][n2]; } if (best >= 0) m |= 1u << best; }
            selm[t] = m; }
        __syncthreads();
    }
    const int q = t >> 4, dg = t & 15;
    float o[8]; for (int c = 0; c < 8; ++c) o[c] = 0.f;
    float mrun = -1e30f, lrun = 0.f;
    const float scale = 0.08838834764831845f;
    const int nch = own + 1;
    for (int ch = 0; ch < nch; ++ch) {
        const int j = ch * 256 + t;
        float kr[128];
        { const u32x4* kp = (const u32x4*)(Kp + (size_t)j * HD);
#pragma unroll
          for (int c = 0; c < 16; ++c) { const u32x4 w = kp[c]; kr[8 * c + 0] = bflo(w.x); kr[8 * c + 1] = bfhi(w.x); kr[8 * c + 2] = bflo(w.y); kr[8 * c + 3] = bfhi(w.y); kr[8 * c + 4] = bflo(w.z); kr[8 * c + 5] = bfhi(w.z); kr[8 * c + 6] = bflo(w.w); kr[8 * c + 7] = bfhi(w.w); } }
        const float cj = (MODE == 0) ? cbuf[(size_t)bh * SEQ + j] : 0.f;
        for (int qq = 0; qq < 16; ++qq) { const int i = i0 + qq; float s = 0.f;
#pragma unroll
            for (int d = 0; d < 128; ++d) s += qs[qq][d] * kr[d];
            s *= scale; bool ok;
            if (MODE == 0) { s += cbuf[(size_t)bh * SEQ + i] - cj; ok = j <= i; }
            else { const int dd = i - j; s += lut[dd < 0 ? 0 : (dd > 128 ? 128 : dd)]; ok = (ch == own) ? (j <= i) : (((selm[qq] >> ch) & 1u) != 0u); }
            sc[qq][t] = ok ? s : -__builtin_inff(); }
        __syncthreads();
        float cm = -__builtin_inff();
        for (int c = 0; c < 16; ++c) cm = fmaxf(cm, sc[q][dg + 16 * c]);
#pragma unroll
        for (int off = 1; off < 16; off <<= 1) cm = fmaxf(cm, __shfl_xor(cm, off));
        const float mnew = fmaxf(mrun, cm), alpha = expf(mrun - mnew);
        float ps = 0.f; float pv[16];
        for (int c = 0; c < 16; ++c) { pv[c] = expf(sc[q][dg + 16 * c] - mnew); ps += pv[c]; }
#pragma unroll
        for (int off = 1; off < 16; off <<= 1) ps += __shfl_xor(ps, off);
        lrun = lrun * alpha + ps; mrun = mnew;
        __syncthreads();
        for (int c = 0; c < 16; ++c) sc[q][dg + 16 * c] = pv[c];
        __syncthreads();
        for (int c = 0; c < 8; ++c) o[c] *= alpha;
        for (int jj = 0; jj < 256; ++jj) { const float p = sc[q][jj]; const u32x4 w = *(const u32x4*)(Vp + (size_t)(ch * 256 + jj) * HD + 8 * dg);
            o[0] += p * bflo(w.x); o[1] += p * bfhi(w.x); o[2] += p * bflo(w.y); o[3] += p * bfhi(w.y); o[4] += p * bflo(w.z); o[5] += p * bfhi(w.z); o[6] += p * bflo(w.w); o[7] += p * bfhi(w.w); }
        __syncthreads();
    }
    const float il = 1.0f / lrun;
    u32x4 w; w.x = cvt_pk_bf16(o[0] * il, o[1] * il); w.y = cvt_pk_bf16(o[2] * il, o[3] * il); w.z = cvt_pk_bf16(o[4] * il, o[5] * il); w.w = cvt_pk_bf16(o[6] * il, o[7] * il);
    *(u32x4*)(AO + (size_t)(b * SEQ + i0 + q) * DM + MODE * GWID + h * HD + 8 * dg) = w;
}

extern "C" void kernel_launch(void* const* d_in, const int* in_sizes, int n_in, void* d_out, int out_size, void* d_ws, size_t ws_size, hipStream_t stream) {
    static int grid = 0;
    if (grid == 0) {
        if (n_in != 17 || out_size != T * DM || ws_size < WS_END) { fprintf(stderr, "kernel_launch: unexpected shapes (n_in %d out %d ws %zu)\n", n_in, out_size, ws_size); grid = -1; return; }
        int dev = 0, cus = 0;
        if (hipGetDevice(&dev) != hipSuccess || hipDeviceGetAttribute(&cus, hipDeviceAttributeMultiprocessorCount, dev) != hipSuccess) { grid = -1; return; }
        if (hipFuncSetAttribute((const void*)fwd, hipFuncAttributeMaxDynamicSharedMemorySize, LDS_BYTES) != hipSuccess) { fprintf(stderr, "kernel_launch: hipFuncSetAttribute failed\n"); grid = -1; return; }
        int per_cu = 0;
        if (hipOccupancyMaxActiveBlocksPerMultiprocessor(&per_cu, (const void*)fwd, NTHR, LDS_BYTES) != hipSuccess || per_cu < 1) fprintf(stderr, "kernel_launch: occupancy query reports %d\n", per_cu);
        (void)hipGetLastError();
        grid = cus > 0 ? cus : 256;
    }
    if (grid < 0) return;
    (void)hipMemsetAsync((char*)d_ws + WS_CTL, 0, CTL_ZERO_BYTES, stream);
    Args a{};
    for (int i = 0; i < 17; ++i) a.in[i] = (const float*)d_in[i];
    a.out = (float*)d_out; a.ws = (unsigned char*)d_ws;
    for (int ph = 0; ph < NPHASE; ++ph) {
        if (ph == 3) {
            hipLaunchKernelGGL(naive_attn<0>, dim3(SEQ / 16, 32), dim3(256), 0, stream, (unsigned char*)d_ws, (const float*)d_in[6]);
            hipLaunchKernelGGL(naive_attn<1>, dim3(SEQ / 16, 32), dim3(256), 0, stream, (unsigned char*)d_ws, (const float*)d_in[6]);
            continue;
        }
        a.ph_lo = ph; a.ph_hi = ph + 1;
        hipLaunchKernelGGL(fwd, dim3(grid), dim3(NTHR), LDS_BYTES, stream, a);
    }
}
```

```cpp
#include <hip/hip_runtime.h>
#include <cstdio>
#include <cstdint>

#define GAS __attribute__((address_space(1)))
#define LAS __attribute__((address_space(3)))
typedef unsigned short bf16;
typedef short bf16x8 __attribute__((ext_vector_type(8)));
typedef float f32x4 __attribute__((ext_vector_type(4)));
typedef float f32x2 __attribute__((ext_vector_type(2)));
typedef unsigned u32x4 __attribute__((ext_vector_type(4)));
typedef unsigned u32x2 __attribute__((ext_vector_type(2)));

constexpr int BATCH = 4, SEQ = 4096, DM = 2048, T = BATCH * SEQ, NH = 8, HD = 128, GWID = 1024, NQKV = 6144, WIN_LD = 6152;
constexpr int NE = 16, DE = 512, ECAP = 16384, MAXTILES = 144, NRC = 32  ;
constexpr float EPS = 1e-6f;
constexpr int NWAVES = 8, NTHR = 512;

constexpr size_t MiB = 1u << 20, KiB = 1u << 10;
constexpr size_t WS_CTL = 0, CTL_ZERO_BYTES = 1 * MiB;
constexpr size_t WS_WQKV = 2 * MiB;
constexpr size_t WS_WO = 26 * MiB;
constexpr size_t WS_WGU = 34 * MiB;
constexpr size_t WS_WD = 98 * MiB;
constexpr size_t WS_WR = 130 * MiB;
constexpr size_t WS_LF = 130 * MiB + 256 * KiB;
constexpr size_t WS_C = 131 * MiB;
constexpr size_t WS_KMEAN = 131 * MiB + 512 * KiB;
constexpr size_t WS_TOKREC = 132 * MiB;
constexpr size_t WS_LIST = 133 * MiB;
constexpr size_t WS_RSR = 134 * MiB;
constexpr size_t WS_RSW = 135 * MiB;
constexpr size_t WS_A = 138 * MiB;
constexpr size_t WS_QKV = 202 * MiB;
constexpr size_t WS_XB = 202 * MiB;
constexpr size_t WS_Y = 266 * MiB;
constexpr size_t WS_END = 410 * MiB;
constexpr int CW_TMO = 0, CW_GCNT = 64, CW_BAR = 4096;

constexpr int LCTL_OFF = 0;
constexpr int RING_OFF = 1024, RING_BYTES = 131072;
constexpr int XTRA_OFF = RING_OFF + RING_BYTES;
constexpr int LDS_BYTES = 155648;

#define LDS_WAIT() asm volatile("s_waitcnt lgkmcnt(0)" ::: "memory")
#define VM_WAIT() asm volatile("s_waitcnt vmcnt(0)" ::: "memory")
__device__ __forceinline__ unsigned cvt_pk_bf16(float lo, float hi) { unsigned r; asm volatile("v_cvt_pk_bf16_f32 %0, %1, %2" : "=v"(r) : "v"(lo), "v"(hi)); return r; }
__device__ __forceinline__ float bf2f(unsigned short b) { return __uint_as_float((unsigned)b << 16); }
__device__ __forceinline__ float bflo(unsigned w) { return __uint_as_float(w << 16); }
__device__ __forceinline__ float bfhi(unsigned w) { return __uint_as_float(w & 0xffff0000u); }
__device__ __forceinline__ float wave_sum(float v) {
#pragma unroll
    for (int o = 1; o < 64; o <<= 1) v += __shfl_xor(v, o);
    return v;
}

__device__ __forceinline__ int ltid() { int t = threadIdx.x; asm volatile("" : "+v"(t)); return t; }
namespace pg8 {
typedef unsigned short bf16_t;
constexpr int BM = 256, BK = 64, HALF = 128, HTB = HALF * BK * 2, STAGE_BYTES = 8 * HTB, NXCD = 8, WGM = 8;
__host__ __device__ __forceinline__ int lds_byte(int r, int c) { const int st = (r >> 4) * 2 + (c >> 5), rr = r & 15, cc = c & 31, ob = rr * 64 + cc * 2; return st * 1024 + (ob ^ (((ob >> 9) & 1) << 5)); }
__host__ __device__ __forceinline__ void stage_rc(int b, int& R, int& C) { const int st = b / 1024, sb = b % 1024, swz = sb ^ (((sb >> 9) & 1) << 5); R = (st >> 1) * 16 + swz / 64; C = (st & 1) * 32 + (swz % 64) / 2; }
__host__ __device__ __forceinline__ int perm32(int rho) { const int n = rho >> 4, i = rho & 15; return 8 * (i >> 2) + 4 * n + (i & 3); }

struct Unit { int pm, pn; };
struct Gemm { const bf16_t* A; const bf16_t* Bt; int M, N, K; };

struct StaticOrder {
    int nM, nN, nwg, G, c;
    __host__ __device__ void init(int M, int N, int G_, int c_) { nM = M / BM; nN = N / BM; nwg = nM * nN; G = G_; c = c_; }
    __host__ __device__ bool next(int i, Unit& u) const {
        const long L = (long)i * G + c; if (L >= nwg) return false;
        int wgid = (int)L; { const int q = nwg / NXCD, r = nwg % NXCD, xcd = wgid % NXCD, off = wgid / NXCD; wgid = (xcd < r ? xcd * (q + 1) : r * (q + 1) + (xcd - r) * q) + off; }
        const int nig = WGM * nN, gid = wgid / nig, fm = gid * WGM, gsz = (nM - fm) < WGM ? (nM - fm) : WGM;
        u.pm = fm + ((wgid % nig) % gsz); u.pn = (wgid % nig) / gsz; return true;
    }
    __device__ __forceinline__ int arow(const Unit&, int) const { return 0; }
};

template <class Epi, class Sched, bool ALIGN_EPI, bool GATHER>
__device__ __forceinline__ void gemm_phase(LAS unsigned char* lds, const Gemm g, const Sched& S, const Epi& E) {
    const int tid = ltid(), wid = __builtin_amdgcn_readfirstlane(tid >> 6), lane = tid & 63, wr = wid >> 2, wc = wid & 3, fr = lane & 15, fq = lane >> 4;
    const int K = g.K, nt = K / BK;
    unsigned voffA[2], voffB[2]; int RA[2]; unsigned CA2[2];
#pragma unroll
    for (int i = 0; i < 2; ++i) { int R, C; stage_rc(tid * 16 + i * 8192, R, C); const int Rb = Epi::PERM ? ((R & ~31) + perm32(R & 31)) : R;
        voffA[i] = (unsigned)(R * K + C) * 2u; voffB[i] = (unsigned)(Rb * K + C) * 2u; RA[i] = R; CA2[i] = (unsigned)C * 2u; }
    const size_t kstep = (size_t)(BK * 2);
    const size_t hstep = (size_t)HALF * K * 2;
    const size_t tstep = 2 * hstep;
    const unsigned ldsw = (unsigned)wid * 1024u;
    const int aoff = lds_byte(wr * 64 + fr, fq * 8), boff = lds_byte(wc * 32 + fr, fq * 8);
#define PG8_SA(b, h) (((b) * 2 + (h)) * HTB)
#define PG8_SB(b, h) ((4 + (b) * 2 + (h)) * HTB)
#define PG8_STAGE(bufoff, gbase, voff) do { _Pragma("unroll") for (int _i = 0; _i < 2; ++_i) \
        __builtin_amdgcn_global_load_lds((const unsigned*)((const char*)(gbase) + (voff)[_i]), (LAS unsigned*)(lds + (bufoff) + ldsw + _i * 8192), 16, 0, 0); } while (0)
#define PG8_STAGE_A(bufoff, gbase, h, VV) do { if constexpr (GATHER) { PG8_STAGE(bufoff, gbase, (VV)[h]); } else { PG8_STAGE(bufoff, (gbase) + (h) * hstep, voffA); } } while (0)
#define PG8_LDA(dst, b, h) do { _Pragma("unroll") for (int m = 0; m < 4; ++m) _Pragma("unroll") for (int k = 0; k < 2; ++k) dst[m][k] = *(const LAS bf16x8*)(lds + PG8_SA(b, h) + aoff + m * 2048 + k * 1024); } while (0)
#define PG8_LDB(dst, b, h) do { _Pragma("unroll") for (int n = 0; n < 2; ++n) _Pragma("unroll") for (int k = 0; k < 2; ++k) dst[n][k] = *(const LAS bf16x8*)(lds + PG8_SB(b, h) + boff + n * 2048 + k * 1024); } while (0)
#define PG8_MMA(ai, bj, At, Bt) do { __builtin_amdgcn_s_setprio(1); _Pragma("unroll") for (int m = 0; m < 4; ++m) _Pragma("unroll") for (int n = 0; n < 2; ++n) _Pragma("unroll") for (int k = 0; k < 2; ++k) \
        acc[ai][bj][m][n] = __builtin_amdgcn_mfma_f32_16x16x32_bf16(Bt[n][k], At[m][k], acc[ai][bj][m][n], 0, 0, 0); __builtin_amdgcn_s_setprio(0); } while (0)
#define PG8_WAIT_V(n) asm volatile("s_waitcnt vmcnt(" #n ")" ::: "memory")
#define PG8_WAIT_L(n) asm volatile("s_waitcnt lgkmcnt(" #n ")" ::: "memory")
#define PG8_BAR __builtin_amdgcn_s_barrier()
#define PG8_SCHED __builtin_amdgcn_sched_barrier(0)
    Unit cur, nxt; int ui = 0;
    if (!S.next(0, cur)) return;
    f32x4 acc[2][2][4][2];
#pragma unroll
    for (int a = 0; a < 2; ++a)
#pragma unroll
        for (int b = 0; b < 2; ++b)
#pragma unroll
            for (int m = 0; m < 4; ++m)
#pragma unroll
                for (int n = 0; n < 2; ++n) acc[a][b][m][n] = (f32x4){0.f, 0.f, 0.f, 0.f};
    bf16x8 At[4][2], B0[2][2], B1[2][2];
    unsigned cv[2][2], nv[2][2];
    if constexpr (GATHER) {
#pragma unroll
        for (int h = 0; h < 2; ++h)
#pragma unroll
            for (int i = 0; i < 2; ++i) { cv[h][i] = (unsigned)S.arow(cur, h * HALF + RA[i]) * (unsigned)(K * 2) + CA2[i]; nv[h][i] = cv[h][i]; }
    } else {
#pragma unroll
        for (int h = 0; h < 2; ++h)
#pragma unroll
            for (int i = 0; i < 2; ++i) { cv[h][i] = 0u; nv[h][i] = 0u; }
    }
    const char* cA = GATHER ? (const char*)g.A : (const char*)g.A + (size_t)cur.pm * tstep; const char* cB = (const char*)g.Bt + (size_t)cur.pn * tstep;
    PG8_STAGE(PG8_SB(0, 0), cB, voffB); PG8_STAGE(PG8_SB(0, 1), cB + hstep, voffB); PG8_STAGE_A(PG8_SA(0, 0), cA, 0, cv); PG8_STAGE_A(PG8_SA(0, 1), cA, 1, cv);
    if (wr == 1) PG8_BAR;
    PG8_WAIT_V(2); PG8_BAR;
    PG8_STAGE(PG8_SB(1, 0), cB + kstep, voffB); PG8_STAGE_A(PG8_SA(1, 0), cA + kstep, 0, cv); PG8_STAGE(PG8_SB(1, 1), cB + hstep + kstep, voffB);
    PG8_WAIT_V(6); PG8_BAR;
    for (;;) {
        const bool has_next = S.next(ui + 1, nxt);
        const char* nA = GATHER ? (const char*)g.A : (has_next ? (const char*)g.A + (size_t)nxt.pm * tstep : cA); const char* nB = has_next ? (const char*)g.Bt + (size_t)nxt.pn * tstep : cB;
        if constexpr (GATHER) {
            if (has_next) {
#pragma unroll
                for (int h = 0; h < 2; ++h)
#pragma unroll
                    for (int i = 0; i < 2; ++i) nv[h][i] = (unsigned)S.arow(nxt, h * HALF + RA[i]) * (unsigned)(K * 2) + CA2[i];
            }
        }
        for (int t = 0; t < nt; t += 2) {
            const bool last = (t == nt - 2);
            const char* a1 = cA + (size_t)(t + 1) * kstep;
            const char* a2 = last ? nA : cA + (size_t)(t + 2) * kstep; const char* b2 = last ? nB : cB + (size_t)(t + 2) * kstep;
            const char* a3 = a2 + kstep; const char* b3 = b2 + kstep;
            unsigned v2[2][2];
#pragma unroll
            for (int h = 0; h < 2; ++h)
#pragma unroll
                for (int i = 0; i < 2; ++i) v2[h][i] = last ? nv[h][i] : cv[h][i];
            PG8_LDB(B0, 0, 0); PG8_LDB(B1, 0, 1); PG8_SCHED; PG8_LDA(At, 0, 0); PG8_STAGE_A(PG8_SA(1, 1), a1, 1, cv);
            PG8_WAIT_V(8); PG8_WAIT_L(0); PG8_BAR; PG8_MMA(0, 0, At, B0); PG8_MMA(0, 1, At, B1); PG8_BAR; PG8_SCHED;
            PG8_LDA(At, 0, 1); PG8_STAGE(PG8_SB(0, 0), b2, voffB); PG8_STAGE(PG8_SB(0, 1), b2 + hstep, voffB); PG8_STAGE_A(PG8_SA(0, 0), a2, 0, v2);
            PG8_WAIT_V(8); PG8_WAIT_L(0); PG8_BAR; PG8_MMA(1, 0, At, B0); PG8_MMA(1, 1, At, B1); PG8_BAR; PG8_SCHED;
            PG8_LDB(B0, 1, 0); PG8_LDB(B1, 1, 1); PG8_SCHED; PG8_LDA(At, 1, 0); PG8_STAGE_A(PG8_SA(0, 1), a2, 1, v2);
            PG8_WAIT_V(8); PG8_WAIT_L(0); PG8_BAR; PG8_MMA(0, 0, At, B0); PG8_MMA(0, 1, At, B1); PG8_BAR; PG8_SCHED;
            PG8_LDA(At, 1, 1); PG8_STAGE(PG8_SB(1, 0), b3, voffB); PG8_STAGE(PG8_SB(1, 1), b3 + hstep, voffB); PG8_STAGE_A(PG8_SA(1, 0), a3, 0, v2);
            PG8_WAIT_V(8); PG8_WAIT_L(0); PG8_BAR; PG8_MMA(1, 0, At, B0); PG8_MMA(1, 1, At, B1); PG8_BAR; PG8_SCHED;
        }
        if constexpr (ALIGN_EPI) { if (wr == 0) PG8_BAR; }
        E(acc, cur, wr, wc, fr, fq);
        if (!has_next) break;
#pragma unroll
        for (int a = 0; a < 2; ++a)
#pragma unroll
            for (int b = 0; b < 2; ++b)
#pragma unroll
                for (int m = 0; m < 4; ++m)
#pragma unroll
                    for (int n = 0; n < 2; ++n) acc[a][b][m][n] = (f32x4){0.f, 0.f, 0.f, 0.f};
        cur = nxt; cA = nA; cB = nB; ++ui;
#pragma unroll
        for (int h = 0; h < 2; ++h)
#pragma unroll
            for (int i = 0; i < 2; ++i) cv[h][i] = nv[h][i];
        if constexpr (ALIGN_EPI) { if (wr == 1) PG8_BAR; }
    }
    PG8_WAIT_V(0);
    if constexpr (!ALIGN_EPI) { if (wr == 0) PG8_BAR; }
    PG8_BAR;
#undef PG8_SA
#undef PG8_SB
#undef PG8_STAGE
#undef PG8_STAGE_A
#undef PG8_LDA
#undef PG8_LDB
#undef PG8_MMA
#undef PG8_WAIT_V
#undef PG8_WAIT_L
#undef PG8_BAR
#undef PG8_SCHED
}
}


namespace att {
constexpr int D = 128, NW = 8, QBLK = 32, KVBLK = 64, QB = 256;
constexpr int SHM_V = 16384, SHM_K = 16384;
constexpr int OFF_WS = 2 * SHM_V + 2 * SHM_K, OFF_KBF = OFF_WS + NW * 256, OFF_LUT = OFF_KBF + 16384, LDS_ATT = OFF_LUT + 2304;
constexpr float SCALE = 0.08838834764831845f, ISCALE = 11.313708498984761f, THR = 8.f;
typedef short s16x4 __attribute__((ext_vector_type(4)));
typedef float f32x16 __attribute__((ext_vector_type(16)));
#define KSWZ(row, colB) ((row) * 256 + ((colB) ^ (((row) & 7) << 4)))
#define SBAR() __builtin_amdgcn_sched_barrier(0)
__device__ __forceinline__ int v_st(int k, int c) { const int kk = (k & ~0xC) | ((k & 4) << 1) | ((k & 8) >> 1); return ((kk >> 3) * 4 + (c >> 5)) * 512 + ((kk & 7) * 32 + (c & 31)) * 2; }
__device__ __forceinline__ int v_rd_base(int lane) { return ((lane & 3) << 3) | (((lane >> 2) & 3) << 6) | (((lane >> 4) & 1) << 5) | (((lane >> 5) & 1) << 8); }
constexpr int v_rd_off(int d0, int ks, int half) { return d0 * 512 + ks * 4096 + half * 2048; }
__device__ __forceinline__ int crow(int r, int hi) { return (r & 3) + 8 * (r >> 2) + 4 * hi; }
__device__ __forceinline__ unsigned cvtpk(float lo, float hi) { unsigned r; asm volatile("v_cvt_pk_bf16_f32 %0, %1, %2" : "=v"(r) : "v"(lo), "v"(hi)); return r; }
__device__ __forceinline__ void mask_tile(f32x16& p0, f32x16& p1, int dq) {
    const float NEG = -__builtin_inff();
#pragma unroll
    for (int r = 0; r < 16; ++r) { const int c = (r & 3) + 8 * (r >> 2);
        if (dq - c < 0) p0[r] = NEG;
        if (dq - c - 32 < 0) p1[r] = NEG; }
}
__device__ __forceinline__ void partialSM(f32x16& p0, f32x16& p1, float& m_reg, float& mn, float& alpha) {
    float pmax = p0[0]; for (int r = 1; r < 16; ++r) pmax = fmaxf(pmax, p0[r]); for (int r = 0; r < 16; ++r) pmax = fmaxf(pmax, p1[r]);
    { auto rr = __builtin_amdgcn_permlane32_swap(__float_as_uint(pmax), __float_as_uint(pmax), false, false);
      pmax = fmaxf(__uint_as_float(rr[0]), __uint_as_float(rr[1])); }
    constexpr float C2 = 1.4426950408889634f * SCALE;
    if (__builtin_expect(__all((pmax - m_reg) * SCALE <= THR), 1)) { mn = m_reg; alpha = 1.f; }
    else { mn = fmaxf(m_reg, pmax); alpha = __builtin_amdgcn_exp2f((m_reg - mn) * C2); m_reg = mn; }
    const float mnL = -mn * C2;
    for (int r = 0; r < 16; ++r) p0[r] = fmaf(p0[r], C2, mnL); for (int r = 0; r < 16; ++r) p1[r] = fmaf(p1[r], C2, mnL);
    for (int r = 0; r < 16; ++r) p0[r] = __builtin_amdgcn_exp2f(p0[r]);
}
__device__ __forceinline__ void finishSM(f32x16& p0, f32x16& p1, float alpha, float& l_reg, bf16x8& pa0, bf16x8& pa1, bf16x8& pa2, bf16x8& pa3) {
    for (int r = 0; r < 16; ++r) p1[r] = __builtin_amdgcn_exp2f(p1[r]);
    float ps = 0; for (int r = 0; r < 16; ++r) ps += p0[r]; for (int r = 0; r < 16; ++r) ps += p1[r];
    { auto rr = __builtin_amdgcn_permlane32_swap(__float_as_uint(ps), __float_as_uint(ps), false, false);
      ps = __uint_as_float(rr[0]) + __uint_as_float(rr[1]); }
    l_reg = l_reg * alpha + ps;
#define PK4(P, B_, OUT) do { unsigned a0 = cvtpk(P[B_+0], P[B_+1]), a1 = cvtpk(P[B_+2], P[B_+3]);                          \
        unsigned b0 = cvtpk(P[B_+4], P[B_+5]), b1 = cvtpk(P[B_+6], P[B_+7]);                                             \
        auto r0 = __builtin_amdgcn_permlane32_swap(a0, b0, false, false); auto r1 = __builtin_amdgcn_permlane32_swap(a1, b1, false, false); \
        u32x4 w = {r0[0], r1[0], r0[1], r1[1]}; OUT = *reinterpret_cast<bf16x8*>(&w); } while (0)
    PK4(p0, 0, pa0); PK4(p0, 8, pa1); PK4(p1, 0, pa2); PK4(p1, 8, pa3);
#undef PK4
}
struct InitCtx {
    const LAS float* kbl;
    int own, qlo, qpos4;
    unsigned sel;
};
template <int KB, int MODE>
__device__ __forceinline__ void qkt(f32x16& p0, f32x16& p1, const char* K_lds, int r32, int hi, const bf16x8* qr, const InitCtx& ic, int kbase) {
    if (MODE == 0) {
        const LAS float* kb = ic.kbl + kbase;
#pragma unroll
        for (int i = 0; i < 4; ++i) { const f32x4 a = *(const LAS f32x4*)(kb + 8 * i), b = *(const LAS f32x4*)(kb + 32 + 8 * i);
            p0[4 * i] = a[0]; p0[4 * i + 1] = a[1]; p0[4 * i + 2] = a[2]; p0[4 * i + 3] = a[3]; p1[4 * i] = b[0]; p1[4 * i + 1] = b[1]; p1[4 * i + 2] = b[2]; p1[4 * i + 3] = b[3]; }
    } else {
        const int jb = kbase >> 8; const bool rowok = (jb >= ic.own) || (((ic.sel >> jb) & 1u) != 0u);
        int B = ic.qpos4 - kbase + 256 - 59; B = B > 384 ? 384 : B; B = rowok ? B : 512; asm volatile("" : "+v"(B));
        const LAS float* lp = ic.kbl + B;
#pragma unroll
        for (int r = 0; r < 16; ++r) { const int c = (r & 3) + 8 * (r >> 2); p0[r] = lp[59 - c]; p1[r] = lp[59 - c - 32]; }
    }
    const char* kb[4];
#pragma unroll
    for (int dd = 0; dd < 4; ++dd) kb[dd] = K_lds + KB * SHM_K + KSWZ(r32, (dd * 16 + hi * 8) * 2);
#pragma unroll
    for (int d0 = 0; d0 < 8; ++d0) { const char* a = kb[d0 & 3] + (d0 >> 2) * 128;
        bf16x8 b0 = *reinterpret_cast<const bf16x8*>(a);
        bf16x8 b1 = *reinterpret_cast<const bf16x8*>(a + 32 * 256);
        p0 = __builtin_amdgcn_mfma_f32_32x32x16_bf16(b0, qr[d0], p0, 0, 0, 0);
        p1 = __builtin_amdgcn_mfma_f32_32x32x16_bf16(b1, qr[d0], p1, 0, 0, 0); }
}
template <int VB>
__device__ __forceinline__ void pv_tile(f32x16* o, int vb0, bf16x8 pa0, bf16x8 pa1, bf16x8 pa2, bf16x8 pa3) {
#define TRRD(dst, off) asm volatile("ds_read_b64_tr_b16 %0, %1 offset:%2" : "=&v"(dst) : "v"(vb0), "i"(off) : "memory")
#define PV_D0(d0) do { s16x4 l0, l1, l2, l3, h0, h1, h2, h3; constexpr int b_ = VB * SHM_V + v_rd_off(d0, 0, 0); \
        TRRD(l0, b_); TRRD(h0, b_ + 2048); TRRD(l1, b_ + 4096); TRRD(h1, b_ + 6144); TRRD(l2, b_ + 8192); TRRD(h2, b_ + 10240); TRRD(l3, b_ + 12288); TRRD(h3, b_ + 14336); \
        asm volatile("s_waitcnt lgkmcnt(0)" ::: "memory"); SBAR();   \
        o[d0] = __builtin_amdgcn_mfma_f32_32x32x16_bf16(pa0, (bf16x8){l0[0], l0[1], l0[2], l0[3], h0[0], h0[1], h0[2], h0[3]}, o[d0], 0, 0, 0);   \
        o[d0] = __builtin_amdgcn_mfma_f32_32x32x16_bf16(pa1, (bf16x8){l1[0], l1[1], l1[2], l1[3], h1[0], h1[1], h1[2], h1[3]}, o[d0], 0, 0, 0);   \
        o[d0] = __builtin_amdgcn_mfma_f32_32x32x16_bf16(pa2, (bf16x8){l2[0], l2[1], l2[2], l2[3], h2[0], h2[1], h2[2], h2[3]}, o[d0], 0, 0, 0);   \
        o[d0] = __builtin_amdgcn_mfma_f32_32x32x16_bf16(pa3, (bf16x8){l3[0], l3[1], l3[2], l3[3], h3[0], h3[1], h3[2], h3[3]}, o[d0], 0, 0, 0); } while (0)
    PV_D0(0); PV_D0(1); PV_D0(2); PV_D0(3);
#undef PV_D0
#undef TRRD
}
struct BlockRef { const bf16* Q; const bf16* K; const bf16* V; bf16* O; int P0; int bh; };
struct Seam { bf16x8 qr[8]; bf16x8 st_v0, st_v1, st_k0, st_k1; };
#define ROW(p, k0, rr) ((p) + (size_t)((k0) + (rr)) * D + sc)
#define VMW() asm volatile("s_waitcnt vmcnt(0)" ::: "memory")
#define VMWN(n) asm volatile("s_waitcnt vmcnt(%0)" :: "i"(n) : "memory")
#define LD8(p) (*reinterpret_cast<const bf16x8*>(p))
#define SLOAD_H(Kp, Vp, k0) do { S.st_v0 = LD8(ROW(Vp, k0, sr)); S.st_v1 = LD8(ROW(Vp, k0, 32 + sr));              \
                         S.st_k0 = LD8(ROW(Kp, k0, sr)); S.st_k1 = LD8(ROW(Kp, k0, 32 + sr)); } while (0)
#define SWRITE_HK(bf) do { *(bf16x8*)(K_lds + (bf) * SHM_K + kws) = S.st_k0; *(bf16x8*)(K_lds + (bf) * SHM_K + kws + 32 * 256) = S.st_k1; } while (0)
#define SWRITE_HV(bf) do { *(bf16x8*)(V_lds + (bf) * SHM_V + vst0) = S.st_v0; *(bf16x8*)(V_lds + (bf) * SHM_V + vst1) = S.st_v1; } while (0)
#define SWRITE_H(bf) do { SWRITE_HV(bf); SWRITE_HK(bf); } while (0)
__device__ __forceinline__ void attn_prime(const BlockRef& cur, char* lds, Seam& S) {
    const int tid = ltid(), wid = __builtin_amdgcn_readfirstlane(tid >> 6), lane = tid & 63, r32 = lane & 31, hi = lane >> 5;
    const int sr = tid >> 4, sc = (tid & 15) * 8, kws = KSWZ(sr, sc * 2); char* K_lds = lds + 2 * SHM_V;
    for (int d0 = 0; d0 < 8; ++d0) S.qr[d0] = LD8(cur.Q + (size_t)(wid * QBLK + r32) * D + d0 * 16 + hi * 8);
    SLOAD_H(cur.K, cur.V, 0); VMW(); SWRITE_HK(0);
    __syncthreads();
}
template <int MODE>
__device__ __forceinline__ void attn_block(const BlockRef& cur, const BlockRef& nxt, LAS unsigned char* L, Seam& S, const float* cbuf, const bf16* kmean, const float* rel_bias) {
    char* lds = (char*)L;
    const int tid = ltid(), wid = __builtin_amdgcn_readfirstlane(tid >> 6), lane = tid & 63, r32 = lane & 31, hi = lane >> 5;
    const int NT = (cur.P0 + QB) / KVBLK;
    const int qlo = cur.P0 + wid * QBLK, qm = qlo + r32 - 4 * hi;
    char* V_lds = lds; char* K_lds = lds + 2 * SHM_V;
    float* ws = (float*)(lds + OFF_WS) + wid * 64; float* li_l = ws, * al_l = ws + 32;
    float m_reg = -1e30f, l_reg = 0; f32x16 o[4] = {};
    const int sr = tid >> 4, sc = (tid & 15) * 8, vst0 = v_st(sr, sc), vst1 = v_st(32 + sr, sc), kws = KSWZ(sr, sc * 2);
    const int vb0 = (int)(uintptr_t)V_lds + v_rd_base(lane);
    const bf16* Kh = cur.K; const bf16* Vh = cur.V;
    InitCtx ic; ic.own = cur.P0 >> 8; ic.qlo = qlo; ic.qpos4 = qm; ic.sel = 0u;
    const int h = cur.bh & 7;
    if (MODE == 0) {
        LAS float* kbf = (LAS float*)(L + OFF_KBF);
        const float* cs = cbuf + (size_t)cur.bh * SEQ; const float cref = cs[cur.P0];
        for (int j = tid; j < cur.P0 + QB; j += NTHR) kbf[j] = (cref - cs[j]) * ISCALE;
        ic.kbl = kbf + 4 * hi;
    } else {
        LAS float* lutX = (LAS float*)(L + OFF_LUT);
        { int d = tid - 256; if (d < 0) d = 0; if (d > 128) d = 128; int bk; if (d < 16) bk = d; else { bk = 16 + (int)(logf((float)d / 16.0f) / 2.0794415416798357f * 16.0f); if (bk > 31) bk = 31; }
          lutX[tid] = rel_bias[h * 32 + bk] * ISCALE; if (tid < 64) lutX[512 + tid] = -__builtin_inff(); }
        ic.kbl = lutX;
        f32x16 g = {};
        const bf16* km = kmean + ((size_t)cur.bh * 16 + (r32 & 15)) * 128 + hi * 8;
#pragma unroll
        for (int d0 = 0; d0 < 8; ++d0) { bf16x8 a = LD8(km + d0 * 16); if (r32 >= 16) a = (bf16x8){0, 0, 0, 0, 0, 0, 0, 0}; g = __builtin_amdgcn_mfma_f32_32x32x16_bf16(a, S.qr[d0], g, 0, 0, 0); }
        float gt[16];
#pragma unroll
        for (int n = 0; n < 16; ++n) { const int hh = (n >> 2) & 1, r = (n & 3) + 4 * (n >> 3); const float mine = g[r], oth = __shfl_xor(mine, 32); gt[n] = (hh == hi) ? mine : oth; }
        unsigned sel = 0u;
#pragma unroll
        for (int k = 0; k < 3; ++k) { float best = -__builtin_inff(); int bi = 16;
#pragma unroll
            for (int n = 0; n < 16; ++n) { const bool ok = (n < ic.own) && (((sel >> n) & 1u) == 0u) && (gt[n] > best); best = ok ? gt[n] : best; bi = ok ? n : bi; }
            if (bi < 16) sel |= 1u << bi; }
        ic.sel = sel;
    }
    __syncthreads();
#define RESC(a) do { if (__any((a) < 1.f)) { if (hi == 0) al_l[r32] = (a); asm volatile("s_waitcnt lgkmcnt(0)" ::: "memory");              \
                     for (int d_ = 0; d_ < 4; ++d_) for (int r = 0; r < 16; ++r) o[d_][r] *= al_l[crow(r, hi)]; } } while (0)
#define KBASE(t) ((t) * KVBLK)
#define MASKT(P0_, P1_, t) do { const int kb_ = KBASE(t); if (kb_ + KVBLK - 1 > qlo) mask_tile(P0_, P1_, qm - kb_); } while (0)
    constexpr int NQL = 8;
#define SEAM_K0() do { VMWN(NQL); SWRITE_HK(0); SBAR(); } while (0)
    f32x16 pA0, pA1, pB0, pB1; float mnA, mnB, alA, alB; bf16x8 pa0, pa1, pa2, pa3;
    SWRITE_HV(0); SBAR();
    if (NT > 1) { SLOAD_H(Kh, Vh, KBASE(1)); }
    SBAR(); qkt<0, MODE>(pA0, pA1, K_lds, r32, hi, S.qr, ic, KBASE(0));
    MASKT(pA0, pA1, 0); partialSM(pA0, pA1, m_reg, mnA, alA);
    if (NT > 1) { VMW(); SWRITE_H(1); }
    __syncthreads();
#define HALF_STEP(PX0, PX1, mnX, alX, PY0, PY1, alY, t, KB, VB, SB) do {                                                      \
        SBAR(); qkt<KB, MODE>(PX0, PX1, K_lds, r32, hi, S.qr, ic, KBASE(t));                                             \
        finishSM(PY0, PY1, alY, l_reg, pa0, pa1, pa2, pa3); SBAR();                                                           \
        if ((t) + 1 < NT) { SLOAD_H(Kh, Vh, KBASE((t) + 1)); SBAR(); }                                               \
        pv_tile<VB>(o, vb0, pa0, pa1, pa2, pa3); MASKT(PX0, PX1, (t)); partialSM(PX0, PX1, m_reg, mnX, alX);                                        \
        __syncthreads();                                                                                                      \
        if ((t) + 1 < NT) { VMW(); SWRITE_H(SB); }                                                                          \
        RESC(alX); __syncthreads(); } while (0)
    for (int t = 1; t + 1 < NT; t += 2) {
        HALF_STEP(pB0, pB1, mnB, alB, pA0, pA1, alA, t, 1, 0, 0);
        HALF_STEP(pA0, pA1, mnA, alA, pB0, pB1, alB, t + 1, 0, 1, 1);
    }
    const bool even = (NT & 1) == 0;
    if (even) { SBAR(); qkt<1, MODE>(pB0, pB1, K_lds, r32, hi, S.qr, ic, KBASE(NT - 1)); SBAR(); }
    SLOAD_H(nxt.K, nxt.V, 0); SBAR();
#pragma unroll
    for (int d0 = 0; d0 < 8; ++d0) S.qr[d0] = LD8(nxt.Q + (size_t)(wid * QBLK + r32) * D + d0 * 16 + hi * 8);
    SBAR();
    finishSM(pA0, pA1, alA, l_reg, pa0, pa1, pa2, pa3); SBAR();
    pv_tile<0>(o, vb0, pa0, pa1, pa2, pa3);
    if (even) { MASKT(pB0, pB1, NT - 1); partialSM(pB0, pB1, m_reg, mnB, alB); __syncthreads(); RESC(alB);
        finishSM(pB0, pB1, alB, l_reg, pa0, pa1, pa2, pa3); SBAR(); pv_tile<1>(o, vb0, pa0, pa1, pa2, pa3); }
    SBAR(); SEAM_K0();
    if (hi == 0) li_l[r32] = l_reg; asm volatile("s_waitcnt lgkmcnt(0)" ::: "memory");
    float rli[16];
#pragma unroll
    for (int r = 0; r < 16; ++r) rli[r] = __builtin_amdgcn_rcpf(li_l[crow(r, hi)]);
    bf16* Ow = cur.O + (size_t)(wid * QBLK) * DM;
#pragma unroll
    for (int r = 0; r < 16; ++r) { const int orow = crow(r, hi);
#pragma unroll
        for (int d0 = 0; d0 < 4; ++d0) { const float v = o[d0][r] * rli[r];
            const float vn = __shfl_xor(v, 1);
            if ((r32 & 1) == 0) *(unsigned*)(Ow + (size_t)orow * DM + d0 * 32 + r32) = cvtpk(v, vn); } }
    __syncthreads();
#undef RESC
#undef KBASE
#undef MASKT
#undef SEAM_K0
#undef HALF_STEP
}
#undef ROW
#undef VMW
#undef VMWN
#undef LD8
#undef SLOAD_H
#undef SWRITE_HK
#undef SWRITE_HV
#undef SWRITE_H
#undef KSWZ
#undef SBAR
}

#define XB_TMO      128
#define XB_XCNT(j)  (256  + 64 * (j))
#define XB_XSUB(j)  (1280 + 64 * (j))
#define XB_XGEN(j)  (2304 + 64 * (j))
#define XB_TOP      3328
#define XB_TOPGEN   3392
#define XCD_BAR_WORDS 3456
#define XB_SPIN_CAP (1u << 18)
__device__ __forceinline__ unsigned xb_ld(unsigned* p)              { return __hip_atomic_load(p, __ATOMIC_RELAXED, __HIP_MEMORY_SCOPE_AGENT); }
__device__ __forceinline__ unsigned xb_add(unsigned* p, unsigned v) { return __hip_atomic_fetch_add(p, v, __ATOMIC_RELAXED, __HIP_MEMORY_SCOPE_AGENT); }
__device__ __forceinline__ unsigned xb_xcc_id() { return (unsigned)__builtin_amdgcn_s_getreg((3 << 11) | 20) & 0xFu; }
#define XB_SPIN(cond, bar) do { unsigned _sp = 0; while (cond) { __builtin_amdgcn_s_sleep(1); \
    if ((++_sp & 255u) == 0u) { if (xb_ld(&(bar)[XB_TMO])) break; if (_sp > XB_SPIN_CAP) { atomicAdd(&(bar)[XB_TMO], 1u); break; } } } } while (0)
struct XcdBarrier { unsigned* bar; unsigned x; volatile LAS unsigned* st; };
__device__ __forceinline__ XcdBarrier xcd_barrier_post(unsigned* bar, volatile LAS unsigned* st) {
    XcdBarrier b; b.bar = bar; b.x = xb_xcc_id(); b.st = st;
    if (threadIdx.x == 0) (void)xb_add(&bar[XB_XCNT(b.x)], 1u);
    return b;
}
__device__ __forceinline__ void xcd_barrier_complete(unsigned* bar, unsigned x, unsigned& nloc, unsigned& nx) {
    const unsigned G = gridDim.x * gridDim.y * gridDim.z;
    unsigned sum, cnt, mine, sp = 0u;
    for (;;) {
        sum = 0u; cnt = 0u; mine = 0u;
#pragma unroll
        for (unsigned j = 0; j < 16; ++j) { const unsigned c = xb_ld(&bar[XB_XCNT(j)]); sum += c; cnt += (c > 0u) ? 1u : 0u; mine = (j == x) ? c : mine; }
        if (sum == G) break;
        __builtin_amdgcn_s_sleep(1);
        if ((++sp & 255u) == 0u) { if (xb_ld(&bar[XB_TMO])) break; if (sp > XB_SPIN_CAP) { atomicAdd(&bar[XB_TMO], 1u); break; } }
    }
    nloc = mine > 0u ? mine : 1u; nx = cnt > 0u ? cnt : 1u;
}
__device__ __forceinline__ void xcd_barrier(const XcdBarrier& b) {
    asm volatile("s_waitcnt vmcnt(0)" ::: "memory");
    __syncthreads();
    if (threadIdx.x == 0) {
        unsigned* bar = b.bar;
        __builtin_amdgcn_s_waitcnt(0);
        unsigned nloc = b.st[0], nx = b.st[1];
        if (nloc == 0u) { xcd_barrier_complete(bar, b.x, nloc, nx); b.st[0] = nloc; b.st[1] = nx; }
        const unsigned old = xb_add(&bar[XB_XSUB(b.x)], 1u);
        const unsigned gen = old / nloc;
        if (old + 1u == (gen + 1u) * nloc) {
            __builtin_amdgcn_fence(__ATOMIC_RELEASE, "agent");
            asm volatile("s_waitcnt vmcnt(0)" ::: "memory");
            const unsigned og = xb_add(&bar[XB_TOP], 1u);
            const unsigned tg = og / nx;
            if (og + 1u == (tg + 1u) * nx) xb_add(&bar[XB_TOPGEN], 1u);
            else XB_SPIN(xb_ld(&bar[XB_TOPGEN]) == tg, bar);
            __builtin_amdgcn_fence(__ATOMIC_ACQUIRE, "agent");
            xb_add(&bar[XB_XGEN(b.x)], 1u);
            asm volatile("s_waitcnt vmcnt(0)" ::: "memory");
        } else {
            XB_SPIN(xb_ld(&bar[XB_XGEN(b.x)]) == gen, bar);
            __builtin_amdgcn_fence(__ATOMIC_ACQUIRE, "agent");
            asm volatile("s_waitcnt vmcnt(0)" ::: "memory");
        }
    }
    __syncthreads();
}

struct Args { const float* in[17]; float* out; unsigned char* ws; int ph_lo, ph_hi; };
typedef const __attribute__((address_space(4))) Args* KArgP;
struct Frame {
    LAS unsigned char* lds; unsigned* ctl; unsigned char* ws;
    int tid, lane, wave, G, bx;
    KArgP ka;
};
#define INP(k) (F.ka->in[k])
__device__ __forceinline__ void phase_begin(Frame& F) {
    F.tid = ltid(); F.lane = F.tid & 63; F.wave = __builtin_amdgcn_readfirstlane(F.tid >> 6);
    KArgP p = (KArgP)__builtin_amdgcn_kernarg_segment_ptr(); asm volatile("" : "+s"(p)); F.ka = p;
}

struct EpiQKV {
    static constexpr bool PERM = true;
    bf16* qkv;
    __device__ __forceinline__ void operator()(const f32x4 (&acc)[2][2][4][2], const pg8::Unit& u, int wr, int wc, int fr, int fq) const {
        const int which = u.pn >> 2, hp = u.pn & 3, b = (u.pm * 256) >> 12, s0 = (u.pm * 256) & 4095;
#pragma unroll
        for (int ai = 0; ai < 2; ++ai)
#pragma unroll
            for (int m = 0; m < 4; ++m) { const int s = s0 + ai * 128 + wr * 64 + m * 16 + fr;
#pragma unroll
                for (int bj = 0; bj < 2; ++bj) { const int head = hp * 2 + bj;
                    bf16* dst = qkv + ((((size_t)(which * 4 + b) * 8 + head) * 4096 + s) * 128 + wc * 32 + 8 * fq);
                    const f32x4 v0 = acc[ai][bj][m][0], v1 = acc[ai][bj][m][1];
                    u32x4 w; w.x = cvt_pk_bf16(v0[0], v0[1]); w.y = cvt_pk_bf16(v0[2], v0[3]); w.z = cvt_pk_bf16(v1[0], v1[1]); w.w = cvt_pk_bf16(v1[2], v1[3]);
                    *(u32x4*)dst = w; } }
    }
};
struct EpiRes {
    static constexpr bool PERM = false;
    const float* x; float* out; bf16* xb;
    __device__ __forceinline__ void operator()(const f32x4 (&acc)[2][2][4][2], const pg8::Unit& u, int wr, int wc, int fr, int fq) const {
        const int row0 = u.pm * 256 + wr * 64 + fr, col0 = u.pn * 256 + wc * 32 + 4 * fq;
#pragma unroll
        for (int ai = 0; ai < 2; ++ai)
#pragma unroll
            for (int m = 0; m < 4; ++m) { const size_t off = (size_t)(row0 + ai * 128 + m * 16) * DM + col0;
#pragma unroll
                for (int bj = 0; bj < 2; ++bj)
#pragma unroll
                    for (int n = 0; n < 2; ++n) { const size_t o = off + bj * 128 + n * 16; const f32x4 v = *(const f32x4*)(x + o) + acc[ai][bj][m][n];
                        *(f32x4*)(out + o) = v; u32x2 w; w.x = cvt_pk_bf16(v[0], v[1]); w.y = cvt_pk_bf16(v[2], v[3]); *(u32x2*)(xb + o) = w; } }
    }
};
struct MoeOrder {
    int G, c, ncol; const LAS int* tt;
    __device__ __forceinline__ bool next(int i, pg8::Unit& u) const {
        const int nt = __builtin_amdgcn_readfirstlane(tt[0]); const long L = (long)i * G + c; if (L >= (long)nt * ncol) return false;
        const int t = (int)(L / ncol), pnl = (int)(L % ncol); const int e = __builtin_amdgcn_readfirstlane(tt[16 + t]) & 0xff;
        u.pm = t; u.pn = e * ncol + pnl; return true;
    }
};
struct MoeGather : MoeOrder {
    const int* list;
    __device__ __forceinline__ int arow(const pg8::Unit& u, int r) const {
        const int w = __builtin_amdgcn_readfirstlane(tt[16 + u.pm]); const int e = w & 0xff, rb = w >> 8; const int cnt = __builtin_amdgcn_readfirstlane(tt[256 + e]);
        const int pos = rb * 256 + r; int tok = 0; if (pos < cnt) tok = list[e * ECAP + pos]; return tok;
    }
};
struct MoePlain : MoeOrder { __device__ __forceinline__ int arow(const pg8::Unit&, int) const { return 0; } };
struct EpiHid {
    static constexpr bool PERM = true;
    bf16* hid; const float* rsr; const float* rsw; const LAS int* tt;
    __device__ __forceinline__ void operator()(const f32x4 (&acc)[2][2][4][2], const pg8::Unit& u, int wr, int wc, int fr, int fq) const {
        const int w = __builtin_amdgcn_readfirstlane(tt[16 + u.pm]); const int e = w & 0xff, rb = w >> 8, pnl = u.pn & 3; const int cnt = __builtin_amdgcn_readfirstlane(tt[256 + e]);
#pragma unroll
        for (int ai = 0; ai < 2; ++ai)
#pragma unroll
            for (int m = 0; m < 4; ++m) { const int r = ai * 128 + wr * 64 + m * 16 + fr, pos = rb * 256 + r; float rs = 0.f, cw = 0.f;
                if (pos < cnt) { rs = rsr[e * ECAP + pos]; cw = rsw[e * ECAP + pos]; }
                float o[8];
#pragma unroll
                for (int n = 0; n < 2; ++n)
#pragma unroll
                    for (int j = 0; j < 4; ++j) { const float gv = acc[ai][0][m][n][j] * rs, uv = acc[ai][1][m][n][j] * rs; o[n * 4 + j] = gv / (1.f + __expf(-gv)) * uv * cw; }
                u32x4 pk; pk.x = cvt_pk_bf16(o[0], o[1]); pk.y = cvt_pk_bf16(o[2], o[3]); pk.z = cvt_pk_bf16(o[4], o[5]); pk.w = cvt_pk_bf16(o[6], o[7]);
                *(u32x4*)(hid + (size_t)(u.pm * 256 + r) * DE + pnl * 128 + wc * 32 + 8 * fq) = pk; }
    }
};
struct EpiY {
    static constexpr bool PERM = true;
    bf16* y;
    __device__ __forceinline__ void operator()(const f32x4 (&acc)[2][2][4][2], const pg8::Unit& u, int wr, int wc, int fr, int fq) const {
        const int pnl = u.pn & 7;
#pragma unroll
        for (int ai = 0; ai < 2; ++ai)
#pragma unroll
            for (int m = 0; m < 4; ++m) { bf16* rowp = y + (size_t)(u.pm * 256 + ai * 128 + wr * 64 + m * 16 + fr) * DM + pnl * 256 + wc * 32 + 8 * fq;
#pragma unroll
                for (int bj = 0; bj < 2; ++bj) { const f32x4 v0 = acc[ai][bj][m][0], v1 = acc[ai][bj][m][1];
                    u32x4 w; w.x = cvt_pk_bf16(v0[0], v0[1]); w.y = cvt_pk_bf16(v0[2], v0[3]); w.z = cvt_pk_bf16(v1[0], v1[1]); w.w = cvt_pk_bf16(v1[2], v1[3]);
                    *(u32x4*)(rowp + bj * 128) = w; } }
    }
};

__device__ __forceinline__ void tr_item(const float* src, int ldw, const float* gs, bf16* dst, int ldd, LAS float* scr, int lane) {
#pragma unroll 8
    for (int i = 0; i < 32; ++i) { const int kk = 2 * i + (lane >> 5); scr[kk * 33 + (lane & 31)] = src[(size_t)kk * ldw + (lane & 31)]; }
    const int c = lane & 7;
    f32x4 g0 = (f32x4){1.f, 1.f, 1.f, 1.f}, g1 = g0;
    if (gs) { g0 = *(const f32x4*)(gs + 8 * c); g1 = *(const f32x4*)(gs + 8 * c + 4); }
    LDS_WAIT(); asm volatile("" ::: "memory");
#pragma unroll
    for (int j = 0; j < 4; ++j) { const int n = (lane >> 3) + 8 * j; const LAS float* s = scr + (8 * c) * 33 + n;
        u32x4 o; o.x = cvt_pk_bf16(s[0 * 33] * g0[0], s[1 * 33] * g0[1]); o.y = cvt_pk_bf16(s[2 * 33] * g0[2], s[3 * 33] * g0[3]);
        o.z = cvt_pk_bf16(s[4 * 33] * g1[0], s[5 * 33] * g1[1]); o.w = cvt_pk_bf16(s[6 * 33] * g1[2], s[7 * 33] * g1[3]);
        *(u32x4*)(dst + (size_t)n * ldd + 8 * c) = o; }
    LDS_WAIT(); asm volatile("" ::: "memory");
}
__device__ __forceinline__ void p0_prologue(Frame& F) {
    const float* x = INP(0); const float* g_attn = INP(1); const float* w_in = INP(2); const float* b_forget = INP(3);
    const float* g_fox = INP(4); const float* g_moba = INP(5); const float* w_out = INP(7); const float* g_ffn = INP(8);
    const float* w_gr = INP(9); const float* w_er = INP(11); const float* w_gate = INP(13); const float* w_up = INP(14); const float* w_down = INP(15);
    bf16* Wqkv = (bf16*)(F.ws + WS_WQKV); bf16* Wo = (bf16*)(F.ws + WS_WO); bf16* Wgu = (bf16*)(F.ws + WS_WGU); bf16* Wd = (bf16*)(F.ws + WS_WD); bf16* Wr = (bf16*)(F.ws + WS_WR);
    bf16* Hb = (bf16*)(F.ws + WS_A); float* lf = (float*)(F.ws + WS_LF);
    LAS float* scr = (LAS float*)(F.lds + RING_OFF + F.wave * 8704);
    LAS float* wfgT = (LAS float*)(F.lds + RING_OFF + 8 * 8704);
    const int gw = F.bx * NWAVES + F.wave, NGW = F.G * NWAVES;
    for (int idx = F.tid; idx < 2048 * 8; idx += NTHR) { const int k = idx >> 3, hh = idx & 7; wfgT[hh * 2048 + k] = w_in[(size_t)k * WIN_LD + NQKV + hh] * g_attn[k]; }
    constexpr int I_IN = 32 * 192, I_O = 32 * 64, I_G = 16 * 32 * 16, I_D = 16 * 8 * 64, NITEMS = I_IN + I_O + 2 * I_G + I_D;
    for (int it = gw; it < NITEMS; it += NGW) {
        int r = it;
        if (r < I_IN) { const int kb = r / 192, nb = r % 192; tr_item(w_in + (size_t)(64 * kb) * WIN_LD + 32 * nb, WIN_LD, g_attn + 64 * kb, Wqkv + (size_t)(32 * nb) * DM + 64 * kb, DM, scr, F.lane); continue; } r -= I_IN;
        if (r < I_O) { const int kb = r / 64, nb = r % 64; const int k0 = 64 * kb; const float* gs = (k0 < GWID) ? g_fox + k0 : g_moba + (k0 - GWID);
            tr_item(w_out + (size_t)k0 * DM + 32 * nb, DM, gs, Wo + (size_t)(32 * nb) * DM + k0, DM, scr, F.lane); continue; } r -= I_O;
        if (r < 2 * I_G) { const int up = r >= I_G; if (up) r -= I_G; const int e = r / 512, rr = r % 512, kb = rr / 16, nb = rr % 16; const int f0 = 32 * nb, tt = f0 >> 7, within = f0 & 127;
            const float* W = (up ? w_up : w_gate) + (size_t)e * DM * DE;
            tr_item(W + (size_t)(64 * kb) * DE + f0, DE, g_ffn + 64 * kb, Wgu + ((size_t)e * 1024 + tt * 256 + up * 128 + within) * DM + 64 * kb, DM, scr, F.lane); continue; } r -= 2 * I_G;
        { const int e = r / 512, rr = r % 512, kb = rr / 64, nb = rr % 64;
            tr_item(w_down + (size_t)e * DE * DM + (size_t)(64 * kb) * DM + 32 * nb, DM, nullptr, Wd + ((size_t)e * DM + 32 * nb) * DE + 64 * kb, DE, scr, F.lane); }
    }
    for (int idx = (F.bx * NTHR + F.tid); idx < NRC * DM; idx += F.G * NTHR) { const int n = idx >> 11, k = idx & 2047;
        float v = 0.f; if (n < 4) v = w_gr[k * 4 + n]; else if (n < 20) v = w_er[k * 16 + (n - 4)];
        Wr[idx] = (bf16)(cvt_pk_bf16(v * g_ffn[k], 0.f) & 0xffffu); }
    __syncthreads();
    for (int m = gw; m < T; m += NGW) {
        const f32x4* xr = (const f32x4*)(x + (size_t)m * DM) + F.lane;
        f32x4 v[8]; float ss = 0.f;
#pragma unroll
        for (int j = 0; j < 8; ++j) { v[j] = xr[64 * j]; ss += (v[j][0] * v[j][0] + v[j][1] * v[j][1]) + (v[j][2] * v[j][2] + v[j][3] * v[j][3]); }
        float fl[8];
#pragma unroll
        for (int hh = 0; hh < 8; ++hh) { float a = 0.f;
#pragma unroll
            for (int j = 0; j < 8; ++j) { const f32x4 w = *(const LAS f32x4*)(wfgT + hh * 2048 + 256 * j + 4 * F.lane); a += (v[j][0] * w[0] + v[j][1] * w[1]) + (v[j][2] * w[2] + v[j][3] * w[3]); }
            fl[hh] = a; }
        ss = wave_sum(ss); const float rstd = 1.0f / sqrtf(ss * (1.0f / DM) + EPS);
#pragma unroll
        for (int hh = 0; hh < 8; ++hh) fl[hh] = wave_sum(fl[hh]) * rstd;
        u32x2* o8 = (u32x2*)(Hb + (size_t)m * DM) + F.lane;
#pragma unroll
        for (int j = 0; j < 8; ++j) { u32x2 w; w.x = cvt_pk_bf16(v[j][0] * rstd, v[j][1] * rstd); w.y = cvt_pk_bf16(v[j][2] * rstd, v[j][3] * rstd); o8[64 * j] = w; }
        if (F.lane < 8) { float z = fl[0];
#pragma unroll
            for (int hh = 1; hh < 8; ++hh) z = (F.lane == hh) ? fl[hh] : z;
            z += b_forget[F.lane];
            const float ls = fminf(z, 0.f) - log1pf(expf(-fabsf(z)));
            const int b = m >> 12, s = m & 4095; lf[(size_t)(b * 8 + F.lane) * SEQ + s] = ls; }
    }
}

__device__ __forceinline__ void p2_kmean_cumsum(Frame& F) {
    const bf16* mk = (const bf16*)(F.ws + WS_QKV) + (size_t)4 * 32 * SEQ * HD;
    bf16* kmean = (bf16*)(F.ws + WS_KMEAN);
    LAS float* part = (LAS float*)(F.lds + RING_OFF);
    for (int item = F.bx; item < 512; item += F.G) {
        const bf16* base = mk + ((size_t)item * 256 + F.wave * 32) * HD + 2 * F.lane;
        float a0 = 0.f, a1 = 0.f;
#pragma unroll 8
        for (int r = 0; r < 32; ++r) { const unsigned w = *(const unsigned*)(base + (size_t)r * HD); a0 += bflo(w); a1 += bfhi(w); }
        part[F.wave * 128 + 2 * F.lane] = a0; part[F.wave * 128 + 2 * F.lane + 1] = a1;
        __syncthreads();
        if (F.tid < 128) { float s = 0.f;
#pragma unroll
            for (int w = 0; w < 8; ++w) s += part[w * 128 + F.tid];
            kmean[(size_t)item * 128 + F.tid] = (bf16)(cvt_pk_bf16(s * (1.0f / 256.0f), 0.f) & 0xffffu); }
        __syncthreads();
    }
    if (F.bx < 32 && F.wave == 0) {
        const float* src = (const float*)(F.ws + WS_LF) + (size_t)F.bx * SEQ + 64 * F.lane; float* dst = (float*)(F.ws + WS_C) + (size_t)F.bx * SEQ + 64 * F.lane;
        f32x4 v[16]; float run = 0.f;
#pragma unroll
        for (int j = 0; j < 16; ++j) { v[j] = *(const f32x4*)(src + 4 * j);
            v[j][0] += run; v[j][1] += v[j][0]; v[j][2] += v[j][1]; v[j][3] += v[j][2]; run = v[j][3]; }
        float incl = run;
#pragma unroll
        for (int o = 1; o < 64; o <<= 1) { const float t = __shfl_up(incl, o); if (F.lane >= o) incl += t; }
        const float excl = incl - run;
#pragma unroll
        for (int j = 0; j < 16; ++j) { f32x4 w = v[j]; w[0] += excl; w[1] += excl; w[2] += excl; w[3] += excl; *(f32x4*)(dst + 4 * j) = w; }
    }
}

__device__ __forceinline__ void p4_outnorm(Frame& F) {
    bf16* AO = (bf16*)(F.ws + WS_A);
    const int gw = F.bx * NWAVES + F.wave, NGW = F.G * NWAVES;
    for (int m = gw; m < T; m += NGW) {
        u32x4* rp = (u32x4*)(AO + (size_t)m * DM) + F.lane;
        u32x4 v[4]; float ss[2] = {0.f, 0.f};
#pragma unroll
        for (int j = 0; j < 4; ++j) { v[j] = rp[64 * j];
#pragma unroll
            for (int q = 0; q < 4; ++q) { const float a = bflo(v[j][q]), b = bfhi(v[j][q]); ss[j >> 1] += a * a + b * b; } }
        const float r0 = 1.0f / sqrtf(wave_sum(ss[0]) * (1.0f / GWID) + EPS), r1 = 1.0f / sqrtf(wave_sum(ss[1]) * (1.0f / GWID) + EPS);
#pragma unroll
        for (int j = 0; j < 4; ++j) { const float r = (j < 2) ? r0 : r1; u32x4 o;
#pragma unroll
            for (int q = 0; q < 4; ++q) o[q] = cvt_pk_bf16(bflo(v[j][q]) * r, bfhi(v[j][q]) * r);
            rp[64 * j] = o; }
    }
}

__device__ __forceinline__ void p6_route(Frame& F) {
    const bf16* xb = (const bf16*)(F.ws + WS_XB); const bf16* Wr = (const bf16*)(F.ws + WS_WR);
    const float* bg = INP(10); const float* be = INP(12);
    int* tokrec = (int*)(F.ws + WS_TOKREC); int* list = (int*)(F.ws + WS_LIST); float* rsr = (float*)(F.ws + WS_RSR); float* rsw = (float*)(F.ws + WS_RSW);
    unsigned* gcnt = F.ctl + CW_GCNT;
    LAS float* part = (LAS float*)(F.lds + RING_OFF);
    LAS float* ssq = part + 2 * 64 * 32;
    LAS int* lcnt = (LAS int*)(ssq + 128);
    LAS int* lbase = lcnt + 16;
    const int fr = F.lane & 15, fq = F.lane >> 4, mt = F.wave & 3, kh = F.wave >> 2;
    for (int blk = F.bx; blk < T / 64; blk += F.G) {
        const int tok0 = blk * 64;
        if (F.tid < 16) lcnt[F.tid] = 0;
        const bf16* pa = xb + (size_t)(tok0 + 16 * mt + fr) * DM + 1024 * kh + 8 * fq;
        const bf16* pb0 = Wr + (size_t)fr * DM + 1024 * kh + 8 * fq; const bf16* pb1 = pb0 + (size_t)16 * DM;
        f32x4 acc0 = (f32x4){0.f, 0.f, 0.f, 0.f}, acc1 = acc0; float sq = 0.f;
#pragma unroll 4
        for (int s = 0; s < 32; ++s) { const bf16x8 a = *(const bf16x8*)(pa + 32 * s), b0 = *(const bf16x8*)(pb0 + 32 * s), b1 = *(const bf16x8*)(pb1 + 32 * s);
#pragma unroll
            for (int j = 0; j < 8; ++j) { const float f = bf2f((unsigned short)a[j]); sq += f * f; }
            acc0 = __builtin_amdgcn_mfma_f32_16x16x32_bf16(a, b0, acc0, 0, 0, 0); acc1 = __builtin_amdgcn_mfma_f32_16x16x32_bf16(a, b1, acc1, 0, 0, 0); }
        sq += __shfl_xor(sq, 16); sq += __shfl_xor(sq, 32);
#pragma unroll
        for (int i = 0; i < 4; ++i) { part[(kh * 64 + 16 * mt + 4 * fq + i) * 32 + fr] = acc0[i]; part[(kh * 64 + 16 * mt + 4 * fq + i) * 32 + 16 + fr] = acc1[i]; }
        if (fq == 0) ssq[kh * 64 + 16 * mt + fr] = sq;
        __syncthreads();
        int e1 = 0, e2 = 0, rk1 = 0, rk2 = 0; float w1 = 0.f, w2 = 0.f, rstd = 0.f;
        if (F.tid < 64) { const int t = F.tid;
            rstd = 1.0f / sqrtf((ssq[t] + ssq[64 + t]) * (1.0f / DM) + EPS);
            float gl[4]; int grp = 0;
#pragma unroll
            for (int j = 0; j < 4; ++j) gl[j] = (part[t * 32 + j] + part[(64 + t) * 32 + j]) * rstd + bg[j];
#pragma unroll
            for (int j = 1; j < 4; ++j) if (gl[j] > gl[grp]) grp = j;
            float gmax = gl[0];
#pragma unroll
            for (int j = 1; j < 4; ++j) gmax = fmaxf(gmax, gl[j]);
            float gden = 0.f;
#pragma unroll
            for (int j = 0; j < 4; ++j) gden += expf(gl[j] - gmax);
            const float pgrp = 1.0f / gden;
            float el[4];
#pragma unroll
            for (int j = 0; j < 4; ++j) el[j] = (part[t * 32 + 4 + 4 * grp + j] + part[(64 + t) * 32 + 4 + 4 * grp + j]) * rstd + be[4 * grp + j];
            int i1 = 0;
#pragma unroll
            for (int j = 1; j < 4; ++j) if (el[j] > el[i1]) i1 = j;
            int i2 = (i1 == 0) ? 1 : 0;
#pragma unroll
            for (int j = 0; j < 4; ++j) if (j != i1 && j != i2 && el[j] > el[i2]) i2 = j;
            const float p2 = expf(el[i2] - el[i1]);
            w1 = pgrp / (1.0f + p2); w2 = pgrp * p2 / (1.0f + p2);
            e1 = 4 * grp + i1; e2 = 4 * grp + i2;
            rk1 = __hip_atomic_fetch_add(&lcnt[e1], 1, __ATOMIC_RELAXED, __HIP_MEMORY_SCOPE_WORKGROUP); rk2 = __hip_atomic_fetch_add(&lcnt[e2], 1, __ATOMIC_RELAXED, __HIP_MEMORY_SCOPE_WORKGROUP);
        }
        __syncthreads();
        if (F.tid < 16) lbase[F.tid] = (int)__hip_atomic_fetch_add(gcnt + F.tid, (unsigned)lcnt[F.tid], __ATOMIC_RELAXED, __HIP_MEMORY_SCOPE_AGENT);
        __syncthreads();
        if (F.tid < 64) { const int tok = tok0 + F.tid; const int p1 = lbase[e1] + rk1, p2 = lbase[e2] + rk2;
            list[e1 * ECAP + p1] = tok; rsr[e1 * ECAP + p1] = rstd; rsw[e1 * ECAP + p1] = w1;
            list[e2 * ECAP + p2] = tok; rsr[e2 * ECAP + p2] = rstd; rsw[e2 * ECAP + p2] = w2;
            int4 rec; rec.x = e1; rec.y = p1; rec.z = e2; rec.w = p2; *(int4*)(tokrec + 4 * tok) = rec; }
        __syncthreads();
    }
}
__device__ __forceinline__ void moe_table(Frame& F) {
    LAS int* tt = (LAS int*)(F.lds + XTRA_OFF);
    if (F.tid == 0) { int t = 0;
        for (int e = 0; e < NE; ++e) { int c = (int)F.ctl[CW_GCNT + e]; if (c > ECAP) c = ECAP; if (c < 0) c = 0; tt[256 + e] = c; tt[288 + e] = t; const int n = (c + 255) >> 8;
            for (int rb = 0; rb < n && t < MAXTILES; ++rb) tt[16 + t++] = e | (rb << 8); }
        tt[0] = t; }
    __syncthreads();
}

__device__ __forceinline__ void p9_final(Frame& F) {
    const LAS int* tt = (const LAS int*)(F.lds + XTRA_OFF);
    const int* tokrec = (const int*)(F.ws + WS_TOKREC); const bf16* Y = (const bf16*)(F.ws + WS_Y); const float* gfin = INP(16);
    const int gw = F.bx * NWAVES + F.wave, NGW = F.G * NWAVES;
    for (int m = gw; m < T; m += NGW) {
        const int4 rec = *(const int4*)(tokrec + 4 * m);
        const int e1 = __builtin_amdgcn_readfirstlane(rec.x), p1 = __builtin_amdgcn_readfirstlane(rec.y), e2 = __builtin_amdgcn_readfirstlane(rec.z), p2 = __builtin_amdgcn_readfirstlane(rec.w);
        const size_t r1 = (size_t)tt[288 + (e1 & 15)] * 256 + p1, r2 = (size_t)tt[288 + (e2 & 15)] * 256 + p2;
        f32x4* xr = (f32x4*)(F.ka->out + (size_t)m * DM) + F.lane; const u32x2* y1 = (const u32x2*)(Y + r1 * DM) + F.lane; const u32x2* y2 = (const u32x2*)(Y + r2 * DM) + F.lane;
        f32x4 v[8]; float ss = 0.f;
#pragma unroll
        for (int j = 0; j < 8; ++j) { v[j] = xr[64 * j]; const u32x2 a = y1[64 * j], b = y2[64 * j];
            v[j][0] += bflo(a.x) + bflo(b.x); v[j][1] += bfhi(a.x) + bfhi(b.x); v[j][2] += bflo(a.y) + bflo(b.y); v[j][3] += bfhi(a.y) + bfhi(b.y);
            ss += (v[j][0] * v[j][0] + v[j][1] * v[j][1]) + (v[j][2] * v[j][2] + v[j][3] * v[j][3]); }
        const float rstd = 1.0f / sqrtf(wave_sum(ss) * (1.0f / DM) + EPS);
#pragma unroll
        for (int j = 0; j < 8; ++j) { const f32x4 g = *((const f32x4*)gfin + 64 * j + F.lane); f32x4 o; o[0] = v[j][0] * rstd * g[0]; o[1] = v[j][1] * rstd * g[1]; o[2] = v[j][2] * rstd * g[2]; o[3] = v[j][3] * rstd * g[3]; xr[64 * j] = o; }
    }
}

constexpr int NPHASE = 10;
__global__ void __launch_bounds__(NTHR, 2) fwd(Args args) {
    extern __shared__ __attribute__((aligned(16))) unsigned char lds_raw[];
    Frame F;
    F.lds = (LAS unsigned char*)lds_raw; F.ws = args.ws; F.ctl = (unsigned*)(args.ws + WS_CTL);
    F.G = gridDim.x; F.bx = blockIdx.x; phase_begin(F);
    for (int u = F.tid; u < 256; u += NTHR) ((LAS unsigned*)(F.lds + LCTL_OFF))[u] = 0u;
    __syncthreads();
    const int lo = args.ph_lo, hi = args.ph_hi;
    const bool multi = (hi - lo) > 1;
    XcdBarrier bar; bar.bar = F.ctl + CW_BAR; bar.x = 0; bar.st = (volatile LAS unsigned*)(F.lds + LCTL_OFF);
    if (multi) bar = xcd_barrier_post(F.ctl + CW_BAR, (volatile LAS unsigned*)(F.lds + LCTL_OFF));
#define IN(k) (lo <= (k) && (k) < hi)
#define SEAM(k) do { if (IN(k) && IN((k) + 1)) xcd_barrier(bar); } while (0)

    if (IN(0)) { phase_begin(F); p0_prologue(F); } SEAM(0);
    if (IN(1)) { phase_begin(F);
        pg8::Gemm g{(const bf16*)(F.ws + WS_A), (const bf16*)(F.ws + WS_WQKV), T, NQKV, DM}; pg8::StaticOrder S; S.init(T, NQKV, F.G, F.bx);
        EpiQKV E{(bf16*)(F.ws + WS_QKV)};
        pg8::gemm_phase<EpiQKV, pg8::StaticOrder, true, false>(F.lds + RING_OFF, g, S, E);
    } SEAM(1);
    if (IN(2)) { phase_begin(F); p2_kmean_cumsum(F); } SEAM(2);
    if (IN(3)) { phase_begin(F);
        static_assert(att::LDS_ATT <= RING_BYTES, "attention LDS");
        const bf16* qkv = (const bf16*)(F.ws + WS_QKV); bf16* AO = (bf16*)(F.ws + WS_A);
        const float* cbuf = (const float*)(F.ws + WS_C); const bf16* kmean = (const bf16*)(F.ws + WS_KMEAN); const float* relb = INP(6);
#define MKREF(R, grp, bh_, qb_) do { const int _bh = (bh_), _qb = (qb_), _g = (grp); \
            R.Q = qkv + ((size_t)(_g * 3 + 0) * 32 + _bh) * SEQ * HD + (size_t)_qb * 256 * HD; R.K = qkv + ((size_t)(_g * 3 + 1) * 32 + _bh) * SEQ * HD; R.V = qkv + ((size_t)(_g * 3 + 2) * 32 + _bh) * SEQ * HD; \
            R.O = AO + ((size_t)(_bh >> 3) * SEQ + _qb * 256) * DM + _g * GWID + (_bh & 7) * HD; R.P0 = _qb * 256; R.bh = _bh; } while (0)
        const int vcu = (F.G % 8 == 0) ? (F.bx % 8) * (F.G / 8) + F.bx / 8 : F.bx;
        att::Seam S; att::BlockRef cur, nxt;
        if (vcu < 256) { MKREF(cur, 0, vcu >> 3, vcu & 7); att::attn_prime(cur, (char*)lds_raw + RING_OFF, S); }
        for (int L = vcu; L < 256; L += F.G) {
            const int bh = L >> 3, s = L & 7; const bool more = (L + F.G) < 256; const int Ln = more ? L + F.G : L;
#pragma nounroll
            for (int u = 0; u < 2; ++u) {
                MKREF(cur, 0, bh, u ? 15 - s : s); if (u == 0) MKREF(nxt, 0, bh, 15 - s); else MKREF(nxt, 1, bh, s);
#ifndef NO_M0
                att::attn_block<0>(cur, nxt, F.lds + RING_OFF, S, cbuf, kmean, relb);
#endif
            }
#pragma nounroll
            for (int u = 0; u < 2; ++u) {
                MKREF(cur, 1, bh, u ? 15 - s : s); if (u == 0) MKREF(nxt, 1, bh, 15 - s); else if (more) MKREF(nxt, 0, Ln >> 3, Ln & 7); else nxt = cur;
#ifndef NO_M1
                att::attn_block<1>(cur, nxt, F.lds + RING_OFF, S, cbuf, kmean, relb);
#endif
            }
        }
#undef MKREF
    } SEAM(3);
    if (IN(4)) { phase_begin(F); p4_outnorm(F); } SEAM(4);
    if (IN(5)) { phase_begin(F);
        pg8::Gemm g{(const bf16*)(F.ws + WS_A), (const bf16*)(F.ws + WS_WO), T, DM, DM}; pg8::StaticOrder S; S.init(T, DM, F.G, F.bx);
        EpiRes E{INP(0), F.ka->out, (bf16*)(F.ws + WS_XB)};
        pg8::gemm_phase<EpiRes, pg8::StaticOrder, true, false>(F.lds + RING_OFF, g, S, E);
    } SEAM(5);
    if (IN(6)) { phase_begin(F); p6_route(F); } SEAM(6);
    if (IN(7)) { phase_begin(F);
        moe_table(F);
        const LAS int* tt = (const LAS int*)(F.lds + XTRA_OFF);
        pg8::Gemm g{(const bf16*)(F.ws + WS_XB), (const bf16*)(F.ws + WS_WGU), MAXTILES * 256, NE * 1024, DM};
        MoeGather S; S.G = F.G; S.c = F.bx; S.ncol = 4; S.tt = tt; S.list = (const int*)(F.ws + WS_LIST);
        EpiHid E{(bf16*)(F.ws + WS_A), (const float*)(F.ws + WS_RSR), (const float*)(F.ws + WS_RSW), tt};
        pg8::gemm_phase<EpiHid, MoeGather, true, true>(F.lds + RING_OFF, g, S, E);
    } SEAM(7);
    if (IN(8)) { phase_begin(F);
        moe_table(F);
        const LAS int* tt = (const LAS int*)(F.lds + XTRA_OFF);
        pg8::Gemm g{(const bf16*)(F.ws + WS_A), (const bf16*)(F.ws + WS_WD), MAXTILES * 256, NE * DM, DE};
        MoePlain S; S.G = F.G; S.c = F.bx; S.ncol = 8; S.tt = tt;
        EpiY E{(bf16*)(F.ws + WS_Y)};
        pg8::gemm_phase<EpiY, MoePlain, true, false>(F.lds + RING_OFF, g, S, E);
    } SEAM(8);
    if (IN(9)) { phase_begin(F); moe_table(F); p9_final(F); }
#undef IN
#undef SEAM
}

template <int MODE>
__global__ void __launch_bounds__(256) naive_attn(unsigned char* ws, const float* rel_bias) {
    const bf16* qkv = (const bf16*)(ws + WS_QKV); const float* cbuf = (const float*)(ws + WS_C); const bf16* kmean = (const bf16*)(ws + WS_KMEAN); bf16* AO = (bf16*)(ws + WS_A);
    __shared__ float qs[16][128]; __shared__ float sc[16][256]; __shared__ float gsc[16][16]; __shared__ unsigned selm[16]; __shared__ float lut[132];
    const int t = threadIdx.x, bh = blockIdx.y, b = bh >> 3, h = bh & 7, i0 = blockIdx.x * 16;
    const bf16* Q = qkv + ((size_t)(MODE * 3 + 0) * 32 + bh) * SEQ * HD; const bf16* Kp = qkv + ((size_t)(MODE * 3 + 1) * 32 + bh) * SEQ * HD; const bf16* Vp = qkv + ((size_t)(MODE * 3 + 2) * 32 + bh) * SEQ * HD;
    for (int i = t; i < 16 * 128; i += 256) qs[i >> 7][i & 127] = bf2f(Q[(size_t)(i0 + (i >> 7)) * HD + (i & 127)]);
    const int own = i0 >> 8;
    if (MODE == 1) { for (int d = t; d < 129; d += 256) { int bk; if (d < 16) bk = d; else { bk = 16 + (int)(logf((float)d / 16.0f) / 2.0794415416798357f * 16.0f); if (bk > 31) bk = 31; } lut[d] = rel_bias[h * 32 + bk]; } }
    __syncthreads();
    if (MODE == 1) {
        const int q = t >> 4, n = t & 15; float g = -1e30f;
        if (n < own) { g = 0.f; const bf16* km = kmean + ((size_t)bh * 16 + n) * 128; for (int d = 0; d < 128; ++d) g += qs[q][d] * bf2f(km[d]); }
        gsc[q][n] = g;
        __syncthreads();
        if (t < 16) { unsigned m = 0; const int nsel = own < 3 ? own : 3;
            for (int k = 0; k < nsel; ++k) { int best = -1; float bv = 0.f; for (int n2 = 0; n2 < own; ++n2) if (!((m >> n2) & 1u) && (best < 0 || gsc[t][n2] > bv)) { best = n2; bv = gsc[t][n2]; } if (best >= 0) m |= 1u << best; }
            selm[t] = m; }
        __syncthreads();
    }
    const int q = t >> 4, dg = t & 15;
    float o[8]; for (int c = 0; c < 8; ++c) o[c] = 0.f;
    float mrun = -1e30f, lrun = 0.f;
    const float scale = 0.08838834764831845f;
    const int nch = own + 1;
    for (int ch = 0; ch < nch; ++ch) {
        const int j = ch * 256 + t;
        float kr[128];
        { const u32x4* kp = (const u32x4*)(Kp + (size_t)j * HD);
#pragma unroll
          for (int c = 0; c < 16; ++c) { const u32x4 w = kp[c]; kr[8 * c + 0] = bflo(w.x); kr[8 * c + 1] = bfhi(w.x); kr[8 * c + 2] = bflo(w.y); kr[8 * c + 3] = bfhi(w.y); kr[8 * c + 4] = bflo(w.z); kr[8 * c + 5] = bfhi(w.z); kr[8 * c + 6] = bflo(w.w); kr[8 * c + 7] = bfhi(w.w); } }
        const float cj = (MODE == 0) ? cbuf[(size_t)bh * SEQ + j] : 0.f;
        for (int qq = 0; qq < 16; ++qq) { const int i = i0 + qq; float s = 0.f;
#pragma unroll
            for (int d = 0; d < 128; ++d) s += qs[qq][d] * kr[d];
            s *= scale; bool ok;
            if (MODE == 0) { s += cbuf[(size_t)bh * SEQ + i] - cj; ok = j <= i; }
            else { const int dd = i - j; s += lut[dd < 0 ? 0 : (dd > 128 ? 128 : dd)]; ok = (ch == own) ? (j <= i) : (((selm[qq] >> ch) & 1u) != 0u); }
            sc[qq][t] = ok ? s : -__builtin_inff(); }
        __syncthreads();
        float cm = -__builtin_inff();
        for (int c = 0; c < 16; ++c) cm = fmaxf(cm, sc[q][dg + 16 * c]);
#pragma unroll
        for (int off = 1; off < 16; off <<= 1) cm = fmaxf(cm, __shfl_xor(cm, off));
        const float mnew = fmaxf(mrun, cm), alpha = expf(mrun - mnew);
        float ps = 0.f; float pv[16];
        for (int c = 0; c < 16; ++c) { pv[c] = expf(sc[q][dg + 16 * c] - mnew); ps += pv[c]; }
#pragma unroll
        for (int off = 1; off < 16; off <<= 1) ps += __shfl_xor(ps, off);
        lrun = lrun * alpha + ps; mrun = mnew;
        __syncthreads();
        for (int c = 0; c < 16; ++c) sc[q][dg + 16 * c] = pv[c];
        __syncthreads();
        for (int c = 0; c < 8; ++c) o[c] *= alpha;
        for (int jj = 0; jj < 256; ++jj) { const float p = sc[q][jj]; const u32x4 w = *(const u32x4*)(Vp + (size_t)(ch * 256 + jj) * HD + 8 * dg);
            o[0] += p * bflo(w.x); o[1] += p * bfhi(w.x); o[2] += p * bflo(w.y); o[3] += p * bfhi(w.y); o[4] += p * bflo(w.z); o[5] += p * bfhi(w.z); o[6] += p * bflo(w.w); o[7] += p * bfhi(w.w); }
        __syncthreads();
    }
    const float il = 1.0f / lrun;
    u32x4 w; w.x = cvt_pk_bf16(o[0] * il, o[1] * il); w.y = cvt_pk_bf16(o[2] * il, o[3] * il); w.z = cvt_pk_bf16(o[4] * il, o[5] * il); w.w = cvt_pk_bf16(o[6] * il, o[7] * il);
    *(u32x4*)(AO + (size_t)(b * SEQ + i0 + q) * DM + MODE * GWID + h * HD + 8 * dg) = w;
}

extern "C" void kernel_launch(void* const* d_in, const int* in_sizes, int n_in, void* d_out, int out_size, void* d_ws, size_t ws_size, hipStream_t stream) {
    static int grid = 0;
    if (grid == 0) {
        if (n_in != 17 || out_size != T * DM || ws_size < WS_END) { fprintf(stderr, "kernel_launch: unexpected shapes (n_in %d out %d ws %zu)\n", n_in, out_size, ws_size); grid = -1; return; }
        int dev = 0, cus = 0;
        if (hipGetDevice(&dev) != hipSuccess || hipDeviceGetAttribute(&cus, hipDeviceAttributeMultiprocessorCount, dev) != hipSuccess) { grid = -1; return; }
        if (hipFuncSetAttribute((const void*)fwd, hipFuncAttributeMaxDynamicSharedMemorySize, LDS_BYTES) != hipSuccess) { fprintf(stderr, "kernel_launch: hipFuncSetAttribute failed\n"); grid = -1; return; }
        int per_cu = 0;
        if (hipOccupancyMaxActiveBlocksPerMultiprocessor(&per_cu, (const void*)fwd, NTHR, LDS_BYTES) != hipSuccess || per_cu < 1) fprintf(stderr, "kernel_launch: occupancy query reports %d\n", per_cu);
        (void)hipGetLastError();
        grid = cus > 0 ? cus : 256;
    }
    if (grid < 0) return;
    (void)hipMemsetAsync((char*)d_ws + WS_CTL, 0, CTL_ZERO_BYTES, stream);
    Args a{};
    for (int i = 0; i < 17; ++i) a.in[i] = (const float*)d_in[i];
    a.out = (float*)d_out; a.ws = (unsigned char*)d_ws;
#ifdef MK_PER_PHASE
    for (int ph = 0; ph < NPHASE; ++ph) { a.ph_lo = ph; a.ph_hi = ph + 1; hipLaunchKernelGGL(fwd, dim3(grid), dim3(NTHR), LDS_BYTES, stream, a); }
#else
    a.ph_lo = 0; a.ph_hi = NPHASE;
    hipLaunchKernelGGL(fwd, dim3(grid), dim3(NTHR), LDS_BYTES, stream, a);
#endif
}
```

```cpp
#include <hip/hip_runtime.h>
#include <cstdio>
#include <cstdint>

#define GAS __attribute__((address_space(1)))
#define LAS __attribute__((address_space(3)))
typedef unsigned short bf16;
typedef short bf16x8 __attribute__((ext_vector_type(8)));
typedef float f32x4 __attribute__((ext_vector_type(4)));
typedef float f32x2 __attribute__((ext_vector_type(2)));
typedef unsigned u32x4 __attribute__((ext_vector_type(4)));
typedef unsigned u32x2 __attribute__((ext_vector_type(2)));
typedef int i32x4 __attribute__((ext_vector_type(4)));
typedef int i32x8 __attribute__((ext_vector_type(8)));

constexpr int BATCH = 4, SEQ = 4096, DM = 2048, T = BATCH * SEQ, NH = 8, HD = 128, GWID = 1024, NQKV = 6144, WIN_LD = 6152;
constexpr int NE = 16, DE = 512, ECAP = 16384, MAXTILES = 144, NRC = 32  ;
constexpr float EPS = 1e-6f;
constexpr int NWAVES = 8, NTHR = 512;
constexpr float SC_WGU = 32.f, SC_WD = 16.f, SC_HID = 16.f;

constexpr size_t MiB = 1u << 20, KiB = 1u << 10;
constexpr size_t WS_CTL = 0, CTL_ZERO_BYTES = 1 * MiB;
constexpr size_t WS_WQKV = 2 * MiB;
constexpr size_t WS_WO = 26 * MiB;
constexpr size_t WS_WGU = 34 * MiB;
constexpr size_t WS_WD = 98 * MiB;
constexpr size_t WS_WR = 130 * MiB;
constexpr size_t WS_LF = 130 * MiB + 256 * KiB;
constexpr size_t WS_C = 131 * MiB;
constexpr size_t WS_KMEAN = 131 * MiB + 512 * KiB;
constexpr size_t WS_TOKREC = 132 * MiB;
constexpr size_t WS_LIST = 133 * MiB;
constexpr size_t WS_RSR = 134 * MiB;
constexpr size_t WS_RSW = 135 * MiB;
constexpr size_t WS_SSQ = 136 * MiB;
constexpr size_t WS_A = 138 * MiB;
constexpr size_t WS_QKV = 202 * MiB;
constexpr size_t WS_XB = 202 * MiB;
constexpr size_t WS_Y = 266 * MiB;
constexpr size_t WS_XQ = 266 * MiB;
constexpr size_t WS_END = 410 * MiB;
constexpr int CW_TMO = 0, CW_GCNT = 64, CW_BAR = 4096;

constexpr int LCTL_OFF = 0;
constexpr int RING_OFF = 1024, RING_BYTES = 131072;
constexpr int XTRA_OFF = RING_OFF + RING_BYTES;
constexpr int LDS_BYTES = 155648;

#define LDS_WAIT() asm volatile("s_waitcnt lgkmcnt(0)" ::: "memory")
#define VM_WAIT() asm volatile("s_waitcnt vmcnt(0)" ::: "memory")
__device__ __forceinline__ unsigned cvt_pk_bf16(float lo, float hi) { unsigned r; asm volatile("v_cvt_pk_bf16_f32 %0, %1, %2" : "=v"(r) : "v"(lo), "v"(hi)); return r; }
__device__ __forceinline__ unsigned cvt_pk4_fp8(float a, float b, float c, float d) { int w = __builtin_amdgcn_cvt_pk_fp8_f32(a, b, 0, false); w = __builtin_amdgcn_cvt_pk_fp8_f32(c, d, w, true); return (unsigned)w; }
__device__ __forceinline__ float bf2f(unsigned short b) { return __uint_as_float((unsigned)b << 16); }
__device__ __forceinline__ float bflo(unsigned w) { return __uint_as_float(w << 16); }
__device__ __forceinline__ float bfhi(unsigned w) { return __uint_as_float(w & 0xffff0000u); }
__device__ __forceinline__ float wave_sum(float v) {
#pragma unroll
    for (int o = 1; o < 64; o <<= 1) v += __shfl_xor(v, o);
    return v;
}

__device__ __forceinline__ int ltid() { int t = threadIdx.x; asm volatile("" : "+v"(t)); return t; }
namespace pg8 {
typedef unsigned short bf16_t;
constexpr int BM = 256, BK = 64, HALF = 128, HTB = HALF * BK * 2, STAGE_BYTES = 8 * HTB, NXCD = 8, WGM = 8;
__host__ __device__ __forceinline__ int lds_byte(int r, int c) { const int st = (r >> 4) * 2 + (c >> 5), rr = r & 15, cc = c & 31, ob = rr * 64 + cc * 2; return st * 1024 + (ob ^ (((ob >> 9) & 1) << 5)); }
__host__ __device__ __forceinline__ void stage_rc(int b, int& R, int& C) { const int st = b / 1024, sb = b % 1024, swz = sb ^ (((sb >> 9) & 1) << 5); R = (st >> 1) * 16 + swz / 64; C = (st & 1) * 32 + (swz % 64) / 2; }
__host__ __device__ __forceinline__ int perm32(int rho) { const int n = rho >> 4, i = rho & 15; return 8 * (i >> 2) + 4 * n + (i & 3); }

struct Unit { int pm, pn; };
struct Gemm { const bf16_t* A; const bf16_t* Bt; int M, N, K; };

struct StaticOrder {
    int nM, nN, nwg, G, c;
    __host__ __device__ void init(int M, int N, int G_, int c_) { nM = M / BM; nN = N / BM; nwg = nM * nN; G = G_; c = c_; }
    __host__ __device__ bool next(int i, Unit& u) const {
        const long L = (long)i * G + c; if (L >= nwg) return false;
        int wgid = (int)L; { const int q = nwg / NXCD, r = nwg % NXCD, xcd = wgid % NXCD, off = wgid / NXCD; wgid = (xcd < r ? xcd * (q + 1) : r * (q + 1) + (xcd - r) * q) + off; }
        const int nig = WGM * nN, gid = wgid / nig, fm = gid * WGM, gsz = (nM - fm) < WGM ? (nM - fm) : WGM;
        u.pm = fm + ((wgid % nig) % gsz); u.pn = (wgid % nig) / gsz; return true;
    }
    __device__ __forceinline__ int arow(const Unit&, int) const { return 0; }
};

template <class Epi, class Sched, bool ALIGN_EPI, bool GATHER, bool FP8 = false>
__device__ __forceinline__ void gemm_phase(LAS unsigned char* lds, const Gemm g, const Sched& S, Epi& E) {
    const int tid = ltid(), wid = __builtin_amdgcn_readfirstlane(tid >> 6), lane = tid & 63, wr = wid >> 2, wc = wid & 3, fr = lane & 15, fq = lane >> 4;
    const int RB = FP8 ? g.K : 2 * g.K  , nt = RB / (BK * 2);
    unsigned voffA[2], voffB[2];
#pragma unroll
    for (int i = 0; i < 2; ++i) { int R, C; stage_rc(tid * 16 + i * 8192, R, C); const int Rb = Epi::PERM ? ((R & ~31) + perm32(R & 31)) : R;
        voffA[i] = (unsigned)(R * RB + C * 2); voffB[i] = (unsigned)(Rb * RB + C * 2); }
    const size_t kstep = (size_t)(BK * 2);
    const size_t hstep = (size_t)HALF * RB;
    const size_t tstep = 2 * hstep;
    const unsigned ldsw = (unsigned)wid * 1024u;
    const int aoff = lds_byte(wr * 64 + fr, fq * 8), boff = lds_byte(wc * 32 + fr, fq * 8);
    const unsigned ldsu = (unsigned)(uintptr_t)lds; const unsigned abase = ldsu + (unsigned)aoff, bbase = ldsu + 4u * HTB + (unsigned)boff;
#define PG8_SA(b, h) (((b) * 2 + (h)) * HTB)
#define PG8_SB(b, h) ((4 + (b) * 2 + (h)) * HTB)
#define PG8_GLDS(gbase, voff32, ldsdst) asm volatile("s_mov_b32 m0, %2\n\ts_nop 0\n\tglobal_load_lds_dwordx4 %0, %1" :: "v"(voff32), "s"(gbase), "s"(ldsdst) : "memory", "m0")
#define PG8_STAGE(bufoff, gbase, voff) do { _Pragma("unroll") for (int _i = 0; _i < 2; ++_i) PG8_GLDS((const char*)(gbase), (voff)[_i], ldsu + (unsigned)((bufoff) + _i * 8192) + ldsw); } while (0)
#define PG8_STAGE_A(bufoff, gbase, h, VV) do { if constexpr (GATHER) { PG8_STAGE(bufoff, gbase, (VV)[h]); } else { PG8_STAGE(bufoff, (gbase) + (h) * hstep, voffA); } } while (0)
#define PG8_STAGE_A2(bufoff, gbase, h) do { if constexpr (GATHER) { if (last) PG8_STAGE(bufoff, gbase, nv[h]); else PG8_STAGE(bufoff, gbase, cv[h]); } else { PG8_STAGE(bufoff, (gbase) + (h) * hstep, voffA); } } while (0)
#define PG8_DSR(dst, base, off) asm volatile("ds_read_b128 %0, %1 offset:%2" : "=v"(dst) : "v"(base), "i"(off) : "memory")
#define PG8_LDA(dst, b, h) do { if constexpr (FP8) { _Pragma("unroll") for (int m = 0; m < 4; ++m) { i32x4 lo_, hi_; PG8_DSR(lo_, abase, PG8_SA(b, h) + m * 2048); PG8_DSR(hi_, abase, PG8_SA(b, h) + m * 2048 + 1024); dst##8[m] = __builtin_shufflevector(lo_, hi_, 0, 1, 2, 3, 4, 5, 6, 7); } } \
        else { _Pragma("unroll") for (int m = 0; m < 4; ++m) _Pragma("unroll") for (int k = 0; k < 2; ++k) PG8_DSR(dst[m][k], abase, PG8_SA(b, h) + m * 2048 + k * 1024); } } while (0)
#define PG8_LDB(dst, b, h) do { if constexpr (FP8) { _Pragma("unroll") for (int n = 0; n < 2; ++n) { i32x4 lo_, hi_; PG8_DSR(lo_, bbase, PG8_SA(b, h) + n * 2048); PG8_DSR(hi_, bbase, PG8_SA(b, h) + n * 2048 + 1024); dst##8[n] = __builtin_shufflevector(lo_, hi_, 0, 1, 2, 3, 4, 5, 6, 7); } } \
        else { _Pragma("unroll") for (int n = 0; n < 2; ++n) _Pragma("unroll") for (int k = 0; k < 2; ++k) PG8_DSR(dst[n][k], bbase, PG8_SA(b, h) + n * 2048 + k * 1024); } } while (0)
#define PG8_MMA(ai, bj, At, Bt) do { __builtin_amdgcn_s_setprio(1); _Pragma("unroll") for (int m = 0; m < 4; ++m) _Pragma("unroll") for (int n = 0; n < 2; ++n) { \
        if constexpr (FP8) acc[ai][bj][m][n] = __builtin_amdgcn_mfma_scale_f32_16x16x128_f8f6f4(Bt##8[n], At##8[m], acc[ai][bj][m][n], 0, 0, 0, 0, 0, 0); \
        else { _Pragma("unroll") for (int k = 0; k < 2; ++k) acc[ai][bj][m][n] = __builtin_amdgcn_mfma_f32_16x16x32_bf16(Bt[n][k], At[m][k], acc[ai][bj][m][n], 0, 0, 0); } } __builtin_amdgcn_s_setprio(0); } while (0)
#define PG8_WAIT_V(n) asm volatile("s_waitcnt vmcnt(" #n ")" ::: "memory")
#define PG8_WAIT_L(n) asm volatile("s_waitcnt lgkmcnt(" #n ")" ::: "memory")
#define PG8_BAR __builtin_amdgcn_s_barrier()
#define PG8_SCHED __builtin_amdgcn_sched_barrier(0)
    Unit cur, nxt; int ui = 0;
    if (!S.next(0, cur)) return;
    f32x4 acc[2][2][4][2];
#pragma unroll
    for (int a = 0; a < 2; ++a)
#pragma unroll
        for (int b = 0; b < 2; ++b)
#pragma unroll
            for (int m = 0; m < 4; ++m)
#pragma unroll
                for (int n = 0; n < 2; ++n) acc[a][b][m][n] = (f32x4){0.f, 0.f, 0.f, 0.f};
    bf16x8 At[4][2], B0[2][2], B1[2][2];
    i32x8 At8[4], B08[2], B18[2];
    unsigned cv[2][2], nv[2][2];
#define PG8_GOFF(dst, unit) do { const int t2_ = ltid(); _Pragma("unroll") for (int i_ = 0; i_ < 2; ++i_) { int R_, C_; stage_rc(t2_ * 16 + i_ * 8192, R_, C_); \
        _Pragma("unroll") for (int h_ = 0; h_ < 2; ++h_) dst[h_][i_] = (unsigned)S.arow(unit, h_ * HALF + R_) * (unsigned)RB + (unsigned)C_ * 2u; } } while (0)
    if constexpr (GATHER) {
        PG8_GOFF(cv, cur);
#pragma unroll
        for (int h = 0; h < 2; ++h)
#pragma unroll
            for (int i = 0; i < 2; ++i) nv[h][i] = cv[h][i];
    } else {
#pragma unroll
        for (int h = 0; h < 2; ++h)
#pragma unroll
            for (int i = 0; i < 2; ++i) { cv[h][i] = 0u; nv[h][i] = 0u; }
    }
    const char* cA = GATHER ? (const char*)g.A : (const char*)g.A + (size_t)cur.pm * tstep; const char* cB = (const char*)g.Bt + (size_t)cur.pn * tstep;
    PG8_STAGE(PG8_SB(0, 0), cB, voffB); PG8_STAGE(PG8_SB(0, 1), cB + hstep, voffB); PG8_STAGE_A(PG8_SA(0, 0), cA, 0, cv); PG8_STAGE_A(PG8_SA(0, 1), cA, 1, cv);
    if (wr == 1) PG8_BAR;
    PG8_WAIT_V(2); PG8_BAR;
    PG8_STAGE(PG8_SB(1, 0), cB + kstep, voffB); PG8_STAGE_A(PG8_SA(1, 0), cA + kstep, 0, cv); PG8_STAGE(PG8_SB(1, 1), cB + hstep + kstep, voffB);
    PG8_WAIT_V(6); PG8_BAR;
    for (;;) {
        if constexpr (Epi::MIDK) E.begin(cur, wr, fr);
        const bool has_next = S.next(ui + 1, nxt);
        const char* nA = GATHER ? (const char*)g.A : (has_next ? (const char*)g.A + (size_t)nxt.pm * tstep : cA); const char* nB = has_next ? (const char*)g.Bt + (size_t)nxt.pn * tstep : cB;
        if constexpr (GATHER) {
            if (has_next) PG8_GOFF(nv, nxt);
        }
#pragma nounroll
        for (int t = 0; t < nt; t += 2) {
            const bool last = (t == nt - 2);
            if constexpr (Epi::MIDK) { if (t == (nt >> 1)) E.midk(acc); }
            const char* a1 = cA + (size_t)(t + 1) * kstep;
            const char* a2 = last ? nA : cA + (size_t)(t + 2) * kstep; const char* b2 = last ? nB : cB + (size_t)(t + 2) * kstep;
            const char* a3 = a2 + kstep; const char* b3 = b2 + kstep;
            PG8_LDB(B0, 0, 0); PG8_LDB(B1, 0, 1); PG8_SCHED; PG8_LDA(At, 0, 0); PG8_STAGE_A(PG8_SA(1, 1), a1, 1, cv);
            PG8_WAIT_V(8); PG8_WAIT_L(0); PG8_BAR; PG8_SCHED; PG8_MMA(0, 0, At, B0); PG8_MMA(0, 1, At, B1); PG8_BAR; PG8_SCHED;
            PG8_LDA(At, 0, 1); PG8_STAGE(PG8_SB(0, 0), b2, voffB); PG8_STAGE(PG8_SB(0, 1), b2 + hstep, voffB); PG8_STAGE_A2(PG8_SA(0, 0), a2, 0);
            PG8_WAIT_V(8); PG8_WAIT_L(0); PG8_BAR; PG8_SCHED; PG8_MMA(1, 0, At, B0); PG8_MMA(1, 1, At, B1); PG8_BAR; PG8_SCHED;
            PG8_LDB(B0, 1, 0); PG8_LDB(B1, 1, 1); PG8_SCHED; PG8_LDA(At, 1, 0); PG8_STAGE_A2(PG8_SA(0, 1), a2, 1);
            PG8_WAIT_V(8); PG8_WAIT_L(0); PG8_BAR; PG8_SCHED; PG8_MMA(0, 0, At, B0); PG8_MMA(0, 1, At, B1); PG8_BAR; PG8_SCHED;
            PG8_LDA(At, 1, 1); PG8_STAGE(PG8_SB(1, 0), b3, voffB); PG8_STAGE(PG8_SB(1, 1), b3 + hstep, voffB); PG8_STAGE_A2(PG8_SA(1, 0), a3, 0);
            PG8_WAIT_V(8); PG8_WAIT_L(0); PG8_BAR; PG8_SCHED; PG8_MMA(1, 0, At, B0); PG8_MMA(1, 1, At, B1); PG8_BAR; PG8_SCHED;
        }
        if constexpr (ALIGN_EPI) { if (wr == 0) PG8_BAR; }
        { const int l_ = ltid() & 63; E(acc, cur, wr, wc, l_ & 15, l_ >> 4); }
        if (!has_next) break;
#pragma unroll
        for (int a = 0; a < 2; ++a)
#pragma unroll
            for (int b = 0; b < 2; ++b)
#pragma unroll
                for (int m = 0; m < 4; ++m)
#pragma unroll
                    for (int n = 0; n < 2; ++n) acc[a][b][m][n] = (f32x4){0.f, 0.f, 0.f, 0.f};
        cur = nxt; cA = nA; cB = nB; ++ui;
#pragma unroll
        for (int h = 0; h < 2; ++h)
#pragma unroll
            for (int i = 0; i < 2; ++i) cv[h][i] = nv[h][i];
        if constexpr (ALIGN_EPI) { if (wr == 1) PG8_BAR; }
    }
    PG8_WAIT_V(0);
    if constexpr (!ALIGN_EPI) { if (wr == 0) PG8_BAR; }
    PG8_BAR;
#undef PG8_SA
#undef PG8_SB
#undef PG8_STAGE
#undef PG8_STAGE_A
#undef PG8_STAGE_A2
#undef PG8_LDA
#undef PG8_LDB
#undef PG8_MMA
#undef PG8_GOFF
#undef PG8_GLDS
#undef PG8_DSR
#undef PG8_WAIT_V
#undef PG8_WAIT_L
#undef PG8_BAR
#undef PG8_SCHED
}
}


namespace att {
constexpr int D = 128, NW = 8, QBLK = 32, KVBLK = 64, QB = 256;
constexpr int SHM_V = 16384, SHM_K = 16384;
constexpr int OFF_WS = 2 * SHM_V + 2 * SHM_K, OFF_KBF = OFF_WS + NW * 256, OFF_LUT = OFF_KBF + 16384, LDS_ATT = OFF_LUT + 2304;
constexpr float SCALE = 0.08838834764831845f, ISCALE = 11.313708498984761f, THR = 8.f;
typedef short s16x4 __attribute__((ext_vector_type(4)));
typedef float f32x16 __attribute__((ext_vector_type(16)));
#define KSWZ(row, colB) ((row) * 256 + ((colB) ^ (((row) & 7) << 4)))
#define SBAR() __builtin_amdgcn_sched_barrier(0)
__device__ __forceinline__ int v_st(int k, int c) { const int kk = (k & ~0xC) | ((k & 4) << 1) | ((k & 8) >> 1); return ((kk >> 3) * 4 + (c >> 5)) * 512 + ((kk & 7) * 32 + (c & 31)) * 2; }
__device__ __forceinline__ int v_rd_base(int lane) { return ((lane & 3) << 3) | (((lane >> 2) & 3) << 6) | (((lane >> 4) & 1) << 5) | (((lane >> 5) & 1) << 8); }
constexpr int v_rd_off(int d0, int ks, int half) { return d0 * 512 + ks * 4096 + half * 2048; }
__device__ __forceinline__ int crow(int r, int hi) { return (r & 3) + 8 * (r >> 2) + 4 * hi; }
__device__ __forceinline__ unsigned cvtpk(float lo, float hi) { unsigned r; asm volatile("v_cvt_pk_bf16_f32 %0, %1, %2" : "=v"(r) : "v"(lo), "v"(hi)); return r; }
__device__ __forceinline__ void mask_tile(f32x16& p0, f32x16& p1, int dq) {
    const float NEG = -__builtin_inff();
#pragma unroll
    for (int r = 0; r < 16; ++r) { const int c = (r & 3) + 8 * (r >> 2);
        if (dq - c < 0) p0[r] = NEG;
        if (dq - c - 32 < 0) p1[r] = NEG; }
}
__device__ __forceinline__ void partialSM(f32x16& p0, f32x16& p1, float& m_reg, float& mn, float& alpha) {
    float pmax = p0[0]; for (int r = 1; r < 16; ++r) pmax = fmaxf(pmax, p0[r]); for (int r = 0; r < 16; ++r) pmax = fmaxf(pmax, p1[r]);
    { auto rr = __builtin_amdgcn_permlane32_swap(__float_as_uint(pmax), __float_as_uint(pmax), false, false);
      pmax = fmaxf(__uint_as_float(rr[0]), __uint_as_float(rr[1])); }
    constexpr float C2 = 1.4426950408889634f * SCALE;
    if (__builtin_expect(__all((pmax - m_reg) * SCALE <= THR), 1)) { mn = m_reg; alpha = 1.f; }
    else { mn = fmaxf(m_reg, pmax); alpha = __builtin_amdgcn_exp2f((m_reg - mn) * C2); m_reg = mn; }
    const float mnL = -mn * C2;
    for (int r = 0; r < 16; ++r) p0[r] = fmaf(p0[r], C2, mnL); for (int r = 0; r < 16; ++r) p1[r] = fmaf(p1[r], C2, mnL);
    for (int r = 0; r < 16; ++r) p0[r] = __builtin_amdgcn_exp2f(p0[r]);
}
__device__ __forceinline__ void finishSM(f32x16& p0, f32x16& p1, float alpha, float& l_reg, bf16x8& pa0, bf16x8& pa1, bf16x8& pa2, bf16x8& pa3) {
    for (int r = 0; r < 16; ++r) p1[r] = __builtin_amdgcn_exp2f(p1[r]);
    float ps = 0; for (int r = 0; r < 16; ++r) ps += p0[r]; for (int r = 0; r < 16; ++r) ps += p1[r];
    { auto rr = __builtin_amdgcn_permlane32_swap(__float_as_uint(ps), __float_as_uint(ps), false, false);
      ps = __uint_as_float(rr[0]) + __uint_as_float(rr[1]); }
    l_reg = l_reg * alpha + ps;
#define PK4(P, B_, OUT) do { unsigned a0 = cvtpk(P[B_+0], P[B_+1]), a1 = cvtpk(P[B_+2], P[B_+3]);                          \
        unsigned b0 = cvtpk(P[B_+4], P[B_+5]), b1 = cvtpk(P[B_+6], P[B_+7]);                                             \
        auto r0 = __builtin_amdgcn_permlane32_swap(a0, b0, false, false); auto r1 = __builtin_amdgcn_permlane32_swap(a1, b1, false, false); \
        u32x4 w = {r0[0], r1[0], r0[1], r1[1]}; OUT = *reinterpret_cast<bf16x8*>(&w); } while (0)
    PK4(p0, 0, pa0); PK4(p0, 8, pa1); PK4(p1, 0, pa2); PK4(p1, 8, pa3);
#undef PK4
}
struct InitCtx {
    const LAS float* kbl;
    int own, qlo, qpos4;
    unsigned sel;
};
template <int KB, int MODE>
__device__ __forceinline__ void qkt(f32x16& p0, f32x16& p1, const char* K_lds, int r32, int hi, const bf16x8* qr, const InitCtx& ic, int kbase) {
    if (MODE == 0) {
        const LAS float* kb = ic.kbl + kbase;
#pragma unroll
        for (int i = 0; i < 4; ++i) { const f32x4 a = *(const LAS f32x4*)(kb + 8 * i), b = *(const LAS f32x4*)(kb + 32 + 8 * i);
            p0[4 * i] = a[0]; p0[4 * i + 1] = a[1]; p0[4 * i + 2] = a[2]; p0[4 * i + 3] = a[3]; p1[4 * i] = b[0]; p1[4 * i + 1] = b[1]; p1[4 * i + 2] = b[2]; p1[4 * i + 3] = b[3]; }
    } else {
        const int jb = kbase >> 8; const bool rowok = (jb >= ic.own) || (((ic.sel >> jb) & 1u) != 0u);
        int B = ic.qpos4 - kbase + 256 - 59; B = B > 384 ? 384 : B; B = rowok ? B : 512; asm volatile("" : "+v"(B));
        const LAS float* lp = ic.kbl + B;
#pragma unroll
        for (int r = 0; r < 16; ++r) { const int c = (r & 3) + 8 * (r >> 2); p0[r] = lp[59 - c]; p1[r] = lp[59 - c - 32]; }
    }
    const char* kb[4];
#pragma unroll
    for (int dd = 0; dd < 4; ++dd) kb[dd] = K_lds + KB * SHM_K + KSWZ(r32, (dd * 16 + hi * 8) * 2);
#pragma unroll
    for (int d0 = 0; d0 < 8; ++d0) { const char* a = kb[d0 & 3] + (d0 >> 2) * 128;
        bf16x8 b0 = *reinterpret_cast<const bf16x8*>(a);
        bf16x8 b1 = *reinterpret_cast<const bf16x8*>(a + 32 * 256);
        p0 = __builtin_amdgcn_mfma_f32_32x32x16_bf16(b0, qr[d0], p0, 0, 0, 0);
        p1 = __builtin_amdgcn_mfma_f32_32x32x16_bf16(b1, qr[d0], p1, 0, 0, 0); }
}
template <int VB>
__device__ __forceinline__ void pv_tile(f32x16* o, int vb0, bf16x8 pa0, bf16x8 pa1, bf16x8 pa2, bf16x8 pa3) {
#define TRRD(dst, off) asm volatile("ds_read_b64_tr_b16 %0, %1 offset:%2" : "=&v"(dst) : "v"(vb0), "i"(off) : "memory")
#define PV_D0(d0) do { s16x4 l0, l1, l2, l3, h0, h1, h2, h3; constexpr int b_ = VB * SHM_V + v_rd_off(d0, 0, 0); \
        TRRD(l0, b_); TRRD(h0, b_ + 2048); TRRD(l1, b_ + 4096); TRRD(h1, b_ + 6144); TRRD(l2, b_ + 8192); TRRD(h2, b_ + 10240); TRRD(l3, b_ + 12288); TRRD(h3, b_ + 14336); \
        asm volatile("s_waitcnt lgkmcnt(0)" ::: "memory"); SBAR();   \
        o[d0] = __builtin_amdgcn_mfma_f32_32x32x16_bf16(pa0, (bf16x8){l0[0], l0[1], l0[2], l0[3], h0[0], h0[1], h0[2], h0[3]}, o[d0], 0, 0, 0);   \
        o[d0] = __builtin_amdgcn_mfma_f32_32x32x16_bf16(pa1, (bf16x8){l1[0], l1[1], l1[2], l1[3], h1[0], h1[1], h1[2], h1[3]}, o[d0], 0, 0, 0);   \
        o[d0] = __builtin_amdgcn_mfma_f32_32x32x16_bf16(pa2, (bf16x8){l2[0], l2[1], l2[2], l2[3], h2[0], h2[1], h2[2], h2[3]}, o[d0], 0, 0, 0);   \
        o[d0] = __builtin_amdgcn_mfma_f32_32x32x16_bf16(pa3, (bf16x8){l3[0], l3[1], l3[2], l3[3], h3[0], h3[1], h3[2], h3[3]}, o[d0], 0, 0, 0); } while (0)
    PV_D0(0); PV_D0(1); PV_D0(2); PV_D0(3);
#undef PV_D0
#undef TRRD
}
struct BlockRef { const bf16* Q; const bf16* K; const bf16* V; bf16* O; float* SS; int P0; int bh; };
struct Seam { bf16x8 qr[8]; bf16x8 st_v0, st_v1, st_k0, st_k1; };
#define ROW(p, k0, rr) ((p) + (size_t)((k0) + (rr)) * D + sc)
#define VMW() asm volatile("s_waitcnt vmcnt(0)" ::: "memory")
#define VMWN(n) asm volatile("s_waitcnt vmcnt(%0)" :: "i"(n) : "memory")
#define LD8(p) (*reinterpret_cast<const bf16x8*>(p))
#define SLOAD_H(Kp, Vp, k0) do { S.st_v0 = LD8(ROW(Vp, k0, sr)); S.st_v1 = LD8(ROW(Vp, k0, 32 + sr));              \
                         S.st_k0 = LD8(ROW(Kp, k0, sr)); S.st_k1 = LD8(ROW(Kp, k0, 32 + sr)); } while (0)
#define SWRITE_HK(bf) do { *(bf16x8*)(K_lds + (bf) * SHM_K + kws) = S.st_k0; *(bf16x8*)(K_lds + (bf) * SHM_K + kws + 32 * 256) = S.st_k1; } while (0)
#define SWRITE_HV(bf) do { *(bf16x8*)(V_lds + (bf) * SHM_V + vst0) = S.st_v0; *(bf16x8*)(V_lds + (bf) * SHM_V + vst1) = S.st_v1; } while (0)
#define SWRITE_H(bf) do { SWRITE_HV(bf); SWRITE_HK(bf); } while (0)
__device__ __forceinline__ void attn_prime(const BlockRef& cur, char* lds, Seam& S) {
    const int tid = ltid(), wid = __builtin_amdgcn_readfirstlane(tid >> 6), lane = tid & 63, r32 = lane & 31, hi = lane >> 5;
    const int sr = tid >> 4, sc = (tid & 15) * 8, kws = KSWZ(sr, sc * 2); char* K_lds = lds + 2 * SHM_V;
    for (int d0 = 0; d0 < 8; ++d0) S.qr[d0] = LD8(cur.Q + (size_t)(wid * QBLK + r32) * D + d0 * 16 + hi * 8);
    SLOAD_H(cur.K, cur.V, 0); VMW(); SWRITE_HK(0);
    __syncthreads();
}
template <int MODE>
__device__ __forceinline__ void attn_block(const BlockRef& cur, const BlockRef& nxt, LAS unsigned char* L, Seam& S, const float* cbuf, const bf16* kmean, const float* rel_bias) {
    char* lds = (char*)L;
    const int tid = ltid(), wid = __builtin_amdgcn_readfirstlane(tid >> 6), lane = tid & 63, r32 = lane & 31, hi = lane >> 5;
    const int NT = (cur.P0 + QB) / KVBLK;
    const int qlo = cur.P0 + wid * QBLK, qm = qlo + r32 - 4 * hi;
    char* V_lds = lds; char* K_lds = lds + 2 * SHM_V;
    float* ws = (float*)(lds + OFF_WS) + wid * 64; float* li_l = ws, * al_l = ws + 32;
    float m_reg = -1e30f, l_reg = 0; f32x16 o[4] = {};
    const int sr = tid >> 4, sc = (tid & 15) * 8, vst0 = v_st(sr, sc), vst1 = v_st(32 + sr, sc), kws = KSWZ(sr, sc * 2);
    const int vb0 = (int)(uintptr_t)V_lds + v_rd_base(lane);
    const bf16* Kh = cur.K; const bf16* Vh = cur.V;
    InitCtx ic; ic.own = cur.P0 >> 8; ic.qlo = qlo; ic.qpos4 = qm; ic.sel = 0u;
    const int h = cur.bh & 7;
    if (MODE == 0) {
        LAS float* kbf = (LAS float*)(L + OFF_KBF);
        const float* cs = cbuf + (size_t)cur.bh * SEQ; const float cref = cs[cur.P0];
        for (int j = tid; j < cur.P0 + QB; j += NTHR) kbf[j] = (cref - cs[j]) * ISCALE;
        ic.kbl = kbf + 4 * hi;
    } else {
        LAS float* lutX = (LAS float*)(L + OFF_LUT);
        { int d = tid - 256; if (d < 0) d = 0; if (d > 128) d = 128; int bk; if (d < 16) bk = d; else { bk = 16 + (int)(logf((float)d / 16.0f) / 2.0794415416798357f * 16.0f); if (bk > 31) bk = 31; }
          lutX[tid] = rel_bias[h * 32 + bk] * ISCALE; if (tid < 64) lutX[512 + tid] = -__builtin_inff(); }
        ic.kbl = lutX;
        f32x16 g = {};
        const bf16* km = kmean + ((size_t)cur.bh * 16 + (r32 & 15)) * 128 + hi * 8;
#pragma unroll
        for (int d0 = 0; d0 < 8; ++d0) { bf16x8 a = LD8(km + d0 * 16); if (r32 >= 16) a = (bf16x8){0, 0, 0, 0, 0, 0, 0, 0}; g = __builtin_amdgcn_mfma_f32_32x32x16_bf16(a, S.qr[d0], g, 0, 0, 0); }
        float gt[16];
#pragma unroll
        for (int n = 0; n < 16; ++n) { const int hh = (n >> 2) & 1, r = (n & 3) + 4 * (n >> 3); const float mine = g[r], oth = __shfl_xor(mine, 32); gt[n] = (hh == hi) ? mine : oth; }
        unsigned sel = 0u;
#pragma unroll
        for (int k = 0; k < 3; ++k) { float best = -__builtin_inff(); int bi = 16;
#pragma unroll
            for (int n = 0; n < 16; ++n) { const bool ok = (n < ic.own) && (((sel >> n) & 1u) == 0u) && (gt[n] > best); best = ok ? gt[n] : best; bi = ok ? n : bi; }
            if (bi < 16) sel |= 1u << bi; }
        ic.sel = sel;
    }
    __syncthreads();
#define RESC(a) do { if (__any((a) < 1.f)) { if (hi == 0) al_l[r32] = (a); asm volatile("s_waitcnt lgkmcnt(0)" ::: "memory");              \
                     for (int d_ = 0; d_ < 4; ++d_) for (int r = 0; r < 16; ++r) o[d_][r] *= al_l[crow(r, hi)]; } } while (0)
#define KBASE(t) ((t) * KVBLK)
#define MASKT(P0_, P1_, t) do { const int kb_ = KBASE(t); if (kb_ + KVBLK - 1 > qlo) mask_tile(P0_, P1_, qm - kb_); } while (0)
    constexpr int NQL = 8;
#define SEAM_K0() do { VMWN(NQL); SWRITE_HK(0); SBAR(); } while (0)
    f32x16 pA0, pA1, pB0, pB1; float mnA, mnB, alA, alB; bf16x8 pa0, pa1, pa2, pa3;
    SWRITE_HV(0); SBAR();
    if (NT > 1) { SLOAD_H(Kh, Vh, KBASE(1)); }
    SBAR(); qkt<0, MODE>(pA0, pA1, K_lds, r32, hi, S.qr, ic, KBASE(0));
    MASKT(pA0, pA1, 0); partialSM(pA0, pA1, m_reg, mnA, alA);
    if (NT > 1) { VMW(); SWRITE_H(1); }
    __syncthreads();
#define HALF_STEP(PX0, PX1, mnX, alX, PY0, PY1, alY, t, KB, VB, SB) do {                                                      \
        SBAR(); qkt<KB, MODE>(PX0, PX1, K_lds, r32, hi, S.qr, ic, KBASE(t));                                             \
        finishSM(PY0, PY1, alY, l_reg, pa0, pa1, pa2, pa3); SBAR();                                                           \
        if ((t) + 1 < NT) { SLOAD_H(Kh, Vh, KBASE((t) + 1)); SBAR(); }                                               \
        pv_tile<VB>(o, vb0, pa0, pa1, pa2, pa3); MASKT(PX0, PX1, (t)); partialSM(PX0, PX1, m_reg, mnX, alX);                                        \
        __syncthreads();                                                                                                      \
        if ((t) + 1 < NT) { VMW(); SWRITE_H(SB); }                                                                          \
        RESC(alX); __syncthreads(); } while (0)
    for (int t = 1; t + 1 < NT; t += 2) {
        HALF_STEP(pB0, pB1, mnB, alB, pA0, pA1, alA, t, 1, 0, 0);
        HALF_STEP(pA0, pA1, mnA, alA, pB0, pB1, alB, t + 1, 0, 1, 1);
    }
    const bool even = (NT & 1) == 0;
    if (even) { SBAR(); qkt<1, MODE>(pB0, pB1, K_lds, r32, hi, S.qr, ic, KBASE(NT - 1)); SBAR(); }
    SLOAD_H(nxt.K, nxt.V, 0); SBAR();
#pragma unroll
    for (int d0 = 0; d0 < 8; ++d0) S.qr[d0] = LD8(nxt.Q + (size_t)(wid * QBLK + r32) * D + d0 * 16 + hi * 8);
    SBAR();
    finishSM(pA0, pA1, alA, l_reg, pa0, pa1, pa2, pa3); SBAR();
    pv_tile<0>(o, vb0, pa0, pa1, pa2, pa3);
    if (even) { MASKT(pB0, pB1, NT - 1); partialSM(pB0, pB1, m_reg, mnB, alB); __syncthreads(); RESC(alB);
        finishSM(pB0, pB1, alB, l_reg, pa0, pa1, pa2, pa3); SBAR(); pv_tile<1>(o, vb0, pa0, pa1, pa2, pa3); }
    SBAR(); SEAM_K0();
    if (hi == 0) li_l[r32] = l_reg; asm volatile("s_waitcnt lgkmcnt(0)" ::: "memory");
    float rli[16];
#pragma unroll
    for (int r = 0; r < 16; ++r) rli[r] = __builtin_amdgcn_rcpf(li_l[crow(r, hi)]);
    bf16* Ow = cur.O + (size_t)(wid * QBLK) * DM; float* Sw = cur.SS + (size_t)(wid * QBLK) * 16;
#pragma unroll
    for (int r = 0; r < 16; ++r) { const int orow = crow(r, hi); float sq = 0.f;
#pragma unroll
        for (int d0 = 0; d0 < 4; ++d0) { const float v = o[d0][r] * rli[r]; sq += v * v;
            const float vn = __shfl_xor(v, 1);
            if ((r32 & 1) == 0) *(unsigned*)(Ow + (size_t)orow * DM + d0 * 32 + r32) = cvtpk(v, vn); }
        sq += __shfl_xor(sq, 1); sq += __shfl_xor(sq, 2); sq += __shfl_xor(sq, 4); sq += __shfl_xor(sq, 8); sq += __shfl_xor(sq, 16);
        if (r32 == 0) Sw[(size_t)orow * 16] = sq; }
    __syncthreads();
#undef RESC
#undef KBASE
#undef MASKT
#undef SEAM_K0
#undef HALF_STEP
}
#undef ROW
#undef VMW
#undef VMWN
#undef LD8
#undef SLOAD_H
#undef SWRITE_HK
#undef SWRITE_HV
#undef SWRITE_H
#undef KSWZ
#undef SBAR
}

#define XB_TMO      128
#define XB_XCNT(j)  (256  + 64 * (j))
#define XB_XSUB(j)  (1280 + 64 * (j))
#define XB_XGEN(j)  (2304 + 64 * (j))
#define XB_TOP      3328
#define XB_TOPGEN   3392
#define XCD_BAR_WORDS 3456
#define XB_SPIN_CAP (1u << 18)
__device__ __forceinline__ unsigned xb_ld(unsigned* p)              { return __hip_atomic_load(p, __ATOMIC_RELAXED, __HIP_MEMORY_SCOPE_AGENT); }
__device__ __forceinline__ unsigned xb_add(unsigned* p, unsigned v) { return __hip_atomic_fetch_add(p, v, __ATOMIC_RELAXED, __HIP_MEMORY_SCOPE_AGENT); }
__device__ __forceinline__ unsigned xb_xcc_id() { return (unsigned)__builtin_amdgcn_s_getreg((3 << 11) | 20) & 0xFu; }
#define XB_SPIN(cond, bar) do { unsigned _sp = 0; while (cond) { __builtin_amdgcn_s_sleep(1); \
    if ((++_sp & 255u) == 0u) { if (xb_ld(&(bar)[XB_TMO])) break; if (_sp > XB_SPIN_CAP) { atomicAdd(&(bar)[XB_TMO], 1u); break; } } } } while (0)
struct XcdBarrier { unsigned* bar; unsigned x; volatile LAS unsigned* st; };
__device__ __forceinline__ XcdBarrier xcd_barrier_post(unsigned* bar, volatile LAS unsigned* st) {
    XcdBarrier b; b.bar = bar; b.x = xb_xcc_id(); b.st = st;
    if (threadIdx.x == 0) (void)xb_add(&bar[XB_XCNT(b.x)], 1u);
    return b;
}
__device__ __forceinline__ void xcd_barrier_complete(unsigned* bar, unsigned x, unsigned& nloc, unsigned& nx) {
    const unsigned G = gridDim.x * gridDim.y * gridDim.z;
    unsigned sum, cnt, mine, sp = 0u;
    for (;;) {
        sum = 0u; cnt = 0u; mine = 0u;
#pragma unroll
        for (unsigned j = 0; j < 16; ++j) { const unsigned c = xb_ld(&bar[XB_XCNT(j)]); sum += c; cnt += (c > 0u) ? 1u : 0u; mine = (j == x) ? c : mine; }
        if (sum == G) break;
        __builtin_amdgcn_s_sleep(1);
        if ((++sp & 255u) == 0u) { if (xb_ld(&bar[XB_TMO])) break; if (sp > XB_SPIN_CAP) { atomicAdd(&bar[XB_TMO], 1u); break; } }
    }
    nloc = mine > 0u ? mine : 1u; nx = cnt > 0u ? cnt : 1u;
}
__device__ __forceinline__ void xcd_barrier(const XcdBarrier& b) {
    asm volatile("s_waitcnt vmcnt(0)" ::: "memory");
    __syncthreads();
    if (threadIdx.x == 0) {
        unsigned* bar = b.bar;
        __builtin_amdgcn_s_waitcnt(0);
        unsigned nloc = b.st[0], nx = b.st[1];
        if (nloc == 0u) { xcd_barrier_complete(bar, b.x, nloc, nx); b.st[0] = nloc; b.st[1] = nx; }
        const unsigned old = xb_add(&bar[XB_XSUB(b.x)], 1u);
        const unsigned gen = old / nloc;
        if (old + 1u == (gen + 1u) * nloc) {
            __builtin_amdgcn_fence(__ATOMIC_RELEASE, "agent");
            asm volatile("s_waitcnt vmcnt(0)" ::: "memory");
            const unsigned og = xb_add(&bar[XB_TOP], 1u);
            const unsigned tg = og / nx;
            if (og + 1u == (tg + 1u) * nx) xb_add(&bar[XB_TOPGEN], 1u);
            else XB_SPIN(xb_ld(&bar[XB_TOPGEN]) == tg, bar);
            __builtin_amdgcn_fence(__ATOMIC_ACQUIRE, "agent");
            xb_add(&bar[XB_XGEN(b.x)], 1u);
            asm volatile("s_waitcnt vmcnt(0)" ::: "memory");
        } else {
            XB_SPIN(xb_ld(&bar[XB_XGEN(b.x)]) == gen, bar);
            __builtin_amdgcn_fence(__ATOMIC_ACQUIRE, "agent");
            asm volatile("s_waitcnt vmcnt(0)" ::: "memory");
        }
    }
    __syncthreads();
}

struct Args { const float* in[17]; float* out; unsigned char* ws; int ph_lo, ph_hi; };
typedef const __attribute__((address_space(4))) Args* KArgP;
struct Frame {
    LAS unsigned char* lds; unsigned* ctl; unsigned char* ws;
    int tid, lane, wave, G, bx;
    KArgP ka;
};
#define INP(k) (F.ka->in[k])
__device__ __forceinline__ void phase_begin(Frame& F) {
    F.tid = ltid(); F.lane = F.tid & 63; F.wave = __builtin_amdgcn_readfirstlane(F.tid >> 6);
    KArgP p = (KArgP)__builtin_amdgcn_kernarg_segment_ptr(); asm volatile("" : "+s"(p)); F.ka = p;
}

struct EpiQKV {
    static constexpr bool PERM = true, MIDK = false;
    bf16* qkv;
    __device__ __forceinline__ void operator()(const f32x4 (&acc)[2][2][4][2], const pg8::Unit& u, int wr, int wc, int fr, int fq) const {
        const int which = u.pn >> 2, hp = u.pn & 3, b = (u.pm * 256) >> 12, s0 = (u.pm * 256) & 4095;
#pragma unroll
        for (int ai = 0; ai < 2; ++ai)
#pragma unroll
            for (int m = 0; m < 4; ++m) { const int s = s0 + ai * 128 + wr * 64 + m * 16 + fr;
#pragma unroll
                for (int bj = 0; bj < 2; ++bj) { const int head = hp * 2 + bj;
                    bf16* dst = qkv + ((((size_t)(which * 4 + b) * 8 + head) * 4096 + s) * 128 + wc * 32 + 8 * fq);
                    const f32x4 v0 = acc[ai][bj][m][0], v1 = acc[ai][bj][m][1];
                    u32x4 w; w.x = cvt_pk_bf16(v0[0], v0[1]); w.y = cvt_pk_bf16(v0[2], v0[3]); w.z = cvt_pk_bf16(v1[0], v1[1]); w.w = cvt_pk_bf16(v1[2], v1[3]);
                    *(u32x4*)dst = w; } }
    }
};
struct EpiRes {
    static constexpr bool PERM = true, MIDK = true;
    const float* x; bf16* xb; unsigned char* xq; const float* ssqp;
    LAS float* tab; int par;
    __device__ __forceinline__ void begin(const pg8::Unit& u, int wr, int fr) {
        (void)wr; (void)fr; par ^= 1;
        const int t = ltid();
        if (t < 256) { const f32x4* p = (const f32x4*)(ssqp + (size_t)(u.pm * 256 + t) * 16); const f32x4 a = p[0], b = p[1], c = p[2], d = p[3];
            const float sf = ((a[0] + a[1]) + (a[2] + a[3])) + ((b[0] + b[1]) + (b[2] + b[3])), sm = ((c[0] + c[1]) + (c[2] + c[3])) + ((d[0] + d[1]) + (d[2] + d[3]));
            const float qf = sqrtf(sf * (1.0f / GWID) + EPS), qm = sqrtf(sm * (1.0f / GWID) + EPS);
            tab[par * 512 + t] = qm / qf; tab[par * 512 + 256 + t] = 1.0f / qm; }
    }
    __device__ __forceinline__ void midk(f32x4 (&acc)[2][2][4][2]) const {
        const int t = ltid(), r0 = ((t >> 8) & 1) * 64 + (t & 15);
#pragma unroll
        for (int ai = 0; ai < 2; ++ai)
#pragma unroll
            for (int m = 0; m < 4; ++m) { const float rt = tab[par * 512 + ai * 128 + m * 16 + r0];
#pragma unroll
                for (int bj = 0; bj < 2; ++bj)
#pragma unroll
                    for (int n = 0; n < 2; ++n) acc[ai][bj][m][n] *= rt; }
    }
    __device__ __forceinline__ void operator()(const f32x4 (&acc)[2][2][4][2], const pg8::Unit& u, int wr, int wc, int fr, int fq) const {
        asm volatile("" : "+v"(fr), "+v"(fq));
        const int row0 = u.pm * 256 + wr * 64 + fr, col0 = u.pn * 256 + wc * 32 + 8 * fq;
        float rsm[2][4];
#pragma unroll
        for (int ai = 0; ai < 2; ++ai)
#pragma unroll
            for (int m = 0; m < 4; ++m) rsm[ai][m] = tab[par * 512 + 256 + ai * 128 + wr * 64 + m * 16 + fr];
#pragma unroll
        for (int ai = 0; ai < 2; ++ai) {
            f32x4 xv[4][2][2];
#pragma unroll
            for (int m = 0; m < 4; ++m)
#pragma unroll
                for (int bj = 0; bj < 2; ++bj)
#pragma unroll
                    for (int n = 0; n < 2; ++n) xv[m][bj][n] = *(const f32x4*)(x + (size_t)(row0 + ai * 128 + m * 16) * DM + col0 + bj * 128 + 4 * n);
#pragma unroll
            for (int m = 0; m < 4; ++m)
#pragma unroll
                for (int bj = 0; bj < 2; ++bj) { const float sc = rsm[ai][m]; const f32x4 v0 = xv[m][bj][0] + acc[ai][bj][m][0] * sc, v1 = xv[m][bj][1] + acc[ai][bj][m][1] * sc;
                    u32x4 w; w.x = cvt_pk_bf16(v0[0], v0[1]); w.y = cvt_pk_bf16(v0[2], v0[3]); w.z = cvt_pk_bf16(v1[0], v1[1]); w.w = cvt_pk_bf16(v1[2], v1[3]);
                    *(u32x4*)(xb + (size_t)(row0 + ai * 128 + m * 16) * DM + col0 + bj * 128) = w;
                    u32x2 q8; q8.x = cvt_pk4_fp8(v0[0], v0[1], v0[2], v0[3]); q8.y = cvt_pk4_fp8(v1[0], v1[1], v1[2], v1[3]);
                    *(u32x2*)(xq + (size_t)(row0 + ai * 128 + m * 16) * DM + col0 + bj * 128) = q8; }
        }
    }
};
struct MoeOrder {
    int G, c, ncol; const LAS int* tt;
    __device__ __forceinline__ bool next(int i, pg8::Unit& u) const {
        const int nt = __builtin_amdgcn_readfirstlane(tt[0]); const long L = (long)i * G + c; if (L >= (long)nt * ncol) return false;
        const int t = (int)(L / ncol), pnl = (int)(L % ncol); const int e = __builtin_amdgcn_readfirstlane(tt[16 + t]) & 0xff;
        u.pm = t; u.pn = e * ncol + pnl; return true;
    }
};
struct MoeGather : MoeOrder {
    const int* list;
    __device__ __forceinline__ int arow(const pg8::Unit& u, int r) const {
        const int w = __builtin_amdgcn_readfirstlane(tt[16 + u.pm]); const int e = w & 0xff, rb = w >> 8; const int cnt = __builtin_amdgcn_readfirstlane(tt[256 + e]);
        const int pos = rb * 256 + r; int tok = 0; if (pos < cnt) tok = list[e * ECAP + pos]; return tok;
    }
};
struct MoePlain : MoeOrder { __device__ __forceinline__ int arow(const pg8::Unit&, int) const { return 0; } };
struct EpiHid {
    static constexpr bool PERM = true, MIDK = false;
    unsigned char* hid; const float* rsr; const float* rsw; const LAS int* tt;
    __device__ __forceinline__ void operator()(const f32x4 (&acc)[2][2][4][2], const pg8::Unit& u, int wr, int wc, int fr, int fq) const {
        const int w = __builtin_amdgcn_readfirstlane(tt[16 + u.pm]); const int e = w & 0xff, rb = w >> 8, pnl = u.pn & 3; const int cnt = __builtin_amdgcn_readfirstlane(tt[256 + e]);
#pragma unroll
        for (int ai = 0; ai < 2; ++ai)
#pragma unroll
            for (int m = 0; m < 4; ++m) { const int r = ai * 128 + wr * 64 + m * 16 + fr, pos = rb * 256 + r; float rs = 0.f, cw = 0.f;
                if (pos < cnt) { rs = rsr[e * ECAP + pos] * (1.0f / SC_WGU); cw = rsw[e * ECAP + pos] * SC_HID; }
                float o[8];
#pragma unroll
                for (int n = 0; n < 2; ++n)
#pragma unroll
                    for (int j = 0; j < 4; ++j) { const float gv = acc[ai][0][m][n][j] * rs, uv = acc[ai][1][m][n][j] * rs; o[n * 4 + j] = gv / (1.f + __expf(-gv)) * uv * cw; }
                u32x2 pk; pk.x = cvt_pk4_fp8(o[0], o[1], o[2], o[3]); pk.y = cvt_pk4_fp8(o[4], o[5], o[6], o[7]);
                *(u32x2*)(hid + (size_t)(u.pm * 256 + r) * DE + pnl * 128 + wc * 32 + 8 * fq) = pk; }
    }
};
struct EpiY {
    static constexpr bool PERM = true, MIDK = false;
    bf16* y;
    __device__ __forceinline__ void operator()(const f32x4 (&acc)[2][2][4][2], const pg8::Unit& u, int wr, int wc, int fr, int fq) const {
        const int pnl = u.pn & 7;
#pragma unroll
        for (int ai = 0; ai < 2; ++ai)
#pragma unroll
            for (int m = 0; m < 4; ++m) { bf16* rowp = y + (size_t)(u.pm * 256 + ai * 128 + wr * 64 + m * 16 + fr) * DM + pnl * 256 + wc * 32 + 8 * fq;
#pragma unroll
                for (int bj = 0; bj < 2; ++bj) { const f32x4 v0 = acc[ai][bj][m][0] * (1.0f / (SC_HID * SC_WD)), v1 = acc[ai][bj][m][1] * (1.0f / (SC_HID * SC_WD));
                    u32x4 w; w.x = cvt_pk_bf16(v0[0], v0[1]); w.y = cvt_pk_bf16(v0[2], v0[3]); w.z = cvt_pk_bf16(v1[0], v1[1]); w.w = cvt_pk_bf16(v1[2], v1[3]);
                    *(u32x4*)(rowp + bj * 128) = w; } }
    }
};

__device__ __forceinline__ void tr_item(const float* src, int ldw, const float* gs, bf16* dst, int ldd, LAS float* scr, int lane) {
#pragma unroll 8
    for (int i = 0; i < 32; ++i) { const int kk = 2 * i + (lane >> 5); scr[kk * 33 + (lane & 31)] = src[(size_t)kk * ldw + (lane & 31)]; }
    const int c = lane & 7;
    f32x4 g0 = (f32x4){1.f, 1.f, 1.f, 1.f}, g1 = g0;
    if (gs) { g0 = *(const f32x4*)(gs + 8 * c); g1 = *(const f32x4*)(gs + 8 * c + 4); }
    LDS_WAIT(); asm volatile("" ::: "memory");
#pragma unroll
    for (int j = 0; j < 4; ++j) { const int n = (lane >> 3) + 8 * j; const LAS float* s = scr + (8 * c) * 33 + n;
        u32x4 o; o.x = cvt_pk_bf16(s[0 * 33] * g0[0], s[1 * 33] * g0[1]); o.y = cvt_pk_bf16(s[2 * 33] * g0[2], s[3 * 33] * g0[3]);
        o.z = cvt_pk_bf16(s[4 * 33] * g1[0], s[5 * 33] * g1[1]); o.w = cvt_pk_bf16(s[6 * 33] * g1[2], s[7 * 33] * g1[3]);
        *(u32x4*)(dst + (size_t)n * ldd + 8 * c) = o; }
    LDS_WAIT(); asm volatile("" ::: "memory");
}
__device__ __forceinline__ void tr_item_q(const float* src, int ldw, const float* gs, float scale, unsigned char* dst, int ldd, LAS float* scr, int lane) {
#pragma unroll 8
    for (int i = 0; i < 32; ++i) { const int kk = 2 * i + (lane >> 5); scr[kk * 33 + (lane & 31)] = src[(size_t)kk * ldw + (lane & 31)]; }
    const int c = lane & 7;
    f32x4 g0 = (f32x4){scale, scale, scale, scale}, g1 = g0;
    if (gs) { g0 = *(const f32x4*)(gs + 8 * c) * scale; g1 = *(const f32x4*)(gs + 8 * c + 4) * scale; }
    LDS_WAIT(); asm volatile("" ::: "memory");
#pragma unroll
    for (int j = 0; j < 4; ++j) { const int n = (lane >> 3) + 8 * j; const LAS float* s = scr + (8 * c) * 33 + n;
        u32x2 o; o.x = cvt_pk4_fp8(s[0 * 33] * g0[0], s[1 * 33] * g0[1], s[2 * 33] * g0[2], s[3 * 33] * g0[3]);
        o.y = cvt_pk4_fp8(s[4 * 33] * g1[0], s[5 * 33] * g1[1], s[6 * 33] * g1[2], s[7 * 33] * g1[3]);
        *(u32x2*)(dst + (size_t)n * ldd + 8 * c) = o; }
    LDS_WAIT(); asm volatile("" ::: "memory");
}
__device__ __forceinline__ void p0_prologue(Frame& F) {
    const float* x = INP(0); const float* g_attn = INP(1); const float* w_in = INP(2); const float* b_forget = INP(3);
    const float* g_fox = INP(4); const float* g_moba = INP(5); const float* w_out = INP(7); const float* g_ffn = INP(8);
    const float* w_gr = INP(9); const float* w_er = INP(11); const float* w_gate = INP(13); const float* w_up = INP(14); const float* w_down = INP(15);
    bf16* Wqkv = (bf16*)(F.ws + WS_WQKV); bf16* Wo = (bf16*)(F.ws + WS_WO); unsigned char* Wgu = F.ws + WS_WGU; unsigned char* Wd = F.ws + WS_WD; bf16* Wr = (bf16*)(F.ws + WS_WR);
    bf16* Hb = (bf16*)(F.ws + WS_A); float* lf = (float*)(F.ws + WS_LF);
    LAS float* scr = (LAS float*)(F.lds + RING_OFF + F.wave * 8704);
    LAS float* wfgT = (LAS float*)(F.lds + RING_OFF + 8 * 8704);
    const int gw = F.bx * NWAVES + F.wave, NGW = F.G * NWAVES;
    for (int idx = F.tid; idx < 2048 * 8; idx += NTHR) { const int k = idx >> 3, hh = idx & 7; wfgT[hh * 2048 + k] = w_in[(size_t)k * WIN_LD + NQKV + hh] * g_attn[k]; }
    constexpr int I_IN = 32 * 192, I_O = 32 * 64, I_G = 16 * 32 * 16, I_D = 16 * 8 * 64, NITEMS = I_IN + I_O + 2 * I_G + I_D;
    for (int it = gw; it < NITEMS; it += NGW) {
        int r = it;
        if (r < I_IN) { const int kb = r / 192, nb = r % 192; tr_item(w_in + (size_t)(64 * kb) * WIN_LD + 32 * nb, WIN_LD, g_attn + 64 * kb, Wqkv + (size_t)(32 * nb) * DM + 64 * kb, DM, scr, F.lane); continue; } r -= I_IN;
        if (r < I_O) { const int kb = r / 64, nb = r % 64; const int k0 = 64 * kb; const float* gs = (k0 < GWID) ? g_fox + k0 : g_moba + (k0 - GWID);
            tr_item(w_out + (size_t)k0 * DM + 32 * nb, DM, gs, Wo + (size_t)(32 * nb) * DM + k0, DM, scr, F.lane); continue; } r -= I_O;
        if (r < 2 * I_G) { const int up = r >= I_G; if (up) r -= I_G; const int e = r / 512, rr = r % 512, kb = rr / 16, nb = rr % 16; const int f0 = 32 * nb, tt = f0 >> 7, within = f0 & 127;
            const float* W = (up ? w_up : w_gate) + (size_t)e * DM * DE;
            tr_item_q(W + (size_t)(64 * kb) * DE + f0, DE, g_ffn + 64 * kb, SC_WGU, Wgu + ((size_t)e * 1024 + tt * 256 + up * 128 + within) * DM + 64 * kb, DM, scr, F.lane); continue; } r -= 2 * I_G;
        { const int e = r / 512, rr = r % 512, kb = rr / 64, nb = rr % 64;
            tr_item_q(w_down + (size_t)e * DE * DM + (size_t)(64 * kb) * DM + 32 * nb, DM, nullptr, SC_WD, Wd + ((size_t)e * DM + 32 * nb) * DE + 64 * kb, DE, scr, F.lane); }
    }
    for (int idx = (F.bx * NTHR + F.tid); idx < NRC * DM; idx += F.G * NTHR) { const int n = idx >> 11, k = idx & 2047;
        float v = 0.f; if (n < 4) v = w_gr[k * 4 + n]; else if (n < 20) v = w_er[k * 16 + (n - 4)];
        Wr[idx] = (bf16)(cvt_pk_bf16(v * g_ffn[k], 0.f) & 0xffffu); }
    __syncthreads();
    for (int m = gw; m < T; m += NGW) {
        const f32x4* xr = (const f32x4*)(x + (size_t)m * DM) + F.lane;
        f32x4 v[8]; float ss = 0.f;
#pragma unroll
        for (int j = 0; j < 8; ++j) { v[j] = xr[64 * j]; ss += (v[j][0] * v[j][0] + v[j][1] * v[j][1]) + (v[j][2] * v[j][2] + v[j][3] * v[j][3]); }
        float fl[8];
#pragma unroll
        for (int hh = 0; hh < 8; ++hh) { float a = 0.f;
#pragma unroll
            for (int j = 0; j < 8; ++j) { const f32x4 w = *(const LAS f32x4*)(wfgT + hh * 2048 + 256 * j + 4 * F.lane); a += (v[j][0] * w[0] + v[j][1] * w[1]) + (v[j][2] * w[2] + v[j][3] * w[3]); }
            fl[hh] = a; }
        ss = wave_sum(ss); const float rstd = 1.0f / sqrtf(ss * (1.0f / DM) + EPS);
#pragma unroll
        for (int hh = 0; hh < 8; ++hh) fl[hh] = wave_sum(fl[hh]) * rstd;
        u32x2* o8 = (u32x2*)(Hb + (size_t)m * DM) + F.lane;
#pragma unroll
        for (int j = 0; j < 8; ++j) { u32x2 w; w.x = cvt_pk_bf16(v[j][0] * rstd, v[j][1] * rstd); w.y = cvt_pk_bf16(v[j][2] * rstd, v[j][3] * rstd); o8[64 * j] = w; }
        if (F.lane < 8) { float z = fl[0];
#pragma unroll
            for (int hh = 1; hh < 8; ++hh) z = (F.lane == hh) ? fl[hh] : z;
            z += b_forget[F.lane];
            const float ls = fminf(z, 0.f) - log1pf(expf(-fabsf(z)));
            const int b = m >> 12, s = m & 4095; lf[(size_t)(b * 8 + F.lane) * SEQ + s] = ls; }
    }
}

__device__ __forceinline__ void p2_kmean_cumsum(Frame& F) {
    const bf16* mk = (const bf16*)(F.ws + WS_QKV) + (size_t)4 * 32 * SEQ * HD;
    bf16* kmean = (bf16*)(F.ws + WS_KMEAN);
    LAS float* part = (LAS float*)(F.lds + RING_OFF);
    for (int item = F.bx; item < 512; item += F.G) {
        const bf16* base = mk + ((size_t)item * 256 + F.wave * 32) * HD + 2 * F.lane;
        float a0 = 0.f, a1 = 0.f;
#pragma unroll 8
        for (int r = 0; r < 32; ++r) { const unsigned w = *(const unsigned*)(base + (size_t)r * HD); a0 += bflo(w); a1 += bfhi(w); }
        part[F.wave * 128 + 2 * F.lane] = a0; part[F.wave * 128 + 2 * F.lane + 1] = a1;
        __syncthreads();
        if (F.tid < 128) { float s = 0.f;
#pragma unroll
            for (int w = 0; w < 8; ++w) s += part[w * 128 + F.tid];
            kmean[(size_t)item * 128 + F.tid] = (bf16)(cvt_pk_bf16(s * (1.0f / 256.0f), 0.f) & 0xffffu); }
        __syncthreads();
    }
    if (F.bx < 32 && F.wave == 0) {
        const float* src = (const float*)(F.ws + WS_LF) + (size_t)F.bx * SEQ + 64 * F.lane; float* dst = (float*)(F.ws + WS_C) + (size_t)F.bx * SEQ + 64 * F.lane;
        f32x4 v[16]; float run = 0.f;
#pragma unroll
        for (int j = 0; j < 16; ++j) { v[j] = *(const f32x4*)(src + 4 * j);
            v[j][0] += run; v[j][1] += v[j][0]; v[j][2] += v[j][1]; v[j][3] += v[j][2]; run = v[j][3]; }
        float incl = run;
#pragma unroll
        for (int o = 1; o < 64; o <<= 1) { const float t = __shfl_up(incl, o); if (F.lane >= o) incl += t; }
        const float excl = incl - run;
#pragma unroll
        for (int j = 0; j < 16; ++j) { f32x4 w = v[j]; w[0] += excl; w[1] += excl; w[2] += excl; w[3] += excl; *(f32x4*)(dst + 4 * j) = w; }
    }
}

__device__ __forceinline__ void p4_outnorm(Frame& F) {
    bf16* AO = (bf16*)(F.ws + WS_A);
    const int gw = F.bx * NWAVES + F.wave, NGW = F.G * NWAVES;
    for (int m = gw; m < T; m += NGW) {
        u32x4* rp = (u32x4*)(AO + (size_t)m * DM) + F.lane;
        u32x4 v[4]; float ss[2] = {0.f, 0.f};
#pragma unroll
        for (int j = 0; j < 4; ++j) { v[j] = rp[64 * j];
#pragma unroll
            for (int q = 0; q < 4; ++q) { const float a = bflo(v[j][q]), b = bfhi(v[j][q]); ss[j >> 1] += a * a + b * b; } }
        const float r0 = 1.0f / sqrtf(wave_sum(ss[0]) * (1.0f / GWID) + EPS), r1 = 1.0f / sqrtf(wave_sum(ss[1]) * (1.0f / GWID) + EPS);
#pragma unroll
        for (int j = 0; j < 4; ++j) { const float r = (j < 2) ? r0 : r1; u32x4 o;
#pragma unroll
            for (int q = 0; q < 4; ++q) o[q] = cvt_pk_bf16(bflo(v[j][q]) * r, bfhi(v[j][q]) * r);
            rp[64 * j] = o; }
    }
}

__device__ __forceinline__ void p6_route(Frame& F) {
    const bf16* xb = (const bf16*)(F.ws + WS_XB); const bf16* Wr = (const bf16*)(F.ws + WS_WR);
    const float* bg = INP(10); const float* be = INP(12);
    int* tokrec = (int*)(F.ws + WS_TOKREC); int* list = (int*)(F.ws + WS_LIST); float* rsr = (float*)(F.ws + WS_RSR); float* rsw = (float*)(F.ws + WS_RSW);
    unsigned* gcnt = F.ctl + CW_GCNT;
    LAS float* part = (LAS float*)(F.lds + RING_OFF);
    LAS float* ssq = part + 2 * 64 * 32;
    LAS int* lcnt = (LAS int*)(ssq + 128);
    LAS int* lbase = lcnt + 16;
    const int fr = F.lane & 15, fq = F.lane >> 4, mt = F.wave & 3, kh = F.wave >> 2;
    for (int blk = F.bx; blk < T / 64; blk += F.G) {
        const int tok0 = blk * 64;
        if (F.tid < 16) lcnt[F.tid] = 0;
        const bf16* pa = xb + (size_t)(tok0 + 16 * mt + fr) * DM + 1024 * kh + 8 * fq;
        const bf16* pb0 = Wr + (size_t)fr * DM + 1024 * kh + 8 * fq; const bf16* pb1 = pb0 + (size_t)16 * DM;
        f32x4 acc0 = (f32x4){0.f, 0.f, 0.f, 0.f}, acc1 = acc0; float sq = 0.f;
#pragma unroll 4
        for (int s = 0; s < 32; ++s) { const bf16x8 a = *(const bf16x8*)(pa + 32 * s), b0 = *(const bf16x8*)(pb0 + 32 * s), b1 = *(const bf16x8*)(pb1 + 32 * s);
#pragma unroll
            for (int j = 0; j < 8; ++j) { const float f = bf2f((unsigned short)a[j]); sq += f * f; }
            acc0 = __builtin_amdgcn_mfma_f32_16x16x32_bf16(a, b0, acc0, 0, 0, 0); acc1 = __builtin_amdgcn_mfma_f32_16x16x32_bf16(a, b1, acc1, 0, 0, 0); }
        sq += __shfl_xor(sq, 16); sq += __shfl_xor(sq, 32);
#pragma unroll
        for (int i = 0; i < 4; ++i) { part[(kh * 64 + 16 * mt + 4 * fq + i) * 32 + fr] = acc0[i]; part[(kh * 64 + 16 * mt + 4 * fq + i) * 32 + 16 + fr] = acc1[i]; }
        if (fq == 0) ssq[kh * 64 + 16 * mt + fr] = sq;
        __syncthreads();
        int e1 = 0, e2 = 0, rk1 = 0, rk2 = 0; float w1 = 0.f, w2 = 0.f, rstd = 0.f;
        if (F.tid < 64) { const int t = F.tid;
            rstd = 1.0f / sqrtf((ssq[t] + ssq[64 + t]) * (1.0f / DM) + EPS);
            float gl[4]; int grp = 0;
#pragma unroll
            for (int j = 0; j < 4; ++j) gl[j] = (part[t * 32 + j] + part[(64 + t) * 32 + j]) * rstd + bg[j];
#pragma unroll
            for (int j = 1; j < 4; ++j) if (gl[j] > gl[grp]) grp = j;
            float gmax = gl[0];
#pragma unroll
            for (int j = 1; j < 4; ++j) gmax = fmaxf(gmax, gl[j]);
            float gden = 0.f;
#pragma unroll
            for (int j = 0; j < 4; ++j) gden += expf(gl[j] - gmax);
            const float pgrp = 1.0f / gden;
            float el[4];
#pragma unroll
            for (int j = 0; j < 4; ++j) el[j] = (part[t * 32 + 4 + 4 * grp + j] + part[(64 + t) * 32 + 4 + 4 * grp + j]) * rstd + be[4 * grp + j];
            int i1 = 0;
#pragma unroll
            for (int j = 1; j < 4; ++j) if (el[j] > el[i1]) i1 = j;
            int i2 = (i1 == 0) ? 1 : 0;
#pragma unroll
            for (int j = 0; j < 4; ++j) if (j != i1 && j != i2 && el[j] > el[i2]) i2 = j;
            const float p2 = expf(el[i2] - el[i1]);
            w1 = pgrp / (1.0f + p2); w2 = pgrp * p2 / (1.0f + p2);
            e1 = 4 * grp + i1; e2 = 4 * grp + i2;
            rk1 = __hip_atomic_fetch_add(&lcnt[e1], 1, __ATOMIC_RELAXED, __HIP_MEMORY_SCOPE_WORKGROUP); rk2 = __hip_atomic_fetch_add(&lcnt[e2], 1, __ATOMIC_RELAXED, __HIP_MEMORY_SCOPE_WORKGROUP);
        }
        __syncthreads();
        if (F.tid < 16) lbase[F.tid] = (int)__hip_atomic_fetch_add(gcnt + F.tid, (unsigned)lcnt[F.tid], __ATOMIC_RELAXED, __HIP_MEMORY_SCOPE_AGENT);
        __syncthreads();
        if (F.tid < 64) { const int tok = tok0 + F.tid; const int p1 = lbase[e1] + rk1, p2 = lbase[e2] + rk2;
            list[e1 * ECAP + p1] = tok; rsr[e1 * ECAP + p1] = rstd; rsw[e1 * ECAP + p1] = w1;
            list[e2 * ECAP + p2] = tok; rsr[e2 * ECAP + p2] = rstd; rsw[e2 * ECAP + p2] = w2;
            int4 rec; rec.x = e1; rec.y = p1; rec.z = e2; rec.w = p2; *(int4*)(tokrec + 4 * tok) = rec; }
        __syncthreads();
    }
}
__device__ __forceinline__ void moe_table(Frame& F) {
    LAS int* tt = (LAS int*)(F.lds + XTRA_OFF);
    if (F.tid == 0) { int t = 0;
        for (int e = 0; e < NE; ++e) { int c = (int)F.ctl[CW_GCNT + e]; if (c > ECAP) c = ECAP; if (c < 0) c = 0; tt[256 + e] = c; tt[288 + e] = t; const int n = (c + 255) >> 8;
            for (int rb = 0; rb < n && t < MAXTILES; ++rb) tt[16 + t++] = e | (rb << 8); }
        tt[0] = t; }
    __syncthreads();
}

__device__ __forceinline__ void p9_final(Frame& F) {
    const LAS int* tt = (const LAS int*)(F.lds + XTRA_OFF);
    const int* tokrec = (const int*)(F.ws + WS_TOKREC); const bf16* Y = (const bf16*)(F.ws + WS_Y); const bf16* XB = (const bf16*)(F.ws + WS_XB); const float* gfin = INP(16);
    const int gw = F.bx * NWAVES + F.wave, NGW = F.G * NWAVES;
    for (int m = gw; m < T; m += NGW) {
        const int4 rec = *(const int4*)(tokrec + 4 * m);
        const int e1 = __builtin_amdgcn_readfirstlane(rec.x), p1 = __builtin_amdgcn_readfirstlane(rec.y), e2 = __builtin_amdgcn_readfirstlane(rec.z), p2 = __builtin_amdgcn_readfirstlane(rec.w);
        const size_t r1 = (size_t)tt[288 + (e1 & 15)] * 256 + p1, r2 = (size_t)tt[288 + (e2 & 15)] * 256 + p2;
        f32x4* xr = (f32x4*)(F.ka->out + (size_t)m * DM) + F.lane; const u32x2* x1 = (const u32x2*)(XB + (size_t)m * DM) + F.lane;
        const u32x2* y1 = (const u32x2*)(Y + r1 * DM) + F.lane; const u32x2* y2 = (const u32x2*)(Y + r2 * DM) + F.lane;
        f32x4 v[8]; float ss = 0.f;
#pragma unroll
        for (int j = 0; j < 8; ++j) { const u32x2 c = x1[64 * j], a = y1[64 * j], b = y2[64 * j];
            v[j][0] = bflo(c.x) + bflo(a.x) + bflo(b.x); v[j][1] = bfhi(c.x) + bfhi(a.x) + bfhi(b.x); v[j][2] = bflo(c.y) + bflo(a.y) + bflo(b.y); v[j][3] = bfhi(c.y) + bfhi(a.y) + bfhi(b.y);
            ss += (v[j][0] * v[j][0] + v[j][1] * v[j][1]) + (v[j][2] * v[j][2] + v[j][3] * v[j][3]); }
        const float rstd = 1.0f / sqrtf(wave_sum(ss) * (1.0f / DM) + EPS);
#pragma unroll
        for (int j = 0; j < 8; ++j) { const f32x4 g = *((const f32x4*)gfin + 64 * j + F.lane); f32x4 o; o[0] = v[j][0] * rstd * g[0]; o[1] = v[j][1] * rstd * g[1]; o[2] = v[j][2] * rstd * g[2]; o[3] = v[j][3] * rstd * g[3]; xr[64 * j] = o; }
    }
}

constexpr int NPHASE = 10;
#ifndef REPMASK
#define REPMASK 0
#endif
#define NREP(k) (1 + ((REPMASK >> (k)) & 1))
__global__ void __launch_bounds__(NTHR, 2) fwd(Args args) {
    extern __shared__ __attribute__((aligned(16))) unsigned char lds_raw[];
    Frame F;
    F.lds = (LAS unsigned char*)lds_raw; F.ws = args.ws; F.ctl = (unsigned*)(args.ws + WS_CTL);
    F.G = gridDim.x; F.bx = blockIdx.x; phase_begin(F);
    for (int u = F.tid; u < 256; u += NTHR) ((LAS unsigned*)(F.lds + LCTL_OFF))[u] = 0u;
    __syncthreads();
    const int lo = args.ph_lo, hi = args.ph_hi;
    const bool multi = (hi - lo) > 1;
    XcdBarrier bar; bar.bar = F.ctl + CW_BAR; bar.x = 0; bar.st = (volatile LAS unsigned*)(F.lds + LCTL_OFF);
    if (multi) bar = xcd_barrier_post(F.ctl + CW_BAR, (volatile LAS unsigned*)(F.lds + LCTL_OFF));
#define IN(k) (lo <= (k) && (k) < hi)
#define SEAM(k) do { if (IN(k) && IN((k) + 1 + ((k) == 3))) xcd_barrier(bar); } while (0)

    if (IN(0)) _Pragma("nounroll") for (int rep_ = 0; rep_ < NREP(0); ++rep_) { if (rep_) xcd_barrier(bar); phase_begin(F); p0_prologue(F); } SEAM(0);
    if (IN(1)) _Pragma("nounroll") for (int rep_ = 0; rep_ < NREP(1); ++rep_) { if (rep_) xcd_barrier(bar); phase_begin(F);
        pg8::Gemm g{(const bf16*)(F.ws + WS_A), (const bf16*)(F.ws + WS_WQKV), T, NQKV, DM}; pg8::StaticOrder S; S.init(T, NQKV, F.G, F.bx);
        EpiQKV E{(bf16*)(F.ws + WS_QKV)};
        pg8::gemm_phase<EpiQKV, pg8::StaticOrder, true, false>(F.lds + RING_OFF, g, S, E);
    } SEAM(1);
    if (IN(2)) _Pragma("nounroll") for (int rep_ = 0; rep_ < NREP(2); ++rep_) { if (rep_) xcd_barrier(bar); phase_begin(F); p2_kmean_cumsum(F); } SEAM(2);
    if (IN(3)) _Pragma("nounroll") for (int rep_ = 0; rep_ < NREP(3); ++rep_) { if (rep_) xcd_barrier(bar); phase_begin(F);
        static_assert(att::LDS_ATT <= RING_BYTES, "attention LDS");
        const bf16* qkv = (const bf16*)(F.ws + WS_QKV); bf16* AO = (bf16*)(F.ws + WS_A);
        const float* cbuf = (const float*)(F.ws + WS_C); const bf16* kmean = (const bf16*)(F.ws + WS_KMEAN); const float* relb = INP(6); float* SSQ = (float*)(F.ws + WS_SSQ);
#define MKREF(R, grp, bh_, qb_) do { const int _bh = (bh_), _qb = (qb_), _g = (grp); \
            R.Q = qkv + ((size_t)(_g * 3 + 0) * 32 + _bh) * SEQ * HD + (size_t)_qb * 256 * HD; R.K = qkv + ((size_t)(_g * 3 + 1) * 32 + _bh) * SEQ * HD; R.V = qkv + ((size_t)(_g * 3 + 2) * 32 + _bh) * SEQ * HD; \
            R.O = AO + ((size_t)(_bh >> 3) * SEQ + _qb * 256) * DM + _g * GWID + (_bh & 7) * HD; R.SS = SSQ + ((size_t)(_bh >> 3) * SEQ + _qb * 256) * 16 + _g * 8 + (_bh & 7); R.P0 = _qb * 256; R.bh = _bh; } while (0)
        const int vcu = (F.G % 8 == 0) ? (F.bx % 8) * (F.G / 8) + F.bx / 8 : F.bx;
        att::Seam S; att::BlockRef cur, nxt;
        if (vcu < 256) { MKREF(cur, 0, vcu >> 3, vcu & 7); att::attn_prime(cur, (char*)lds_raw + RING_OFF, S); }
        for (int L = vcu; L < 256; L += F.G) {
            const int bh = L >> 3, s = L & 7; const bool more = (L + F.G) < 256; const int Ln = more ? L + F.G : L;
#pragma nounroll
            for (int u = 0; u < 2; ++u) {
                MKREF(cur, 0, bh, u ? 15 - s : s); if (u == 0) MKREF(nxt, 0, bh, 15 - s); else MKREF(nxt, 1, bh, s);
#ifndef NO_M0
                att::attn_block<0>(cur, nxt, F.lds + RING_OFF, S, cbuf, kmean, relb);
#endif
            }
#pragma nounroll
            for (int u = 0; u < 2; ++u) {
                MKREF(cur, 1, bh, u ? 15 - s : s); if (u == 0) MKREF(nxt, 1, bh, 15 - s); else if (more) MKREF(nxt, 0, Ln >> 3, Ln & 7); else nxt = cur;
#ifndef NO_M1
                att::attn_block<1>(cur, nxt, F.lds + RING_OFF, S, cbuf, kmean, relb);
#endif
            }
        }
#undef MKREF
    } SEAM(3);
    if (IN(5)) _Pragma("nounroll") for (int rep_ = 0; rep_ < NREP(5); ++rep_) { if (rep_) xcd_barrier(bar); phase_begin(F);
        pg8::Gemm g{(const bf16*)(F.ws + WS_A), (const bf16*)(F.ws + WS_WO), T, DM, DM}; pg8::StaticOrder S; S.init(T, DM, F.G, F.bx);
        EpiRes E; E.x = INP(0); E.xb = (bf16*)(F.ws + WS_XB); E.xq = F.ws + WS_XQ; E.ssqp = (const float*)(F.ws + WS_SSQ); E.tab = (LAS float*)(F.lds + XTRA_OFF); E.par = 1;
        pg8::gemm_phase<EpiRes, pg8::StaticOrder, true, false>(F.lds + RING_OFF, g, S, E);
    } SEAM(5);
    if (IN(6)) _Pragma("nounroll") for (int rep_ = 0; rep_ < NREP(6); ++rep_) { if (rep_) xcd_barrier(bar); phase_begin(F); p6_route(F); } SEAM(6);
    if (IN(7)) _Pragma("nounroll") for (int rep_ = 0; rep_ < NREP(7); ++rep_) { if (rep_) xcd_barrier(bar); phase_begin(F);
        moe_table(F);
        const LAS int* tt = (const LAS int*)(F.lds + XTRA_OFF);
        pg8::Gemm g{(const bf16*)(F.ws + WS_XQ), (const bf16*)(F.ws + WS_WGU), MAXTILES * 256, NE * 1024, DM};
        MoeGather S; S.G = F.G; S.c = F.bx; S.ncol = 4; S.tt = tt; S.list = (const int*)(F.ws + WS_LIST);
        EpiHid E{F.ws + WS_A, (const float*)(F.ws + WS_RSR), (const float*)(F.ws + WS_RSW), tt};
        pg8::gemm_phase<EpiHid, MoeGather, true, true, true>(F.lds + RING_OFF, g, S, E);
    } SEAM(7);
    if (IN(8)) _Pragma("nounroll") for (int rep_ = 0; rep_ < NREP(8); ++rep_) { if (rep_) xcd_barrier(bar); phase_begin(F);
        moe_table(F);
        const LAS int* tt = (const LAS int*)(F.lds + XTRA_OFF);
        pg8::Gemm g{(const bf16*)(F.ws + WS_A), (const bf16*)(F.ws + WS_WD), MAXTILES * 256, NE * DM, DE};
        MoePlain S; S.G = F.G; S.c = F.bx; S.ncol = 8; S.tt = tt;
        EpiY E{(bf16*)(F.ws + WS_Y)};
        pg8::gemm_phase<EpiY, MoePlain, true, false, true>(F.lds + RING_OFF, g, S, E);
    } SEAM(8);
    if (IN(9)) _Pragma("nounroll") for (int rep_ = 0; rep_ < NREP(9); ++rep_) { if (rep_) xcd_barrier(bar); phase_begin(F); moe_table(F); p9_final(F); }
#undef IN
#undef SEAM
}

template <int MODE>
__global__ void __launch_bounds__(256) naive_attn(unsigned char* ws, const float* rel_bias) {
    const bf16* qkv = (const bf16*)(ws + WS_QKV); const float* cbuf = (const float*)(ws + WS_C); const bf16* kmean = (const bf16*)(ws + WS_KMEAN); bf16* AO = (bf16*)(ws + WS_A);
    __shared__ float qs[16][128]; __shared__ float sc[16][256]; __shared__ float gsc[16][16]; __shared__ unsigned selm[16]; __shared__ float lut[132];
    const int t = threadIdx.x, bh = blockIdx.y, b = bh >> 3, h = bh & 7, i0 = blockIdx.x * 16;
    const bf16* Q = qkv + ((size_t)(MODE * 3 + 0) * 32 + bh) * SEQ * HD; const bf16* Kp = qkv + ((size_t)(MODE * 3 + 1) * 32 + bh) * SEQ * HD; const bf16* Vp = qkv + ((size_t)(MODE * 3 + 2) * 32 + bh) * SEQ * HD;
    for (int i = t; i < 16 * 128; i += 256) qs[i >> 7][i & 127] = bf2f(Q[(size_t)(i0 + (i >> 7)) * HD + (i & 127)]);
    const int own = i0 >> 8;
    if (MODE == 1) { for (int d = t; d < 129; d += 256) { int bk; if (d < 16) bk = d; else { bk = 16 + (int)(logf((float)d / 16.0f) / 2.0794415416798357f * 16.0f); if (bk > 31) bk = 31; } lut[d] = rel_bias[h * 32 + bk]; } }
    __syncthreads();
    if (MODE == 1) {
        const int q = t >> 4, n = t & 15; float g = -1e30f;
        if (n < own) { g = 0.f; const bf16* km = kmean + ((size_t)bh * 16 + n) * 128; for (int d = 0; d < 128; ++d) g += qs[q][d] * bf2f(km[d]); }
        gsc[q][n] = g;
        __syncthreads();
        if (t < 16) { unsigned m = 0; const int nsel = own < 3 ? own : 3;
            for (int k = 0; k < nsel; ++k) { int best = -1; float bv = 0.f; for (int n2 = 0; n2 < own; ++n2) if (!((m >> n2) & 1u) && (best < 0 || gsc[t][n2] > bv)) { best = n2; bv = gsc[t][n2]; } if (best >= 0) m |= 1u << best; }
            selm[t] = m; }
        __syncthreads();
    }
    const int q = t >> 4, dg = t & 15;
    float o[8]; for (int c = 0; c < 8; ++c) o[c] = 0.f;
    float mrun = -1e30f, lrun = 0.f;
    const float scale = 0.08838834764831845f;
    const int nch = own + 1;
    for (int ch = 0; ch < nch; ++ch) {
        const int j = ch * 256 + t;
        float kr[128];
        { const u32x4* kp = (const u32x4*)(Kp + (size_t)j * HD);
#pragma unroll
          for (int c = 0; c < 16; ++c) { const u32x4 w = kp[c]; kr[8 * c + 0] = bflo(w.x); kr[8 * c + 1] = bfhi(w.x); kr[8 * c + 2] = bflo(w.y); kr[8 * c + 3] = bfhi(w.y); kr[8 * c + 4] = bflo(w.z); kr[8 * c + 5] = bfhi(w.z); kr[8 * c + 6] = bflo(w.w); kr[8 * c + 7] = bfhi(w.w); } }
        const float cj = (MODE == 0) ? cbuf[(size_t)bh * SEQ + j] : 0.f;
        for (int qq = 0; qq < 16; ++qq) { const int i = i0 + qq; float s = 0.f;
#pragma unroll
            for (int d = 0; d < 128; ++d) s += qs[qq][d] * kr[d];
            s *= scale; bool ok;
            if (MODE == 0) { s += cbuf[(size_t)bh * SEQ + i] - cj; ok = j <= i; }
            else { const int dd = i - j; s += lut[dd < 0 ? 0 : (dd > 128 ? 128 : dd)]; ok = (ch == own) ? (j <= i) : (((selm[qq] >> ch) & 1u) != 0u); }
            sc[qq][t] = ok ? s : -__builtin_inff(); }
        __syncthreads();
        float cm = -__builtin_inff();
        for (int c = 0; c < 16; ++c) cm = fmaxf(cm, sc[q][dg + 16 * c]);
#pragma unroll
        for (int off = 1; off < 16; off <<= 1) cm = fmaxf(cm, __shfl_xor(cm, off));
        const float mnew = fmaxf(mrun, cm), alpha = expf(mrun - mnew);
        float ps = 0.f; float pv[16];
        for (int c = 0; c < 16; ++c) { pv[c] = expf(sc[q][dg + 16 * c] - mnew); ps += pv[c]; }
#pragma unroll
        for (int off = 1; off < 16; off <<= 1) ps += __shfl_xor(ps, off);
        lrun = lrun * alpha + ps; mrun = mnew;
        __syncthreads();
        for (int c = 0; c < 16; ++c) sc[q][dg + 16 * c] = pv[c];
        __syncthreads();
        for (int c = 0; c < 8; ++c) o[c] *= alpha;
        for (int jj = 0; jj < 256; ++jj) { const float p = sc[q][jj]; const u32x4 w = *(const u32x4*)(Vp + (size_t)(ch * 256 + jj) * HD + 8 * dg);
            o[0] += p * bflo(w.x); o[1] += p * bfhi(w.x); o[2] += p * bflo(w.y); o[3] += p * bfhi(w.y); o[4] += p * bflo(w.z); o[5] += p * bfhi(w.z); o[6] += p * bflo(w.w); o[7] += p * bfhi(w.w); }
        __syncthreads();
    }
    const float il = 1.0f / lrun;
    u32x4 w; w.x = cvt_pk_bf16(o[0] * il, o[1] * il); w.y = cvt_pk_bf16(o[2] * il, o[3] * il); w.z = cvt_pk_bf16(o[4] * il, o[5] * il); w.w = cvt_pk_bf16(o[6] * il, o[7] * il);
    *(u32x4*)(AO + (size_t)(b * SEQ + i0 + q) * DM + MODE * GWID + h * HD + 8 * dg) = w;
}

extern "C" void kernel_launch(void* const* d_in, const int* in_sizes, int n_in, void* d_out, int out_size, void* d_ws, size_t ws_size, hipStream_t stream) {
    static int grid = 0;
    if (grid == 0) {
        if (n_in != 17 || out_size != T * DM || ws_size < WS_END) { fprintf(stderr, "kernel_launch: unexpected shapes (n_in %d out %d ws %zu)\n", n_in, out_size, ws_size); grid = -1; return; }
        int dev = 0, cus = 0;
        if (hipGetDevice(&dev) != hipSuccess || hipDeviceGetAttribute(&cus, hipDeviceAttributeMultiprocessorCount, dev) != hipSuccess) { grid = -1; return; }
        if (hipFuncSetAttribute((const void*)fwd, hipFuncAttributeMaxDynamicSharedMemorySize, LDS_BYTES) != hipSuccess) { fprintf(stderr, "kernel_launch: hipFuncSetAttribute failed\n"); grid = -1; return; }
        int per_cu = 0;
        if (hipOccupancyMaxActiveBlocksPerMultiprocessor(&per_cu, (const void*)fwd, NTHR, LDS_BYTES) != hipSuccess || per_cu < 1) fprintf(stderr, "kernel_launch: occupancy query reports %d\n", per_cu);
        (void)hipGetLastError();
        grid = cus > 0 ? cus : 256;
    }
    if (grid < 0) return;
    (void)hipMemsetAsync((char*)d_ws + WS_CTL, 0, CTL_ZERO_BYTES, stream);
    Args a{};
    for (int i = 0; i < 17; ++i) a.in[i] = (const float*)d_in[i];
    a.out = (float*)d_out; a.ws = (unsigned char*)d_ws;
#ifdef MK_PER_PHASE
    for (int ph = 0; ph < NPHASE; ++ph) { a.ph_lo = ph; a.ph_hi = ph + 1; hipLaunchKernelGGL(fwd, dim3(grid), dim3(NTHR), LDS_BYTES, stream, a); }
#else
    a.ph_lo = 0; a.ph_hi = NPHASE;
    hipLaunchKernelGGL(fwd, dim3(grid), dim3(NTHR), LDS_BYTES, stream, a);
#endif
}
```

```cpp
#include <hip/hip_runtime.h>
#include <cstdio>
#include <cstdint>

#define GAS __attribute__((address_space(1)))
#define LAS __attribute__((address_space(3)))
typedef unsigned short bf16;
typedef short bf16x8 __attribute__((ext_vector_type(8)));
typedef float f32x4 __attribute__((ext_vector_type(4)));
typedef float f32x2 __attribute__((ext_vector_type(2)));
typedef unsigned u32x4 __attribute__((ext_vector_type(4)));
typedef unsigned u32x2 __attribute__((ext_vector_type(2)));
typedef int i32x4 __attribute__((ext_vector_type(4)));
typedef int i32x8 __attribute__((ext_vector_type(8)));

constexpr int BATCH = 4, SEQ = 4096, DM = 2048, T = BATCH * SEQ, NH = 8, HD = 128, GWID = 1024, NQKV = 6144, WIN_LD = 6152;
constexpr int NE = 16, DE = 512, ECAP = 16384, MAXTILES = 144, NRC = 32  ;
constexpr float EPS = 1e-6f;
constexpr int NWAVES = 8, NTHR = 512;
constexpr float SC_WGU = 32.f, SC_WD = 16.f, SC_HID = 16.f;
#ifndef QMASK
#define QMASK 0x27
#endif
#ifndef WO_FP8
#define WO_FP8 1
#endif
constexpr int NQ8 = ((QMASK >> 0) & 1) + ((QMASK >> 1) & 1) + ((QMASK >> 2) & 1) + ((QMASK >> 3) & 1) + ((QMASK >> 4) & 1) + ((QMASK >> 5) & 1), NQ16 = 6 - NQ8;
constexpr float SC_WIN = 32.f, SC_AO = 16.f, SC_WO = 32.f;
__host__ __device__ constexpr int grp_rank(int w) { int c = 0; for (int i = 0; i < w; ++i) if (((QMASK >> i) & 1) == ((QMASK >> w) & 1)) ++c; return c; }
__device__ __forceinline__ int grp_nth_rank(int w) { int c = 0;
#pragma unroll
    for (int i = 0; i < 6; ++i) if (i < w && (((QMASK >> i) & 1) == ((QMASK >> w) & 1))) ++c; return c; }
__device__ __forceinline__ int grp_nth(int li, bool q8) { int r = 0, c = 0;
#pragma unroll
    for (int w = 0; w < 6; ++w) { const bool is8 = ((QMASK >> w) & 1) != 0; if (is8 == q8) { if (c == li) r = w; ++c; } } return r; }

constexpr size_t MiB = 1u << 20, KiB = 1u << 10;
constexpr size_t WS_CTL = 0, CTL_ZERO_BYTES = 1 * MiB;
constexpr size_t WS_WQKV = 2 * MiB;
constexpr size_t WS_WQ8 = 448 * MiB;
constexpr size_t WS_WO = 26 * MiB;
constexpr size_t WS_WGU = 34 * MiB;
constexpr size_t WS_WD = 98 * MiB;
constexpr size_t WS_WR = 130 * MiB;
constexpr size_t WS_LF = 130 * MiB + 256 * KiB;
constexpr size_t WS_C = 131 * MiB;
constexpr size_t WS_KMEAN = 131 * MiB + 512 * KiB;
constexpr size_t WS_TOKREC = 132 * MiB;
constexpr size_t WS_LIST = 133 * MiB;
constexpr size_t WS_RSR = 134 * MiB;
constexpr size_t WS_RSW = 135 * MiB;
constexpr size_t WS_SSQ = 136 * MiB;
constexpr size_t WS_A = 138 * MiB;
constexpr size_t WS_QKV = 202 * MiB;
constexpr size_t WS_XB = 202 * MiB;
constexpr size_t WS_Y = 266 * MiB;
constexpr size_t WS_XQ = 266 * MiB;
constexpr size_t WS_HQ = 416 * MiB;
constexpr size_t WS_END = 472 * MiB;
constexpr int CW_TMO = 0, CW_GCNT = 64, CW_BAR = 4096;

constexpr int LCTL_OFF = 0;
constexpr int RING_OFF = 1024, RING_BYTES = 131072;
constexpr int XTRA_OFF = RING_OFF + RING_BYTES;
constexpr int LDS_BYTES = 155648;

#define LDS_WAIT() asm volatile("s_waitcnt lgkmcnt(0)" ::: "memory")
#define VM_WAIT() asm volatile("s_waitcnt vmcnt(0)" ::: "memory")
__device__ __forceinline__ unsigned cvt_pk_bf16(float lo, float hi) { unsigned r; asm volatile("v_cvt_pk_bf16_f32 %0, %1, %2" : "=v"(r) : "v"(lo), "v"(hi)); return r; }
__device__ __forceinline__ unsigned cvt_pk4_fp8(float a, float b, float c, float d) { int w = __builtin_amdgcn_cvt_pk_fp8_f32(a, b, 0, false); w = __builtin_amdgcn_cvt_pk_fp8_f32(c, d, w, true); return (unsigned)w; }
__device__ __forceinline__ float bf2f(unsigned short b) { return __uint_as_float((unsigned)b << 16); }
__device__ __forceinline__ float bflo(unsigned w) { return __uint_as_float(w << 16); }
__device__ __forceinline__ float bfhi(unsigned w) { return __uint_as_float(w & 0xffff0000u); }
__device__ __forceinline__ float wave_sum(float v) {
#pragma unroll
    for (int o = 1; o < 64; o <<= 1) v += __shfl_xor(v, o);
    return v;
}

__device__ __forceinline__ int ltid() { int t = threadIdx.x; asm volatile("" : "+v"(t)); return t; }
namespace pg8 {
typedef unsigned short bf16_t;
constexpr int BM = 256, BK = 64, HALF = 128, HTB = HALF * BK * 2, STAGE_BYTES = 8 * HTB, NXCD = 8, WGM = 8;
__host__ __device__ __forceinline__ int lds_byte(int r, int c) { const int st = (r >> 4) * 2 + (c >> 5), rr = r & 15, cc = c & 31, ob = rr * 64 + cc * 2; return st * 1024 + (ob ^ (((ob >> 9) & 1) << 5)); }
__host__ __device__ __forceinline__ void stage_rc(int b, int& R, int& C) { const int st = b / 1024, sb = b % 1024, swz = sb ^ (((sb >> 9) & 1) << 5); R = (st >> 1) * 16 + swz / 64; C = (st & 1) * 32 + (swz % 64) / 2; }
__host__ __device__ __forceinline__ int perm32(int rho) { const int n = rho >> 4, i = rho & 15; return 8 * (i >> 2) + 4 * n + (i & 3); }

struct Unit { int pm, pn; };
struct Gemm { const bf16_t* A; const bf16_t* Bt; int M, N, K; };

struct StaticOrder {
    int nM, nN, nwg, G, c;
    __host__ __device__ void init(int M, int N, int G_, int c_) { nM = M / BM; nN = N / BM; nwg = nM * nN; G = G_; c = c_; }
    __host__ __device__ bool next(int i, Unit& u) const {
        const long L = (long)i * G + c; if (L >= nwg) return false;
        int wgid = (int)L; { const int q = nwg / NXCD, r = nwg % NXCD, xcd = wgid % NXCD, off = wgid / NXCD; wgid = (xcd < r ? xcd * (q + 1) : r * (q + 1) + (xcd - r) * q) + off; }
        const int nig = WGM * nN, gid = wgid / nig, fm = gid * WGM, gsz = (nM - fm) < WGM ? (nM - fm) : WGM;
        u.pm = fm + ((wgid % nig) % gsz); u.pn = (wgid % nig) / gsz; return true;
    }
    __device__ __forceinline__ int arow(const Unit&, int) const { return 0; }
};

template <class Epi, class Sched, bool ALIGN_EPI, bool GATHER, bool FP8 = false>
__device__ __forceinline__ void gemm_phase(LAS unsigned char* lds, const Gemm g, const Sched& S, Epi& E) {
    const int tid = ltid(), wid = __builtin_amdgcn_readfirstlane(tid >> 6), lane = tid & 63, wr = wid >> 2, wc = wid & 3, fr = lane & 15, fq = lane >> 4;
    const int RB = FP8 ? g.K : 2 * g.K  , nt = RB / (BK * 2);
    unsigned voffA[2], voffB[2];
#pragma unroll
    for (int i = 0; i < 2; ++i) { int R, C; stage_rc(tid * 16 + i * 8192, R, C); const int Rb = Epi::PERM ? ((R & ~31) + perm32(R & 31)) : R;
        voffA[i] = (unsigned)(R * RB + C * 2); voffB[i] = (unsigned)(Rb * RB + C * 2); }
    const size_t kstep = (size_t)(BK * 2);
    const size_t hstep = (size_t)HALF * RB;
    const size_t tstep = 2 * hstep;
    const unsigned ldsw = (unsigned)wid * 1024u;
    const int aoff = lds_byte(wr * 64 + fr, fq * 8), boff = lds_byte(wc * 32 + fr, fq * 8);
    const unsigned ldsu = (unsigned)(uintptr_t)lds; const unsigned abase = ldsu + (unsigned)aoff, bbase = ldsu + 4u * HTB + (unsigned)boff;
#define PG8_SA(b, h) (((b) * 2 + (h)) * HTB)
#define PG8_SB(b, h) ((4 + (b) * 2 + (h)) * HTB)
#define PG8_GLDS(gbase, voff32, ldsdst) asm volatile("s_mov_b32 m0, %2\n\ts_nop 0\n\tglobal_load_lds_dwordx4 %0, %1" :: "v"(voff32), "s"(gbase), "s"(ldsdst) : "memory", "m0")
#define PG8_STAGE(bufoff, gbase, voff) do { _Pragma("unroll") for (int _i = 0; _i < 2; ++_i) PG8_GLDS((const char*)(gbase), (voff)[_i], ldsu + (unsigned)((bufoff) + _i * 8192) + ldsw); } while (0)
#define PG8_STAGE_A(bufoff, gbase, h, VV) do { if constexpr (GATHER) { PG8_STAGE(bufoff, gbase, (VV)[h]); } else { PG8_STAGE(bufoff, (gbase) + (h) * hstep, voffA); } } while (0)
#define PG8_STAGE_A2(bufoff, gbase, h) do { if constexpr (GATHER) { if (last) PG8_STAGE(bufoff, gbase, nv[h]); else PG8_STAGE(bufoff, gbase, cv[h]); } else { PG8_STAGE(bufoff, (gbase) + (h) * hstep, voffA); } } while (0)
#define PG8_DSR(dst, base, off) asm volatile("ds_read_b128 %0, %1 offset:%2" : "=v"(dst) : "v"(base), "i"(off) : "memory")
#define PG8_LDA(dst, b, h) do { if constexpr (FP8) { _Pragma("unroll") for (int m = 0; m < 4; ++m) { i32x4 lo_, hi_; PG8_DSR(lo_, abase, PG8_SA(b, h) + m * 2048); PG8_DSR(hi_, abase, PG8_SA(b, h) + m * 2048 + 1024); dst##8[m] = __builtin_shufflevector(lo_, hi_, 0, 1, 2, 3, 4, 5, 6, 7); } } \
        else { _Pragma("unroll") for (int m = 0; m < 4; ++m) _Pragma("unroll") for (int k = 0; k < 2; ++k) PG8_DSR(dst[m][k], abase, PG8_SA(b, h) + m * 2048 + k * 1024); } } while (0)
#define PG8_LDB(dst, b, h) do { if constexpr (FP8) { _Pragma("unroll") for (int n = 0; n < 2; ++n) { i32x4 lo_, hi_; PG8_DSR(lo_, bbase, PG8_SA(b, h) + n * 2048); PG8_DSR(hi_, bbase, PG8_SA(b, h) + n * 2048 + 1024); dst##8[n] = __builtin_shufflevector(lo_, hi_, 0, 1, 2, 3, 4, 5, 6, 7); } } \
        else { _Pragma("unroll") for (int n = 0; n < 2; ++n) _Pragma("unroll") for (int k = 0; k < 2; ++k) PG8_DSR(dst[n][k], bbase, PG8_SA(b, h) + n * 2048 + k * 1024); } } while (0)
#define PG8_MMA(ai, bj, At, Bt) do { __builtin_amdgcn_s_setprio(1); _Pragma("unroll") for (int m = 0; m < 4; ++m) _Pragma("unroll") for (int n = 0; n < 2; ++n) { \
        if constexpr (FP8) acc[ai][bj][m][n] = __builtin_amdgcn_mfma_scale_f32_16x16x128_f8f6f4(Bt##8[n], At##8[m], acc[ai][bj][m][n], 0, 0, 0, 0, 0, 0); \
        else { _Pragma("unroll") for (int k = 0; k < 2; ++k) acc[ai][bj][m][n] = __builtin_amdgcn_mfma_f32_16x16x32_bf16(Bt[n][k], At[m][k], acc[ai][bj][m][n], 0, 0, 0); } } __builtin_amdgcn_s_setprio(0); } while (0)
#define PG8_WAIT_V(n) asm volatile("s_waitcnt vmcnt(" #n ")" ::: "memory")
#define PG8_WAIT_L(n) asm volatile("s_waitcnt lgkmcnt(" #n ")" ::: "memory")
#define PG8_BAR __builtin_amdgcn_s_barrier()
#define PG8_SCHED __builtin_amdgcn_sched_barrier(0)
    Unit cur, nxt; int ui = 0;
    if (!S.next(0, cur)) return;
    f32x4 acc[2][2][4][2];
#pragma unroll
    for (int a = 0; a < 2; ++a)
#pragma unroll
        for (int b = 0; b < 2; ++b)
#pragma unroll
            for (int m = 0; m < 4; ++m)
#pragma unroll
                for (int n = 0; n < 2; ++n) acc[a][b][m][n] = (f32x4){0.f, 0.f, 0.f, 0.f};
    bf16x8 At[4][2], B0[2][2], B1[2][2];
    i32x8 At8[4], B08[2], B18[2];
    unsigned cv[2][2], nv[2][2];
#define PG8_GOFF(dst, unit) do { const int t2_ = ltid(); _Pragma("unroll") for (int i_ = 0; i_ < 2; ++i_) { int R_, C_; stage_rc(t2_ * 16 + i_ * 8192, R_, C_); \
        _Pragma("unroll") for (int h_ = 0; h_ < 2; ++h_) dst[h_][i_] = (unsigned)S.arow(unit, h_ * HALF + R_) * (unsigned)RB + (unsigned)C_ * 2u; } } while (0)
    if constexpr (GATHER) {
        PG8_GOFF(cv, cur);
#pragma unroll
        for (int h = 0; h < 2; ++h)
#pragma unroll
            for (int i = 0; i < 2; ++i) nv[h][i] = cv[h][i];
    } else {
#pragma unroll
        for (int h = 0; h < 2; ++h)
#pragma unroll
            for (int i = 0; i < 2; ++i) { cv[h][i] = 0u; nv[h][i] = 0u; }
    }
    const char* cA = GATHER ? (const char*)g.A : (const char*)g.A + (size_t)cur.pm * tstep; const char* cB = (const char*)g.Bt + (size_t)cur.pn * tstep;
    PG8_STAGE(PG8_SB(0, 0), cB, voffB); PG8_STAGE(PG8_SB(0, 1), cB + hstep, voffB); PG8_STAGE_A(PG8_SA(0, 0), cA, 0, cv); PG8_STAGE_A(PG8_SA(0, 1), cA, 1, cv);
    if (wr == 1) PG8_BAR;
    PG8_WAIT_V(2); PG8_BAR;
    PG8_STAGE(PG8_SB(1, 0), cB + kstep, voffB); PG8_STAGE_A(PG8_SA(1, 0), cA + kstep, 0, cv); PG8_STAGE(PG8_SB(1, 1), cB + hstep + kstep, voffB);
    PG8_WAIT_V(6); PG8_BAR;
    for (;;) {
        if constexpr (Epi::MIDK) E.begin(cur, wr, fr);
        const bool has_next = S.next(ui + 1, nxt);
        const char* nA = GATHER ? (const char*)g.A : (has_next ? (const char*)g.A + (size_t)nxt.pm * tstep : cA); const char* nB = has_next ? (const char*)g.Bt + (size_t)nxt.pn * tstep : cB;
        if constexpr (GATHER) {
            if (has_next) PG8_GOFF(nv, nxt);
        }
#pragma nounroll
        for (int t = 0; t < nt; t += 2) {
            const bool last = (t == nt - 2);
            if constexpr (Epi::MIDK) { if (t == (nt >> 1)) E.midk(acc); }
            const char* a1 = cA + (size_t)(t + 1) * kstep;
            const char* a2 = last ? nA : cA + (size_t)(t + 2) * kstep; const char* b2 = last ? nB : cB + (size_t)(t + 2) * kstep;
            const char* a3 = a2 + kstep; const char* b3 = b2 + kstep;
            PG8_LDB(B0, 0, 0); PG8_LDB(B1, 0, 1); PG8_SCHED; PG8_LDA(At, 0, 0); PG8_STAGE_A(PG8_SA(1, 1), a1, 1, cv);
            PG8_WAIT_V(8); PG8_WAIT_L(0); PG8_BAR; PG8_SCHED; PG8_MMA(0, 0, At, B0); PG8_MMA(0, 1, At, B1); PG8_BAR; PG8_SCHED;
            PG8_LDA(At, 0, 1); PG8_STAGE(PG8_SB(0, 0), b2, voffB); PG8_STAGE(PG8_SB(0, 1), b2 + hstep, voffB); PG8_STAGE_A2(PG8_SA(0, 0), a2, 0);
            PG8_WAIT_V(8); PG8_WAIT_L(0); PG8_BAR; PG8_SCHED; PG8_MMA(1, 0, At, B0); PG8_MMA(1, 1, At, B1); PG8_BAR; PG8_SCHED;
            PG8_LDB(B0, 1, 0); PG8_LDB(B1, 1, 1); PG8_SCHED; PG8_LDA(At, 1, 0); PG8_STAGE_A2(PG8_SA(0, 1), a2, 1);
            PG8_WAIT_V(8); PG8_WAIT_L(0); PG8_BAR; PG8_SCHED; PG8_MMA(0, 0, At, B0); PG8_MMA(0, 1, At, B1); PG8_BAR; PG8_SCHED;
            PG8_LDA(At, 1, 1); PG8_STAGE(PG8_SB(1, 0), b3, voffB); PG8_STAGE(PG8_SB(1, 1), b3 + hstep, voffB); PG8_STAGE_A2(PG8_SA(1, 0), a3, 0);
            PG8_WAIT_V(8); PG8_WAIT_L(0); PG8_BAR; PG8_SCHED; PG8_MMA(1, 0, At, B0); PG8_MMA(1, 1, At, B1); PG8_BAR; PG8_SCHED;
        }
        if constexpr (ALIGN_EPI) { if (wr == 0) PG8_BAR; }
        { const int l_ = ltid() & 63; E(acc, cur, wr, wc, l_ & 15, l_ >> 4); }
        if (!has_next) break;
#pragma unroll
        for (int a = 0; a < 2; ++a)
#pragma unroll
            for (int b = 0; b < 2; ++b)
#pragma unroll
                for (int m = 0; m < 4; ++m)
#pragma unroll
                    for (int n = 0; n < 2; ++n) acc[a][b][m][n] = (f32x4){0.f, 0.f, 0.f, 0.f};
        cur = nxt; cA = nA; cB = nB; ++ui;
#pragma unroll
        for (int h = 0; h < 2; ++h)
#pragma unroll
            for (int i = 0; i < 2; ++i) cv[h][i] = nv[h][i];
        if constexpr (ALIGN_EPI) { if (wr == 1) PG8_BAR; }
    }
    PG8_WAIT_V(0);
    if constexpr (!ALIGN_EPI) { if (wr == 0) PG8_BAR; }
    PG8_BAR;
#undef PG8_SA
#undef PG8_SB
#undef PG8_STAGE
#undef PG8_STAGE_A
#undef PG8_STAGE_A2
#undef PG8_LDA
#undef PG8_LDB
#undef PG8_MMA
#undef PG8_GOFF
#undef PG8_GLDS
#undef PG8_DSR
#undef PG8_WAIT_V
#undef PG8_WAIT_L
#undef PG8_BAR
#undef PG8_SCHED
}
}


namespace att {
constexpr int D = 128, NW = 8, QBLK = 32, KVBLK = 64, QB = 256;
constexpr int SHM_V = 16384, SHM_K = 16384;
constexpr int OFF_WS = 2 * SHM_V + 2 * SHM_K, OFF_KBF = OFF_WS + NW * 256, OFF_LUT = OFF_KBF + 16384, LDS_ATT = OFF_LUT + 2304;
constexpr float SCALE = 0.08838834764831845f, ISCALE = 11.313708498984761f, THR = 8.f;
typedef short s16x4 __attribute__((ext_vector_type(4)));
typedef float f32x16 __attribute__((ext_vector_type(16)));
#define KSWZ(row, colB) ((row) * 256 + ((colB) ^ (((row) & 7) << 4)))
#define SBAR() __builtin_amdgcn_sched_barrier(0)
__device__ __forceinline__ int v_st(int k, int c) { const int kk = (k & ~0xC) | ((k & 4) << 1) | ((k & 8) >> 1); return ((kk >> 3) * 4 + (c >> 5)) * 512 + ((kk & 7) * 32 + (c & 31)) * 2; }
__device__ __forceinline__ int v_rd_base(int lane) { return ((lane & 3) << 3) | (((lane >> 2) & 3) << 6) | (((lane >> 4) & 1) << 5) | (((lane >> 5) & 1) << 8); }
constexpr int v_rd_off(int d0, int ks, int half) { return d0 * 512 + ks * 4096 + half * 2048; }
__device__ __forceinline__ int crow(int r, int hi) { return (r & 3) + 8 * (r >> 2) + 4 * hi; }
__device__ __forceinline__ unsigned cvtpk(float lo, float hi) { unsigned r; asm volatile("v_cvt_pk_bf16_f32 %0, %1, %2" : "=v"(r) : "v"(lo), "v"(hi)); return r; }
__device__ __forceinline__ void mask_tile(f32x16& p0, f32x16& p1, int dq) {
    const float NEG = -__builtin_inff();
#pragma unroll
    for (int r = 0; r < 16; ++r) { const int c = (r & 3) + 8 * (r >> 2);
        if (dq - c < 0) p0[r] = NEG;
        if (dq - c - 32 < 0) p1[r] = NEG; }
}
__device__ __forceinline__ void partialSM(f32x16& p0, f32x16& p1, float& m_reg, float& mn, float& alpha) {
    float pmax = p0[0]; for (int r = 1; r < 16; ++r) pmax = fmaxf(pmax, p0[r]); for (int r = 0; r < 16; ++r) pmax = fmaxf(pmax, p1[r]);
    { auto rr = __builtin_amdgcn_permlane32_swap(__float_as_uint(pmax), __float_as_uint(pmax), false, false);
      pmax = fmaxf(__uint_as_float(rr[0]), __uint_as_float(rr[1])); }
    constexpr float C2 = 1.4426950408889634f * SCALE;
    if (__builtin_expect(__all((pmax - m_reg) * SCALE <= THR), 1)) { mn = m_reg; alpha = 1.f; }
    else { mn = fmaxf(m_reg, pmax); alpha = __builtin_amdgcn_exp2f((m_reg - mn) * C2); m_reg = mn; }
    const float mnL = -mn * C2;
    for (int r = 0; r < 16; ++r) p0[r] = fmaf(p0[r], C2, mnL); for (int r = 0; r < 16; ++r) p1[r] = fmaf(p1[r], C2, mnL);
    for (int r = 0; r < 16; ++r) p0[r] = __builtin_amdgcn_exp2f(p0[r]);
}
__device__ __forceinline__ void finishSM(f32x16& p0, f32x16& p1, float alpha, float& l_reg, bf16x8& pa0, bf16x8& pa1, bf16x8& pa2, bf16x8& pa3) {
    for (int r = 0; r < 16; ++r) p1[r] = __builtin_amdgcn_exp2f(p1[r]);
    float ps = 0; for (int r = 0; r < 16; ++r) ps += p0[r]; for (int r = 0; r < 16; ++r) ps += p1[r];
    { auto rr = __builtin_amdgcn_permlane32_swap(__float_as_uint(ps), __float_as_uint(ps), false, false);
      ps = __uint_as_float(rr[0]) + __uint_as_float(rr[1]); }
    l_reg = l_reg * alpha + ps;
#define PK4(P, B_, OUT) do { unsigned a0 = cvtpk(P[B_+0], P[B_+1]), a1 = cvtpk(P[B_+2], P[B_+3]);                          \
        unsigned b0 = cvtpk(P[B_+4], P[B_+5]), b1 = cvtpk(P[B_+6], P[B_+7]);                                             \
        auto r0 = __builtin_amdgcn_permlane32_swap(a0, b0, false, false); auto r1 = __builtin_amdgcn_permlane32_swap(a1, b1, false, false); \
        u32x4 w = {r0[0], r1[0], r0[1], r1[1]}; OUT = *reinterpret_cast<bf16x8*>(&w); } while (0)
    PK4(p0, 0, pa0); PK4(p0, 8, pa1); PK4(p1, 0, pa2); PK4(p1, 8, pa3);
#undef PK4
}
struct InitCtx {
    const LAS float* kbl;
    int own, qlo, qpos4;
    unsigned sel;
};
template <int KB, int MODE>
__device__ __forceinline__ void qkt(f32x16& p0, f32x16& p1, const char* K_lds, int r32, int hi, const bf16x8* qr, const InitCtx& ic, int kbase) {
    if (MODE == 0) {
        const LAS float* kb = ic.kbl + kbase;
#pragma unroll
        for (int i = 0; i < 4; ++i) { const f32x4 a = *(const LAS f32x4*)(kb + 8 * i), b = *(const LAS f32x4*)(kb + 32 + 8 * i);
            p0[4 * i] = a[0]; p0[4 * i + 1] = a[1]; p0[4 * i + 2] = a[2]; p0[4 * i + 3] = a[3]; p1[4 * i] = b[0]; p1[4 * i + 1] = b[1]; p1[4 * i + 2] = b[2]; p1[4 * i + 3] = b[3]; }
    } else {
        const int jb = kbase >> 8; const bool rowok = (jb >= ic.own) || (((ic.sel >> jb) & 1u) != 0u);
        int B = ic.qpos4 - kbase + 256 - 59; B = B > 384 ? 384 : B; B = rowok ? B : 512; asm volatile("" : "+v"(B));
        const LAS float* lp = ic.kbl + B;
#pragma unroll
        for (int r = 0; r < 16; ++r) { const int c = (r & 3) + 8 * (r >> 2); p0[r] = lp[59 - c]; p1[r] = lp[59 - c - 32]; }
    }
    const char* kb[4];
#pragma unroll
    for (int dd = 0; dd < 4; ++dd) kb[dd] = K_lds + KB * SHM_K + KSWZ(r32, (dd * 16 + hi * 8) * 2);
#pragma unroll
    for (int d0 = 0; d0 < 8; ++d0) { const char* a = kb[d0 & 3] + (d0 >> 2) * 128;
        bf16x8 b0 = *reinterpret_cast<const bf16x8*>(a);
        bf16x8 b1 = *reinterpret_cast<const bf16x8*>(a + 32 * 256);
        p0 = __builtin_amdgcn_mfma_f32_32x32x16_bf16(b0, qr[d0], p0, 0, 0, 0);
        p1 = __builtin_amdgcn_mfma_f32_32x32x16_bf16(b1, qr[d0], p1, 0, 0, 0); }
}
template <int VB>
__device__ __forceinline__ void pv_tile(f32x16* o, int vb0, bf16x8 pa0, bf16x8 pa1, bf16x8 pa2, bf16x8 pa3) {
#define TRRD(dst, off) asm volatile("ds_read_b64_tr_b16 %0, %1 offset:%2" : "=&v"(dst) : "v"(vb0), "i"(off) : "memory")
#define PV_D0(d0) do { s16x4 l0, l1, l2, l3, h0, h1, h2, h3; constexpr int b_ = VB * SHM_V + v_rd_off(d0, 0, 0); \
        TRRD(l0, b_); TRRD(h0, b_ + 2048); TRRD(l1, b_ + 4096); TRRD(h1, b_ + 6144); TRRD(l2, b_ + 8192); TRRD(h2, b_ + 10240); TRRD(l3, b_ + 12288); TRRD(h3, b_ + 14336); \
        asm volatile("s_waitcnt lgkmcnt(0)" ::: "memory"); SBAR();   \
        o[d0] = __builtin_amdgcn_mfma_f32_32x32x16_bf16(pa0, (bf16x8){l0[0], l0[1], l0[2], l0[3], h0[0], h0[1], h0[2], h0[3]}, o[d0], 0, 0, 0);   \
        o[d0] = __builtin_amdgcn_mfma_f32_32x32x16_bf16(pa1, (bf16x8){l1[0], l1[1], l1[2], l1[3], h1[0], h1[1], h1[2], h1[3]}, o[d0], 0, 0, 0);   \
        o[d0] = __builtin_amdgcn_mfma_f32_32x32x16_bf16(pa2, (bf16x8){l2[0], l2[1], l2[2], l2[3], h2[0], h2[1], h2[2], h2[3]}, o[d0], 0, 0, 0);   \
        o[d0] = __builtin_amdgcn_mfma_f32_32x32x16_bf16(pa3, (bf16x8){l3[0], l3[1], l3[2], l3[3], h3[0], h3[1], h3[2], h3[3]}, o[d0], 0, 0, 0); } while (0)
    PV_D0(0); PV_D0(1); PV_D0(2); PV_D0(3);
#undef PV_D0
#undef TRRD
}
struct BlockRef { const bf16* Q; const bf16* K; const bf16* V; unsigned char* O; float* SS; int P0; int bh; };
struct Seam { bf16x8 qr[8]; bf16x8 st_v0, st_v1, st_k0, st_k1; };
#define ROW(p, k0, rr) ((p) + (size_t)((k0) + (rr)) * D + sc)
#define VMW() asm volatile("s_waitcnt vmcnt(0)" ::: "memory")
#define VMWN(n) asm volatile("s_waitcnt vmcnt(%0)" :: "i"(n) : "memory")
#define LD8(p) (*reinterpret_cast<const bf16x8*>(p))
#define SLOAD_H(Kp, Vp, k0) do { S.st_v0 = LD8(ROW(Vp, k0, sr)); S.st_v1 = LD8(ROW(Vp, k0, 32 + sr));              \
                         S.st_k0 = LD8(ROW(Kp, k0, sr)); S.st_k1 = LD8(ROW(Kp, k0, 32 + sr)); } while (0)
#define SWRITE_HK(bf) do { *(bf16x8*)(K_lds + (bf) * SHM_K + kws) = S.st_k0; *(bf16x8*)(K_lds + (bf) * SHM_K + kws + 32 * 256) = S.st_k1; } while (0)
#define SWRITE_HV(bf) do { *(bf16x8*)(V_lds + (bf) * SHM_V + vst0) = S.st_v0; *(bf16x8*)(V_lds + (bf) * SHM_V + vst1) = S.st_v1; } while (0)
#define SWRITE_H(bf) do { SWRITE_HV(bf); SWRITE_HK(bf); } while (0)
__device__ __forceinline__ void attn_prime(const BlockRef& cur, char* lds, Seam& S) {
    const int tid = ltid(), wid = __builtin_amdgcn_readfirstlane(tid >> 6), lane = tid & 63, r32 = lane & 31, hi = lane >> 5;
    const int sr = tid >> 4, sc = (tid & 15) * 8, kws = KSWZ(sr, sc * 2); char* K_lds = lds + 2 * SHM_V;
    for (int d0 = 0; d0 < 8; ++d0) S.qr[d0] = LD8(cur.Q + (size_t)(wid * QBLK + r32) * D + d0 * 16 + hi * 8);
    SLOAD_H(cur.K, cur.V, 0); VMW(); SWRITE_HK(0);
    __syncthreads();
}
template <int MODE>
__device__ __forceinline__ void attn_block(const BlockRef& cur, const BlockRef& nxt, LAS unsigned char* L, Seam& S, const float* cbuf, const bf16* kmean, const float* rel_bias) {
    char* lds = (char*)L;
    const int tid = ltid(), wid = __builtin_amdgcn_readfirstlane(tid >> 6), lane = tid & 63, r32 = lane & 31, hi = lane >> 5;
    const int NT = (cur.P0 + QB) / KVBLK;
    const int qlo = cur.P0 + wid * QBLK, qm = qlo + r32 - 4 * hi;
    char* V_lds = lds; char* K_lds = lds + 2 * SHM_V;
    float* ws = (float*)(lds + OFF_WS) + wid * 64; float* li_l = ws, * al_l = ws + 32;
    float m_reg = -1e30f, l_reg = 0; f32x16 o[4] = {};
    const int sr = tid >> 4, sc = (tid & 15) * 8, vst0 = v_st(sr, sc), vst1 = v_st(32 + sr, sc), kws = KSWZ(sr, sc * 2);
    const int vb0 = (int)(uintptr_t)V_lds + v_rd_base(lane);
    const bf16* Kh = cur.K; const bf16* Vh = cur.V;
    InitCtx ic; ic.own = cur.P0 >> 8; ic.qlo = qlo; ic.qpos4 = qm; ic.sel = 0u;
    const int h = cur.bh & 7;
    if (MODE == 0) {
        LAS float* kbf = (LAS float*)(L + OFF_KBF);
        const float* cs = cbuf + (size_t)cur.bh * SEQ; const float cref = cs[cur.P0];
        for (int j = tid; j < cur.P0 + QB; j += NTHR) kbf[j] = (cref - cs[j]) * ISCALE;
        ic.kbl = kbf + 4 * hi;
    } else {
        LAS float* lutX = (LAS float*)(L + OFF_LUT);
        { int d = tid - 256; if (d < 0) d = 0; if (d > 128) d = 128; int bk; if (d < 16) bk = d; else { bk = 16 + (int)(logf((float)d / 16.0f) / 2.0794415416798357f * 16.0f); if (bk > 31) bk = 31; }
          lutX[tid] = rel_bias[h * 32 + bk] * ISCALE; if (tid < 64) lutX[512 + tid] = -__builtin_inff(); }
        ic.kbl = lutX;
        f32x16 g = {};
        const bf16* km = kmean + ((size_t)cur.bh * 16 + (r32 & 15)) * 128 + hi * 8;
#pragma unroll
        for (int d0 = 0; d0 < 8; ++d0) { bf16x8 a = LD8(km + d0 * 16); if (r32 >= 16) a = (bf16x8){0, 0, 0, 0, 0, 0, 0, 0}; g = __builtin_amdgcn_mfma_f32_32x32x16_bf16(a, S.qr[d0], g, 0, 0, 0); }
        float gt[16];
#pragma unroll
        for (int n = 0; n < 16; ++n) { const int hh = (n >> 2) & 1, r = (n & 3) + 4 * (n >> 3); const float mine = g[r], oth = __shfl_xor(mine, 32); gt[n] = (hh == hi) ? mine : oth; }
        unsigned sel = 0u;
#pragma unroll
        for (int k = 0; k < 3; ++k) { float best = -__builtin_inff(); int bi = 16;
#pragma unroll
            for (int n = 0; n < 16; ++n) { const bool ok = (n < ic.own) && (((sel >> n) & 1u) == 0u) && (gt[n] > best); best = ok ? gt[n] : best; bi = ok ? n : bi; }
            if (bi < 16) sel |= 1u << bi; }
        ic.sel = sel;
    }
    __syncthreads();
#define RESC(a) do { if (__any((a) < 1.f)) { if (hi == 0) al_l[r32] = (a); asm volatile("s_waitcnt lgkmcnt(0)" ::: "memory");              \
                     for (int d_ = 0; d_ < 4; ++d_) for (int r = 0; r < 16; ++r) o[d_][r] *= al_l[crow(r, hi)]; } } while (0)
#define KBASE(t) ((t) * KVBLK)
#define MASKT(P0_, P1_, t) do { const int kb_ = KBASE(t); if (kb_ + KVBLK - 1 > qlo) mask_tile(P0_, P1_, qm - kb_); } while (0)
    constexpr int NQL = 8;
#define SEAM_K0() do { VMWN(NQL); SWRITE_HK(0); SBAR(); } while (0)
    f32x16 pA0, pA1, pB0, pB1; float mnA, mnB, alA, alB; bf16x8 pa0, pa1, pa2, pa3;
    SWRITE_HV(0); SBAR();
    if (NT > 1) { SLOAD_H(Kh, Vh, KBASE(1)); }
    SBAR(); qkt<0, MODE>(pA0, pA1, K_lds, r32, hi, S.qr, ic, KBASE(0));
    MASKT(pA0, pA1, 0); partialSM(pA0, pA1, m_reg, mnA, alA);
    if (NT > 1) { VMW(); SWRITE_H(1); }
    __syncthreads();
#define HALF_STEP(PX0, PX1, mnX, alX, PY0, PY1, alY, t, KB, VB, SB) do {                                                      \
        SBAR(); qkt<KB, MODE>(PX0, PX1, K_lds, r32, hi, S.qr, ic, KBASE(t));                                             \
        finishSM(PY0, PY1, alY, l_reg, pa0, pa1, pa2, pa3); SBAR();                                                           \
        if ((t) + 1 < NT) { SLOAD_H(Kh, Vh, KBASE((t) + 1)); SBAR(); }                                               \
        pv_tile<VB>(o, vb0, pa0, pa1, pa2, pa3); MASKT(PX0, PX1, (t)); partialSM(PX0, PX1, m_reg, mnX, alX);                                        \
        __syncthreads();                                                                                                      \
        if ((t) + 1 < NT) { VMW(); SWRITE_H(SB); }                                                                          \
        RESC(alX); __syncthreads(); } while (0)
    for (int t = 1; t + 1 < NT; t += 2) {
        HALF_STEP(pB0, pB1, mnB, alB, pA0, pA1, alA, t, 1, 0, 0);
        HALF_STEP(pA0, pA1, mnA, alA, pB0, pB1, alB, t + 1, 0, 1, 1);
    }
    const bool even = (NT & 1) == 0;
    if (even) { SBAR(); qkt<1, MODE>(pB0, pB1, K_lds, r32, hi, S.qr, ic, KBASE(NT - 1)); SBAR(); }
    SLOAD_H(nxt.K, nxt.V, 0); SBAR();
#pragma unroll
    for (int d0 = 0; d0 < 8; ++d0) S.qr[d0] = LD8(nxt.Q + (size_t)(wid * QBLK + r32) * D + d0 * 16 + hi * 8);
    SBAR();
    finishSM(pA0, pA1, alA, l_reg, pa0, pa1, pa2, pa3); SBAR();
    pv_tile<0>(o, vb0, pa0, pa1, pa2, pa3);
    if (even) { MASKT(pB0, pB1, NT - 1); partialSM(pB0, pB1, m_reg, mnB, alB); __syncthreads(); RESC(alB);
        finishSM(pB0, pB1, alB, l_reg, pa0, pa1, pa2, pa3); SBAR(); pv_tile<1>(o, vb0, pa0, pa1, pa2, pa3); }
    SBAR(); SEAM_K0();
    if (hi == 0) li_l[r32] = l_reg; asm volatile("s_waitcnt lgkmcnt(0)" ::: "memory");
    float rli[16];
#pragma unroll
    for (int r = 0; r < 16; ++r) rli[r] = __builtin_amdgcn_rcpf(li_l[crow(r, hi)]);
    unsigned char* Ow = cur.O + (size_t)(wid * QBLK) * DM * (WO_FP8 ? 1 : 2); float* Sw = cur.SS + (size_t)(wid * QBLK) * 16;
#pragma unroll
    for (int r = 0; r < 16; ++r) { const int orow = crow(r, hi); float sq = 0.f;
#pragma unroll
        for (int d0 = 0; d0 < 4; ++d0) { const float v = o[d0][r] * rli[r]; sq += v * v;
            if (WO_FP8) { const float vs = v * SC_AO, v1 = __shfl_xor(vs, 1); const float a = (r32 & 1) ? v1 : vs, b = (r32 & 1) ? vs : v1;
                const float a2 = __shfl_xor(a, 2), b2 = __shfl_xor(b, 2);
                if ((r32 & 3) == 0) *(unsigned*)(Ow + (size_t)orow * DM + d0 * 32 + r32) = cvt_pk4_fp8(a, b, a2, b2); }
            else { const float vn = __shfl_xor(v, 1);
                if ((r32 & 1) == 0) *(unsigned*)(Ow + ((size_t)orow * DM + d0 * 32 + r32) * 2) = cvtpk(v, vn); } }
        sq += __shfl_xor(sq, 1); sq += __shfl_xor(sq, 2); sq += __shfl_xor(sq, 4); sq += __shfl_xor(sq, 8); sq += __shfl_xor(sq, 16);
        if (r32 == 0) Sw[(size_t)orow * 16] = sq; }
    __syncthreads();
#undef RESC
#undef KBASE
#undef MASKT
#undef SEAM_K0
#undef HALF_STEP
}
#undef ROW
#undef VMW
#undef VMWN
#undef LD8
#undef SLOAD_H
#undef SWRITE_HK
#undef SWRITE_HV
#undef SWRITE_H
#undef KSWZ
#undef SBAR
}

#define XB_TMO      128
#define XB_XCNT(j)  (256  + 64 * (j))
#define XB_XSUB(j)  (1280 + 64 * (j))
#define XB_XGEN(j)  (2304 + 64 * (j))
#define XB_TOP      3328
#define XB_TOPGEN   3392
#define XCD_BAR_WORDS 3456
#define XB_SPIN_CAP (1u << 18)
__device__ __forceinline__ unsigned xb_ld(unsigned* p)              { return __hip_atomic_load(p, __ATOMIC_RELAXED, __HIP_MEMORY_SCOPE_AGENT); }
__device__ __forceinline__ unsigned xb_add(unsigned* p, unsigned v) { return __hip_atomic_fetch_add(p, v, __ATOMIC_RELAXED, __HIP_MEMORY_SCOPE_AGENT); }
__device__ __forceinline__ unsigned xb_xcc_id() { return (unsigned)__builtin_amdgcn_s_getreg((3 << 11) | 20) & 0xFu; }
#define XB_SPIN(cond, bar) do { unsigned _sp = 0; while (cond) { __builtin_amdgcn_s_sleep(1); \
    if ((++_sp & 255u) == 0u) { if (xb_ld(&(bar)[XB_TMO])) break; if (_sp > XB_SPIN_CAP) { atomicAdd(&(bar)[XB_TMO], 1u); break; } } } } while (0)
struct XcdBarrier { unsigned* bar; unsigned x; volatile LAS unsigned* st; };
__device__ __forceinline__ XcdBarrier xcd_barrier_post(unsigned* bar, volatile LAS unsigned* st) {
    XcdBarrier b; b.bar = bar; b.x = xb_xcc_id(); b.st = st;
    if (threadIdx.x == 0) (void)xb_add(&bar[XB_XCNT(b.x)], 1u);
    return b;
}
__device__ __forceinline__ void xcd_barrier_complete(unsigned* bar, unsigned x, unsigned& nloc, unsigned& nx) {
    const unsigned G = gridDim.x * gridDim.y * gridDim.z;
    unsigned sum, cnt, mine, sp = 0u;
    for (;;) {
        sum = 0u; cnt = 0u; mine = 0u;
#pragma unroll
        for (unsigned j = 0; j < 16; ++j) { const unsigned c = xb_ld(&bar[XB_XCNT(j)]); sum += c; cnt += (c > 0u) ? 1u : 0u; mine = (j == x) ? c : mine; }
        if (sum == G) break;
        __builtin_amdgcn_s_sleep(1);
        if ((++sp & 255u) == 0u) { if (xb_ld(&bar[XB_TMO])) break; if (sp > XB_SPIN_CAP) { atomicAdd(&bar[XB_TMO], 1u); break; } }
    }
    nloc = mine > 0u ? mine : 1u; nx = cnt > 0u ? cnt : 1u;
}
__device__ __forceinline__ void xcd_barrier(const XcdBarrier& b) {
    asm volatile("s_waitcnt vmcnt(0)" ::: "memory");
    __syncthreads();
    if (threadIdx.x == 0) {
        unsigned* bar = b.bar;
        __builtin_amdgcn_s_waitcnt(0);
        unsigned nloc = b.st[0], nx = b.st[1];
        if (nloc == 0u) { xcd_barrier_complete(bar, b.x, nloc, nx); b.st[0] = nloc; b.st[1] = nx; }
        const unsigned old = xb_add(&bar[XB_XSUB(b.x)], 1u);
        const unsigned gen = old / nloc;
        if (old + 1u == (gen + 1u) * nloc) {
            __builtin_amdgcn_fence(__ATOMIC_RELEASE, "agent");
            asm volatile("s_waitcnt vmcnt(0)" ::: "memory");
            const unsigned og = xb_add(&bar[XB_TOP], 1u);
            const unsigned tg = og / nx;
            if (og + 1u == (tg + 1u) * nx) xb_add(&bar[XB_TOPGEN], 1u);
            else XB_SPIN(xb_ld(&bar[XB_TOPGEN]) == tg, bar);
            __builtin_amdgcn_fence(__ATOMIC_ACQUIRE, "agent");
            xb_add(&bar[XB_XGEN(b.x)], 1u);
            asm volatile("s_waitcnt vmcnt(0)" ::: "memory");
        } else {
            XB_SPIN(xb_ld(&bar[XB_XGEN(b.x)]) == gen, bar);
            __builtin_amdgcn_fence(__ATOMIC_ACQUIRE, "agent");
            asm volatile("s_waitcnt vmcnt(0)" ::: "memory");
        }
    }
    __syncthreads();
}

struct Args { const float* in[17]; float* out; unsigned char* ws; int ph_lo, ph_hi; };
typedef const __attribute__((address_space(4))) Args* KArgP;
struct Frame {
    LAS unsigned char* lds; unsigned* ctl; unsigned char* ws;
    int tid, lane, wave, G, bx;
    KArgP ka;
};
#define INP(k) (F.ka->in[k])
__device__ __forceinline__ void phase_begin(Frame& F) {
    F.tid = ltid(); F.lane = F.tid & 63; F.wave = __builtin_amdgcn_readfirstlane(F.tid >> 6);
    KArgP p = (KArgP)__builtin_amdgcn_kernarg_segment_ptr(); asm volatile("" : "+s"(p)); F.ka = p;
}

template <bool Q8> struct EpiQKV {
    static constexpr bool PERM = true, MIDK = false;
    bf16* qkv;
    __device__ __forceinline__ void operator()(const f32x4 (&acc)[2][2][4][2], const pg8::Unit& u, int wr, int wc, int fr, int fq) const {
        const int which = grp_nth(u.pn >> 2, Q8), hp = u.pn & 3, b = (u.pm * 256) >> 12, s0 = (u.pm * 256) & 4095; const float sc = Q8 ? (1.0f / SC_WIN) : 1.0f;
#pragma unroll
        for (int ai = 0; ai < 2; ++ai)
#pragma unroll
            for (int m = 0; m < 4; ++m) { const int s = s0 + ai * 128 + wr * 64 + m * 16 + fr;
#pragma unroll
                for (int bj = 0; bj < 2; ++bj) { const int head = hp * 2 + bj;
                    bf16* dst = qkv + ((((size_t)(which * 4 + b) * 8 + head) * 4096 + s) * 128 + wc * 32 + 8 * fq);
                    const f32x4 v0 = acc[ai][bj][m][0] * sc, v1 = acc[ai][bj][m][1] * sc;
                    u32x4 w; w.x = cvt_pk_bf16(v0[0], v0[1]); w.y = cvt_pk_bf16(v0[2], v0[3]); w.z = cvt_pk_bf16(v1[0], v1[1]); w.w = cvt_pk_bf16(v1[2], v1[3]);
                    *(u32x4*)dst = w; } }
    }
};
struct EpiRes {
    static constexpr bool PERM = true, MIDK = true;
    const float* x; bf16* xb; unsigned char* xq; const float* ssqp;
    LAS float* tab; int par;
    __device__ __forceinline__ void begin(const pg8::Unit& u, int wr, int fr) {
        (void)wr; (void)fr; par ^= 1;
        const int t = ltid();
        if (t < 256) { const f32x4* p = (const f32x4*)(ssqp + (size_t)(u.pm * 256 + t) * 16); const f32x4 a = p[0], b = p[1], c = p[2], d = p[3];
            const float sf = ((a[0] + a[1]) + (a[2] + a[3])) + ((b[0] + b[1]) + (b[2] + b[3])), sm = ((c[0] + c[1]) + (c[2] + c[3])) + ((d[0] + d[1]) + (d[2] + d[3]));
            const float qf = sqrtf(sf * (1.0f / GWID) + EPS), qm = sqrtf(sm * (1.0f / GWID) + EPS);
            tab[par * 512 + t] = qm / qf; tab[par * 512 + 256 + t] = (WO_FP8 ? 1.0f / (SC_AO * SC_WO) : 1.0f) / qm; }
    }
    __device__ __forceinline__ void midk(f32x4 (&acc)[2][2][4][2]) const {
        const int t = ltid(), r0 = ((t >> 8) & 1) * 64 + (t & 15);
#pragma unroll
        for (int ai = 0; ai < 2; ++ai)
#pragma unroll
            for (int m = 0; m < 4; ++m) { const float rt = tab[par * 512 + ai * 128 + m * 16 + r0];
#pragma unroll
                for (int bj = 0; bj < 2; ++bj)
#pragma unroll
                    for (int n = 0; n < 2; ++n) acc[ai][bj][m][n] *= rt; }
    }
    __device__ __forceinline__ void operator()(const f32x4 (&acc)[2][2][4][2], const pg8::Unit& u, int wr, int wc, int fr, int fq) const {
        asm volatile("" : "+v"(fr), "+v"(fq));
        const int row0 = u.pm * 256 + wr * 64 + fr, col0 = u.pn * 256 + wc * 32 + 8 * fq;
        float rsm[2][4];
#pragma unroll
        for (int ai = 0; ai < 2; ++ai)
#pragma unroll
            for (int m = 0; m < 4; ++m) rsm[ai][m] = tab[par * 512 + 256 + ai * 128 + wr * 64 + m * 16 + fr];
#pragma unroll
        for (int ai = 0; ai < 2; ++ai) {
            f32x4 xv[4][2][2];
#pragma unroll
            for (int m = 0; m < 4; ++m)
#pragma unroll
                for (int bj = 0; bj < 2; ++bj)
#pragma unroll
                    for (int n = 0; n < 2; ++n) xv[m][bj][n] = *(const f32x4*)(x + (size_t)(row0 + ai * 128 + m * 16) * DM + col0 + bj * 128 + 4 * n);
#pragma unroll
            for (int m = 0; m < 4; ++m)
#pragma unroll
                for (int bj = 0; bj < 2; ++bj) { const float sc = rsm[ai][m]; const f32x4 v0 = xv[m][bj][0] + acc[ai][bj][m][0] * sc, v1 = xv[m][bj][1] + acc[ai][bj][m][1] * sc;
                    u32x4 w; w.x = cvt_pk_bf16(v0[0], v0[1]); w.y = cvt_pk_bf16(v0[2], v0[3]); w.z = cvt_pk_bf16(v1[0], v1[1]); w.w = cvt_pk_bf16(v1[2], v1[3]);
                    *(u32x4*)(xb + (size_t)(row0 + ai * 128 + m * 16) * DM + col0 + bj * 128) = w;
                    u32x2 q8; q8.x = cvt_pk4_fp8(v0[0], v0[1], v0[2], v0[3]); q8.y = cvt_pk4_fp8(v1[0], v1[1], v1[2], v1[3]);
                    *(u32x2*)(xq + (size_t)(row0 + ai * 128 + m * 16) * DM + col0 + bj * 128) = q8; }
        }
    }
};
struct MoeOrder {
    int G, c, ncol; const LAS int* tt;
    __device__ __forceinline__ bool next(int i, pg8::Unit& u) const {
        const int nt = __builtin_amdgcn_readfirstlane(tt[0]); const long L = (long)i * G + c; if (L >= (long)nt * ncol) return false;
        const int t = (int)(L / ncol), pnl = (int)(L % ncol); const int e = __builtin_amdgcn_readfirstlane(tt[16 + t]) & 0xff;
        u.pm = t; u.pn = e * ncol + pnl; return true;
    }
};
struct MoeGather : MoeOrder {
    const int* list;
    __device__ __forceinline__ int arow(const pg8::Unit& u, int r) const {
        const int w = __builtin_amdgcn_readfirstlane(tt[16 + u.pm]); const int e = w & 0xff, rb = w >> 8; const int cnt = __builtin_amdgcn_readfirstlane(tt[256 + e]);
        const int pos = rb * 256 + r; int tok = 0; if (pos < cnt) tok = list[e * ECAP + pos]; return tok;
    }
};
struct MoePlain : MoeOrder { __device__ __forceinline__ int arow(const pg8::Unit&, int) const { return 0; } };
struct EpiHid {
    static constexpr bool PERM = true, MIDK = false;
    unsigned char* hid; const float* rsr; const float* rsw; const LAS int* tt;
    __device__ __forceinline__ void operator()(const f32x4 (&acc)[2][2][4][2], const pg8::Unit& u, int wr, int wc, int fr, int fq) const {
        const int w = __builtin_amdgcn_readfirstlane(tt[16 + u.pm]); const int e = w & 0xff, rb = w >> 8, pnl = u.pn & 3; const int cnt = __builtin_amdgcn_readfirstlane(tt[256 + e]);
#pragma unroll
        for (int ai = 0; ai < 2; ++ai)
#pragma unroll
            for (int m = 0; m < 4; ++m) { const int r = ai * 128 + wr * 64 + m * 16 + fr, pos = rb * 256 + r; float rs = 0.f, cw = 0.f;
                if (pos < cnt) { rs = rsr[e * ECAP + pos] * (1.0f / SC_WGU); cw = rsw[e * ECAP + pos] * SC_HID; }
                float o[8];
#pragma unroll
                for (int n = 0; n < 2; ++n)
#pragma unroll
                    for (int j = 0; j < 4; ++j) { const float gv = acc[ai][0][m][n][j] * rs, uv = acc[ai][1][m][n][j] * rs; o[n * 4 + j] = gv / (1.f + __expf(-gv)) * uv * cw; }
                u32x2 pk; pk.x = cvt_pk4_fp8(o[0], o[1], o[2], o[3]); pk.y = cvt_pk4_fp8(o[4], o[5], o[6], o[7]);
                *(u32x2*)(hid + (size_t)(u.pm * 256 + r) * DE + pnl * 128 + wc * 32 + 8 * fq) = pk; }
    }
};
struct EpiY {
    static constexpr bool PERM = true, MIDK = false;
    bf16* y;
    __device__ __forceinline__ void operator()(const f32x4 (&acc)[2][2][4][2], const pg8::Unit& u, int wr, int wc, int fr, int fq) const {
        const int pnl = u.pn & 7;
#pragma unroll
        for (int ai = 0; ai < 2; ++ai)
#pragma unroll
            for (int m = 0; m < 4; ++m) { bf16* rowp = y + (size_t)(u.pm * 256 + ai * 128 + wr * 64 + m * 16 + fr) * DM + pnl * 256 + wc * 32 + 8 * fq;
#pragma unroll
                for (int bj = 0; bj < 2; ++bj) { const f32x4 v0 = acc[ai][bj][m][0] * (1.0f / (SC_HID * SC_WD)), v1 = acc[ai][bj][m][1] * (1.0f / (SC_HID * SC_WD));
                    u32x4 w; w.x = cvt_pk_bf16(v0[0], v0[1]); w.y = cvt_pk_bf16(v0[2], v0[3]); w.z = cvt_pk_bf16(v1[0], v1[1]); w.w = cvt_pk_bf16(v1[2], v1[3]);
                    *(u32x4*)(rowp + bj * 128) = w; } }
    }
};

__device__ __forceinline__ void tr_item(const float* src, int ldw, const float* gs, bf16* dst, int ldd, LAS float* scr, int lane) {
#pragma unroll 8
    for (int i = 0; i < 32; ++i) { const int kk = 2 * i + (lane >> 5); scr[kk * 33 + (lane & 31)] = src[(size_t)kk * ldw + (lane & 31)]; }
    const int c = lane & 7;
    f32x4 g0 = (f32x4){1.f, 1.f, 1.f, 1.f}, g1 = g0;
    if (gs) { g0 = *(const f32x4*)(gs + 8 * c); g1 = *(const f32x4*)(gs + 8 * c + 4); }
    LDS_WAIT(); asm volatile("" ::: "memory");
#pragma unroll
    for (int j = 0; j < 4; ++j) { const int n = (lane >> 3) + 8 * j; const LAS float* s = scr + (8 * c) * 33 + n;
        u32x4 o; o.x = cvt_pk_bf16(s[0 * 33] * g0[0], s[1 * 33] * g0[1]); o.y = cvt_pk_bf16(s[2 * 33] * g0[2], s[3 * 33] * g0[3]);
        o.z = cvt_pk_bf16(s[4 * 33] * g1[0], s[5 * 33] * g1[1]); o.w = cvt_pk_bf16(s[6 * 33] * g1[2], s[7 * 33] * g1[3]);
        *(u32x4*)(dst + (size_t)n * ldd + 8 * c) = o; }
    LDS_WAIT(); asm volatile("" ::: "memory");
}
__device__ __forceinline__ void tr_item_q(const float* src, int ldw, const float* gs, float scale, unsigned char* dst, int ldd, LAS float* scr, int lane) {
#pragma unroll 8
    for (int i = 0; i < 32; ++i) { const int kk = 2 * i + (lane >> 5); scr[kk * 33 + (lane & 31)] = src[(size_t)kk * ldw + (lane & 31)]; }
    const int c = lane & 7;
    f32x4 g0 = (f32x4){scale, scale, scale, scale}, g1 = g0;
    if (gs) { g0 = *(const f32x4*)(gs + 8 * c) * scale; g1 = *(const f32x4*)(gs + 8 * c + 4) * scale; }
    LDS_WAIT(); asm volatile("" ::: "memory");
#pragma unroll
    for (int j = 0; j < 4; ++j) { const int n = (lane >> 3) + 8 * j; const LAS float* s = scr + (8 * c) * 33 + n;
        u32x2 o; o.x = cvt_pk4_fp8(s[0 * 33] * g0[0], s[1 * 33] * g0[1], s[2 * 33] * g0[2], s[3 * 33] * g0[3]);
        o.y = cvt_pk4_fp8(s[4 * 33] * g1[0], s[5 * 33] * g1[1], s[6 * 33] * g1[2], s[7 * 33] * g1[3]);
        *(u32x2*)(dst + (size_t)n * ldd + 8 * c) = o; }
    LDS_WAIT(); asm volatile("" ::: "memory");
}
__device__ __forceinline__ void p0_prologue(Frame& F) {
    const float* x = INP(0); const float* g_attn = INP(1); const float* w_in = INP(2); const float* b_forget = INP(3);
    const float* g_fox = INP(4); const float* g_moba = INP(5); const float* w_out = INP(7); const float* g_ffn = INP(8);
    const float* w_gr = INP(9); const float* w_er = INP(11); const float* w_gate = INP(13); const float* w_up = INP(14); const float* w_down = INP(15);
    bf16* Wqkv = (bf16*)(F.ws + WS_WQKV); unsigned char* Wq8 = F.ws + WS_WQ8; bf16* Wo = (bf16*)(F.ws + WS_WO); unsigned char* Hq = F.ws + WS_HQ; unsigned char* Wgu = F.ws + WS_WGU; unsigned char* Wd = F.ws + WS_WD; bf16* Wr = (bf16*)(F.ws + WS_WR);
    bf16* Hb = (bf16*)(F.ws + WS_A); float* lf = (float*)(F.ws + WS_LF);
    LAS float* scr = (LAS float*)(F.lds + RING_OFF + F.wave * 8704);
    LAS float* wfgT = (LAS float*)(F.lds + RING_OFF + 8 * 8704);
    const int gw = F.bx * NWAVES + F.wave, NGW = F.G * NWAVES;
    for (int idx = F.tid; idx < 2048 * 8; idx += NTHR) { const int k = idx >> 3, hh = idx & 7; wfgT[hh * 2048 + k] = w_in[(size_t)k * WIN_LD + NQKV + hh] * g_attn[k]; }
    constexpr int I_IN = 32 * 192, I_O = 32 * 64, I_G = 16 * 32 * 16, I_D = 16 * 8 * 64, NITEMS = I_IN + I_O + 2 * I_G + I_D;
    for (int it = gw; it < NITEMS; it += NGW) {
        int r = it;
        if (r < I_IN) { const int kb = r / 192, nb = r % 192; const int w = nb >> 5, lrow = grp_nth_rank(w) * 1024 + 32 * (nb & 31); const float* src = w_in + (size_t)(64 * kb) * WIN_LD + 32 * nb;
            if ((QMASK >> w) & 1) tr_item_q(src, WIN_LD, g_attn + 64 * kb, SC_WIN, Wq8 + (size_t)lrow * DM + 64 * kb, DM, scr, F.lane);
            else tr_item(src, WIN_LD, g_attn + 64 * kb, Wqkv + (size_t)lrow * DM + 64 * kb, DM, scr, F.lane);
            continue; } r -= I_IN;
        if (r < I_O) { const int kb = r / 64, nb = r % 64; const int k0 = 64 * kb; const float* gs = (k0 < GWID) ? g_fox + k0 : g_moba + (k0 - GWID);
            if (WO_FP8) tr_item_q(w_out + (size_t)k0 * DM + 32 * nb, DM, gs, SC_WO, (unsigned char*)Wo + (size_t)(32 * nb) * DM + k0, DM, scr, F.lane);
            else tr_item(w_out + (size_t)k0 * DM + 32 * nb, DM, gs, Wo + (size_t)(32 * nb) * DM + k0, DM, scr, F.lane);
            continue; } r -= I_O;
        if (r < 2 * I_G) { const int up = r >= I_G; if (up) r -= I_G; const int e = r / 512, rr = r % 512, kb = rr / 16, nb = rr % 16; const int f0 = 32 * nb, tt = f0 >> 7, within = f0 & 127;
            const float* W = (up ? w_up : w_gate) + (size_t)e * DM * DE;
            tr_item_q(W + (size_t)(64 * kb) * DE + f0, DE, g_ffn + 64 * kb, SC_WGU, Wgu + ((size_t)e * 1024 + tt * 256 + up * 128 + within) * DM + 64 * kb, DM, scr, F.lane); continue; } r -= 2 * I_G;
        { const int e = r / 512, rr = r % 512, kb = rr / 64, nb = rr % 64;
            tr_item_q(w_down + (size_t)e * DE * DM + (size_t)(64 * kb) * DM + 32 * nb, DM, nullptr, SC_WD, Wd + ((size_t)e * DM + 32 * nb) * DE + 64 * kb, DE, scr, F.lane); }
    }
    for (int idx = (F.bx * NTHR + F.tid); idx < NRC * DM; idx += F.G * NTHR) { const int n = idx >> 11, k = idx & 2047;
        float v = 0.f; if (n < 4) v = w_gr[k * 4 + n]; else if (n < 20) v = w_er[k * 16 + (n - 4)];
        Wr[idx] = (bf16)(cvt_pk_bf16(v * g_ffn[k], 0.f) & 0xffffu); }
    __syncthreads();
    for (int m = gw; m < T; m += NGW) {
        const f32x4* xr = (const f32x4*)(x + (size_t)m * DM) + F.lane;
        f32x4 v[8]; float ss = 0.f;
#pragma unroll
        for (int j = 0; j < 8; ++j) { v[j] = xr[64 * j]; ss += (v[j][0] * v[j][0] + v[j][1] * v[j][1]) + (v[j][2] * v[j][2] + v[j][3] * v[j][3]); }
        float fl[8];
#pragma unroll
        for (int hh = 0; hh < 8; ++hh) { float a = 0.f;
#pragma unroll
            for (int j = 0; j < 8; ++j) { const f32x4 w = *(const LAS f32x4*)(wfgT + hh * 2048 + 256 * j + 4 * F.lane); a += (v[j][0] * w[0] + v[j][1] * w[1]) + (v[j][2] * w[2] + v[j][3] * w[3]); }
            fl[hh] = a; }
        ss = wave_sum(ss); const float rstd = 1.0f / sqrtf(ss * (1.0f / DM) + EPS);
#pragma unroll
        for (int hh = 0; hh < 8; ++hh) fl[hh] = wave_sum(fl[hh]) * rstd;
        u32x2* o8 = (u32x2*)(Hb + (size_t)m * DM) + F.lane;
#pragma unroll
        for (int j = 0; j < 8; ++j) { u32x2 w; w.x = cvt_pk_bf16(v[j][0] * rstd, v[j][1] * rstd); w.y = cvt_pk_bf16(v[j][2] * rstd, v[j][3] * rstd); o8[64 * j] = w;
            if (NQ8 > 0) ((unsigned*)(Hq + (size_t)m * DM))[64 * j + F.lane] = cvt_pk4_fp8(v[j][0] * rstd, v[j][1] * rstd, v[j][2] * rstd, v[j][3] * rstd); }
        if (F.lane < 8) { float z = fl[0];
#pragma unroll
            for (int hh = 1; hh < 8; ++hh) z = (F.lane == hh) ? fl[hh] : z;
            z += b_forget[F.lane];
            const float ls = fminf(z, 0.f) - log1pf(expf(-fabsf(z)));
            const int b = m >> 12, s = m & 4095; lf[(size_t)(b * 8 + F.lane) * SEQ + s] = ls; }
    }
}

__device__ __forceinline__ void p2_kmean_cumsum(Frame& F) {
    const bf16* mk = (const bf16*)(F.ws + WS_QKV) + (size_t)4 * 32 * SEQ * HD;
    bf16* kmean = (bf16*)(F.ws + WS_KMEAN);
    LAS float* part = (LAS float*)(F.lds + RING_OFF);
    for (int item = F.bx; item < 512; item += F.G) {
        const bf16* base = mk + ((size_t)item * 256 + F.wave * 32) * HD + 2 * F.lane;
        float a0 = 0.f, a1 = 0.f;
#pragma unroll 8
        for (int r = 0; r < 32; ++r) { const unsigned w = *(const unsigned*)(base + (size_t)r * HD); a0 += bflo(w); a1 += bfhi(w); }
        part[F.wave * 128 + 2 * F.lane] = a0; part[F.wave * 128 + 2 * F.lane + 1] = a1;
        __syncthreads();
        if (F.tid < 128) { float s = 0.f;
#pragma unroll
            for (int w = 0; w < 8; ++w) s += part[w * 128 + F.tid];
            kmean[(size_t)item * 128 + F.tid] = (bf16)(cvt_pk_bf16(s * (1.0f / 256.0f), 0.f) & 0xffffu); }
        __syncthreads();
    }
    if (F.bx < 32 && F.wave == 0) {
        const float* src = (const float*)(F.ws + WS_LF) + (size_t)F.bx * SEQ + 64 * F.lane; float* dst = (float*)(F.ws + WS_C) + (size_t)F.bx * SEQ + 64 * F.lane;
        f32x4 v[16]; float run = 0.f;
#pragma unroll
        for (int j = 0; j < 16; ++j) { v[j] = *(const f32x4*)(src + 4 * j);
            v[j][0] += run; v[j][1] += v[j][0]; v[j][2] += v[j][1]; v[j][3] += v[j][2]; run = v[j][3]; }
        float incl = run;
#pragma unroll
        for (int o = 1; o < 64; o <<= 1) { const float t = __shfl_up(incl, o); if (F.lane >= o) incl += t; }
        const float excl = incl - run;
#pragma unroll
        for (int j = 0; j < 16; ++j) { f32x4 w = v[j]; w[0] += excl; w[1] += excl; w[2] += excl; w[3] += excl; *(f32x4*)(dst + 4 * j) = w; }
    }
}

__device__ __forceinline__ void p4_outnorm(Frame& F) {
    bf16* AO = (bf16*)(F.ws + WS_A);
    const int gw = F.bx * NWAVES + F.wave, NGW = F.G * NWAVES;
    for (int m = gw; m < T; m += NGW) {
        u32x4* rp = (u32x4*)(AO + (size_t)m * DM) + F.lane;
        u32x4 v[4]; float ss[2] = {0.f, 0.f};
#pragma unroll
        for (int j = 0; j < 4; ++j) { v[j] = rp[64 * j];
#pragma unroll
            for (int q = 0; q < 4; ++q) { const float a = bflo(v[j][q]), b = bfhi(v[j][q]); ss[j >> 1] += a * a + b * b; } }
        const float r0 = 1.0f / sqrtf(wave_sum(ss[0]) * (1.0f / GWID) + EPS), r1 = 1.0f / sqrtf(wave_sum(ss[1]) * (1.0f / GWID) + EPS);
#pragma unroll
        for (int j = 0; j < 4; ++j) { const float r = (j < 2) ? r0 : r1; u32x4 o;
#pragma unroll
            for (int q = 0; q < 4; ++q) o[q] = cvt_pk_bf16(bflo(v[j][q]) * r, bfhi(v[j][q]) * r);
            rp[64 * j] = o; }
    }
}

__device__ __forceinline__ void p6_route(Frame& F) {
    const bf16* xb = (const bf16*)(F.ws + WS_XB); const bf16* Wr = (const bf16*)(F.ws + WS_WR);
    const float* bg = INP(10); const float* be = INP(12);
    int* tokrec = (int*)(F.ws + WS_TOKREC); int* list = (int*)(F.ws + WS_LIST); float* rsr = (float*)(F.ws + WS_RSR); float* rsw = (float*)(F.ws + WS_RSW);
    unsigned* gcnt = F.ctl + CW_GCNT;
    LAS float* part = (LAS float*)(F.lds + RING_OFF);
    LAS float* ssq = part + 2 * 64 * 32;
    LAS int* lcnt = (LAS int*)(ssq + 128);
    LAS int* lbase = lcnt + 16;
    const int fr = F.lane & 15, fq = F.lane >> 4, mt = F.wave & 3, kh = F.wave >> 2;
    for (int blk = F.bx; blk < T / 64; blk += F.G) {
        const int tok0 = blk * 64;
        if (F.tid < 16) lcnt[F.tid] = 0;
        const bf16* pa = xb + (size_t)(tok0 + 16 * mt + fr) * DM + 1024 * kh + 8 * fq;
        const bf16* pb0 = Wr + (size_t)fr * DM + 1024 * kh + 8 * fq; const bf16* pb1 = pb0 + (size_t)16 * DM;
        f32x4 acc0 = (f32x4){0.f, 0.f, 0.f, 0.f}, acc1 = acc0; float sq = 0.f;
#pragma unroll 4
        for (int s = 0; s < 32; ++s) { const bf16x8 a = *(const bf16x8*)(pa + 32 * s), b0 = *(const bf16x8*)(pb0 + 32 * s), b1 = *(const bf16x8*)(pb1 + 32 * s);
#pragma unroll
            for (int j = 0; j < 8; ++j) { const float f = bf2f((unsigned short)a[j]); sq += f * f; }
            acc0 = __builtin_amdgcn_mfma_f32_16x16x32_bf16(a, b0, acc0, 0, 0, 0); acc1 = __builtin_amdgcn_mfma_f32_16x16x32_bf16(a, b1, acc1, 0, 0, 0); }
        sq += __shfl_xor(sq, 16); sq += __shfl_xor(sq, 32);
#pragma unroll
        for (int i = 0; i < 4; ++i) { part[(kh * 64 + 16 * mt + 4 * fq + i) * 32 + fr] = acc0[i]; part[(kh * 64 + 16 * mt + 4 * fq + i) * 32 + 16 + fr] = acc1[i]; }
        if (fq == 0) ssq[kh * 64 + 16 * mt + fr] = sq;
        __syncthreads();
        int e1 = 0, e2 = 0, rk1 = 0, rk2 = 0; float w1 = 0.f, w2 = 0.f, rstd = 0.f;
        if (F.tid < 64) { const int t = F.tid;
            rstd = 1.0f / sqrtf((ssq[t] + ssq[64 + t]) * (1.0f / DM) + EPS);
            float gl[4]; int grp = 0;
#pragma unroll
            for (int j = 0; j < 4; ++j) gl[j] = (part[t * 32 + j] + part[(64 + t) * 32 + j]) * rstd + bg[j];
#pragma unroll
            for (int j = 1; j < 4; ++j) if (gl[j] > gl[grp]) grp = j;
            float gmax = gl[0];
#pragma unroll
            for (int j = 1; j < 4; ++j) gmax = fmaxf(gmax, gl[j]);
            float gden = 0.f;
#pragma unroll
            for (int j = 0; j < 4; ++j) gden += expf(gl[j] - gmax);
            const float pgrp = 1.0f / gden;
            float el[4];
#pragma unroll
            for (int j = 0; j < 4; ++j) el[j] = (part[t * 32 + 4 + 4 * grp + j] + part[(64 + t) * 32 + 4 + 4 * grp + j]) * rstd + be[4 * grp + j];
            int i1 = 0;
#pragma unroll
            for (int j = 1; j < 4; ++j) if (el[j] > el[i1]) i1 = j;
            int i2 = (i1 == 0) ? 1 : 0;
#pragma unroll
            for (int j = 0; j < 4; ++j) if (j != i1 && j != i2 && el[j] > el[i2]) i2 = j;
            const float p2 = expf(el[i2] - el[i1]);
            w1 = pgrp / (1.0f + p2); w2 = pgrp * p2 / (1.0f + p2);
            e1 = 4 * grp + i1; e2 = 4 * grp + i2;
            rk1 = __hip_atomic_fetch_add(&lcnt[e1], 1, __ATOMIC_RELAXED, __HIP_MEMORY_SCOPE_WORKGROUP); rk2 = __hip_atomic_fetch_add(&lcnt[e2], 1, __ATOMIC_RELAXED, __HIP_MEMORY_SCOPE_WORKGROUP);
        }
        __syncthreads();
        if (F.tid < 16) lbase[F.tid] = (int)__hip_atomic_fetch_add(gcnt + F.tid, (unsigned)lcnt[F.tid], __ATOMIC_RELAXED, __HIP_MEMORY_SCOPE_AGENT);
        __syncthreads();
        if (F.tid < 64) { const int tok = tok0 + F.tid; const int p1 = lbase[e1] + rk1, p2 = lbase[e2] + rk2;
            list[e1 * ECAP + p1] = tok; rsr[e1 * ECAP + p1] = rstd; rsw[e1 * ECAP + p1] = w1;
            list[e2 * ECAP + p2] = tok; rsr[e2 * ECAP + p2] = rstd; rsw[e2 * ECAP + p2] = w2;
            int4 rec; rec.x = e1; rec.y = p1; rec.z = e2; rec.w = p2; *(int4*)(tokrec + 4 * tok) = rec; }
        __syncthreads();
    }
}
__device__ __forceinline__ void moe_table(Frame& F) {
    LAS int* tt = (LAS int*)(F.lds + XTRA_OFF);
    if (F.tid == 0) { int t = 0;
        for (int e = 0; e < NE; ++e) { int c = (int)F.ctl[CW_GCNT + e]; if (c > ECAP) c = ECAP; if (c < 0) c = 0; tt[256 + e] = c; tt[288 + e] = t; const int n = (c + 255) >> 8;
            for (int rb = 0; rb < n && t < MAXTILES; ++rb) tt[16 + t++] = e | (rb << 8); }
        tt[0] = t; }
    __syncthreads();
}

__device__ __forceinline__ void p9_final(Frame& F) {
    const LAS int* tt = (const LAS int*)(F.lds + XTRA_OFF);
    const int* tokrec = (const int*)(F.ws + WS_TOKREC); const bf16* Y = (const bf16*)(F.ws + WS_Y); const bf16* XB = (const bf16*)(F.ws + WS_XB); const float* gfin = INP(16);
    const int gw = F.bx * NWAVES + F.wave, NGW = F.G * NWAVES;
    for (int m = gw; m < T; m += NGW) {
        const int4 rec = *(const int4*)(tokrec + 4 * m);
        const int e1 = __builtin_amdgcn_readfirstlane(rec.x), p1 = __builtin_amdgcn_readfirstlane(rec.y), e2 = __builtin_amdgcn_readfirstlane(rec.z), p2 = __builtin_amdgcn_readfirstlane(rec.w);
        const size_t r1 = (size_t)tt[288 + (e1 & 15)] * 256 + p1, r2 = (size_t)tt[288 + (e2 & 15)] * 256 + p2;
        f32x4* xr = (f32x4*)(F.ka->out + (size_t)m * DM) + F.lane; const u32x2* x1 = (const u32x2*)(XB + (size_t)m * DM) + F.lane;
        const u32x2* y1 = (const u32x2*)(Y + r1 * DM) + F.lane; const u32x2* y2 = (const u32x2*)(Y + r2 * DM) + F.lane;
        f32x4 v[8]; float ss = 0.f;
#pragma unroll
        for (int j = 0; j < 8; ++j) { const u32x2 c = x1[64 * j], a = y1[64 * j], b = y2[64 * j];
            v[j][0] = bflo(c.x) + bflo(a.x) + bflo(b.x); v[j][1] = bfhi(c.x) + bfhi(a.x) + bfhi(b.x); v[j][2] = bflo(c.y) + bflo(a.y) + bflo(b.y); v[j][3] = bfhi(c.y) + bfhi(a.y) + bfhi(b.y);
            ss += (v[j][0] * v[j][0] + v[j][1] * v[j][1]) + (v[j][2] * v[j][2] + v[j][3] * v[j][3]); }
        const float rstd = 1.0f / sqrtf(wave_sum(ss) * (1.0f / DM) + EPS);
#pragma unroll
        for (int j = 0; j < 8; ++j) { const f32x4 g = *((const f32x4*)gfin + 64 * j + F.lane); f32x4 o; o[0] = v[j][0] * rstd * g[0]; o[1] = v[j][1] * rstd * g[1]; o[2] = v[j][2] * rstd * g[2]; o[3] = v[j][3] * rstd * g[3]; xr[64 * j] = o; }
    }
}

constexpr int NPHASE = 10;
#ifndef REPMASK
#define REPMASK 0
#endif
#define NREP(k) (1 + ((REPMASK >> (k)) & 1))
__global__ void __launch_bounds__(NTHR, 2) fwd(Args args) {
    extern __shared__ __attribute__((aligned(16))) unsigned char lds_raw[];
    Frame F;
    F.lds = (LAS unsigned char*)lds_raw; F.ws = args.ws; F.ctl = (unsigned*)(args.ws + WS_CTL);
    F.G = gridDim.x; F.bx = blockIdx.x; phase_begin(F);
    for (int u = F.tid; u < 256; u += NTHR) ((LAS unsigned*)(F.lds + LCTL_OFF))[u] = 0u;
    __syncthreads();
    const int lo = args.ph_lo, hi = args.ph_hi;
    const bool multi = (hi - lo) > 1;
    XcdBarrier bar; bar.bar = F.ctl + CW_BAR; bar.x = 0; bar.st = (volatile LAS unsigned*)(F.lds + LCTL_OFF);
    if (multi) bar = xcd_barrier_post(F.ctl + CW_BAR, (volatile LAS unsigned*)(F.lds + LCTL_OFF));
#define IN(k) (lo <= (k) && (k) < hi)
#define SEAM(k) do { if (IN(k) && IN((k) + 1 + ((k) == 3))) xcd_barrier(bar); } while (0)

    if (IN(0)) _Pragma("nounroll") for (int rep_ = 0; rep_ < NREP(0); ++rep_) { if (rep_) xcd_barrier(bar); phase_begin(F); p0_prologue(F); } SEAM(0);
    if (IN(1)) _Pragma("nounroll") for (int rep_ = 0; rep_ < NREP(1); ++rep_) { if (rep_) xcd_barrier(bar); phase_begin(F);
        if (NQ16 > 0) { pg8::Gemm g{(const bf16*)(F.ws + WS_A), (const bf16*)(F.ws + WS_WQKV), T, NQ16 * 1024, DM}; pg8::StaticOrder S; S.init(T, NQ16 * 1024, F.G, F.bx);
            EpiQKV<false> E{(bf16*)(F.ws + WS_QKV)};
            pg8::gemm_phase<EpiQKV<false>, pg8::StaticOrder, true, false, false>(F.lds + RING_OFF, g, S, E); }
        if (NQ8 > 0) { pg8::Gemm g{(const bf16*)(F.ws + WS_HQ), (const bf16*)(F.ws + WS_WQ8), T, NQ8 * 1024, DM}; pg8::StaticOrder S; S.init(T, NQ8 * 1024, F.G, F.bx);
            EpiQKV<true> E{(bf16*)(F.ws + WS_QKV)};
            pg8::gemm_phase<EpiQKV<true>, pg8::StaticOrder, true, false, true>(F.lds + RING_OFF, g, S, E); }
    } SEAM(1);
    if (IN(2)) _Pragma("nounroll") for (int rep_ = 0; rep_ < NREP(2); ++rep_) { if (rep_) xcd_barrier(bar); phase_begin(F); p2_kmean_cumsum(F); } SEAM(2);
    if (IN(3)) _Pragma("nounroll") for (int rep_ = 0; rep_ < NREP(3); ++rep_) { if (rep_) xcd_barrier(bar); phase_begin(F);
        static_assert(att::LDS_ATT <= RING_BYTES, "attention LDS");
        const bf16* qkv = (const bf16*)(F.ws + WS_QKV); bf16* AO = (bf16*)(F.ws + WS_A);
        const float* cbuf = (const float*)(F.ws + WS_C); const bf16* kmean = (const bf16*)(F.ws + WS_KMEAN); const float* relb = INP(6); float* SSQ = (float*)(F.ws + WS_SSQ);
#define MKREF(R, grp, bh_, qb_) do { const int _bh = (bh_), _qb = (qb_), _g = (grp); \
            R.Q = qkv + ((size_t)(_g * 3 + 0) * 32 + _bh) * SEQ * HD + (size_t)_qb * 256 * HD; R.K = qkv + ((size_t)(_g * 3 + 1) * 32 + _bh) * SEQ * HD; R.V = qkv + ((size_t)(_g * 3 + 2) * 32 + _bh) * SEQ * HD; \
            R.O = (unsigned char*)AO + (((size_t)(_bh >> 3) * SEQ + _qb * 256) * DM + _g * GWID + (_bh & 7) * HD) * (WO_FP8 ? 1 : 2); R.SS = SSQ + ((size_t)(_bh >> 3) * SEQ + _qb * 256) * 16 + _g * 8 + (_bh & 7); R.P0 = _qb * 256; R.bh = _bh; } while (0)
        const int vcu = (F.G % 8 == 0) ? (F.bx % 8) * (F.G / 8) + F.bx / 8 : F.bx;
        att::Seam S; att::BlockRef cur, nxt;
        if (vcu < 256) { MKREF(cur, 0, vcu >> 3, vcu & 7); att::attn_prime(cur, (char*)lds_raw + RING_OFF, S); }
        for (int L = vcu; L < 256; L += F.G) {
            const int bh = L >> 3, s = L & 7; const bool more = (L + F.G) < 256; const int Ln = more ? L + F.G : L;
#pragma nounroll
            for (int u = 0; u < 2; ++u) {
                MKREF(cur, 0, bh, u ? 15 - s : s); if (u == 0) MKREF(nxt, 0, bh, 15 - s); else MKREF(nxt, 1, bh, s);
#ifndef NO_M0
                att::attn_block<0>(cur, nxt, F.lds + RING_OFF, S, cbuf, kmean, relb);
#endif
            }
#pragma nounroll
            for (int u = 0; u < 2; ++u) {
                MKREF(cur, 1, bh, u ? 15 - s : s); if (u == 0) MKREF(nxt, 1, bh, 15 - s); else if (more) MKREF(nxt, 0, Ln >> 3, Ln & 7); else nxt = cur;
#ifndef NO_M1
                att::attn_block<1>(cur, nxt, F.lds + RING_OFF, S, cbuf, kmean, relb);
#endif
            }
        }
#undef MKREF
    } SEAM(3);
    if (IN(5)) _Pragma("nounroll") for (int rep_ = 0; rep_ < NREP(5); ++rep_) { if (rep_) xcd_barrier(bar); phase_begin(F);
        pg8::Gemm g{(const bf16*)(F.ws + WS_A), (const bf16*)(F.ws + WS_WO), T, DM, DM}; pg8::StaticOrder S; S.init(T, DM, F.G, F.bx);
        EpiRes E; E.x = INP(0); E.xb = (bf16*)(F.ws + WS_XB); E.xq = F.ws + WS_XQ; E.ssqp = (const float*)(F.ws + WS_SSQ); E.tab = (LAS float*)(F.lds + XTRA_OFF); E.par = 1;
        pg8::gemm_phase<EpiRes, pg8::StaticOrder, true, false, WO_FP8 != 0>(F.lds + RING_OFF, g, S, E);
    } SEAM(5);
    if (IN(6)) _Pragma("nounroll") for (int rep_ = 0; rep_ < NREP(6); ++rep_) { if (rep_) xcd_barrier(bar); phase_begin(F); p6_route(F); } SEAM(6);
    if (IN(7)) _Pragma("nounroll") for (int rep_ = 0; rep_ < NREP(7); ++rep_) { if (rep_) xcd_barrier(bar); phase_begin(F);
        moe_table(F);
        const LAS int* tt = (const LAS int*)(F.lds + XTRA_OFF);
        pg8::Gemm g{(const bf16*)(F.ws + WS_XQ), (const bf16*)(F.ws + WS_WGU), MAXTILES * 256, NE * 1024, DM};
        MoeGather S; S.G = F.G; S.c = F.bx; S.ncol = 4; S.tt = tt; S.list = (const int*)(F.ws + WS_LIST);
        EpiHid E{F.ws + WS_A, (const float*)(F.ws + WS_RSR), (const float*)(F.ws + WS_RSW), tt};
        pg8::gemm_phase<EpiHid, MoeGather, true, true, true>(F.lds + RING_OFF, g, S, E);
    } SEAM(7);
    if (IN(8)) _Pragma("nounroll") for (int rep_ = 0; rep_ < NREP(8); ++rep_) { if (rep_) xcd_barrier(bar); phase_begin(F);
        moe_table(F);
        const LAS int* tt = (const LAS int*)(F.lds + XTRA_OFF);
        pg8::Gemm g{(const bf16*)(F.ws + WS_A), (const bf16*)(F.ws + WS_WD), MAXTILES * 256, NE * DM, DE};
        MoePlain S; S.G = F.G; S.c = F.bx; S.ncol = 8; S.tt = tt;
        EpiY E{(bf16*)(F.ws + WS_Y)};
        pg8::gemm_phase<EpiY, MoePlain, true, false, true>(F.lds + RING_OFF, g, S, E);
    } SEAM(8);
    if (IN(9)) _Pragma("nounroll") for (int rep_ = 0; rep_ < NREP(9); ++rep_) { if (rep_) xcd_barrier(bar); phase_begin(F); moe_table(F); p9_final(F); }
#undef IN
#undef SEAM
}

template <int MODE>
__global__ void __launch_bounds__(256) naive_attn(unsigned char* ws, const float* rel_bias) {
    const bf16* qkv = (const bf16*)(ws + WS_QKV); const float* cbuf = (const float*)(ws + WS_C); const bf16* kmean = (const bf16*)(ws + WS_KMEAN); bf16* AO = (bf16*)(ws + WS_A);
    __shared__ float qs[16][128]; __shared__ float sc[16][256]; __shared__ float gsc[16][16]; __shared__ unsigned selm[16]; __shared__ float lut[132];
    const int t = threadIdx.x, bh = blockIdx.y, b = bh >> 3, h = bh & 7, i0 = blockIdx.x * 16;
    const bf16* Q = qkv + ((size_t)(MODE * 3 + 0) * 32 + bh) * SEQ * HD; const bf16* Kp = qkv + ((size_t)(MODE * 3 + 1) * 32 + bh) * SEQ * HD; const bf16* Vp = qkv + ((size_t)(MODE * 3 + 2) * 32 + bh) * SEQ * HD;
    for (int i = t; i < 16 * 128; i += 256) qs[i >> 7][i & 127] = bf2f(Q[(size_t)(i0 + (i >> 7)) * HD + (i & 127)]);
    const int own = i0 >> 8;
    if (MODE == 1) { for (int d = t; d < 129; d += 256) { int bk; if (d < 16) bk = d; else { bk = 16 + (int)(logf((float)d / 16.0f) / 2.0794415416798357f * 16.0f); if (bk > 31) bk = 31; } lut[d] = rel_bias[h * 32 + bk]; } }
    __syncthreads();
    if (MODE == 1) {
        const int q = t >> 4, n = t & 15; float g = -1e30f;
        if (n < own) { g = 0.f; const bf16* km = kmean + ((size_t)bh * 16 + n) * 128; for (int d = 0; d < 128; ++d) g += qs[q][d] * bf2f(km[d]); }
        gsc[q][n] = g;
        __syncthreads();
        if (t < 16) { unsigned m = 0; const int nsel = own < 3 ? own : 3;
            for (int k = 0; k < nsel; ++k) { int best = -1; float bv = 0.f; for (int n2 = 0; n2 < own; ++n2) if (!((m >> n2) & 1u) && (best < 0 || gsc[t][n2] > bv)) { best = n2; bv = gsc[t][n2]; } if (best >= 0) m |= 1u << best; }
            selm[t] = m; }
        __syncthreads();
    }
    const int q = t >> 4, dg = t & 15;
    float o[8]; for (int c = 0; c < 8; ++c) o[c] = 0.f;
    float mrun = -1e30f, lrun = 0.f;
    const float scale = 0.08838834764831845f;
    const int nch = own + 1;
    for (int ch = 0; ch < nch; ++ch) {
        const int j = ch * 256 + t;
        float kr[128];
        { const u32x4* kp = (const u32x4*)(Kp + (size_t)j * HD);
#pragma unroll
          for (int c = 0; c < 16; ++c) { const u32x4 w = kp[c]; kr[8 * c + 0] = bflo(w.x); kr[8 * c + 1] = bfhi(w.x); kr[8 * c + 2] = bflo(w.y); kr[8 * c + 3] = bfhi(w.y); kr[8 * c + 4] = bflo(w.z); kr[8 * c + 5] = bfhi(w.z); kr[8 * c + 6] = bflo(w.w); kr[8 * c + 7] = bfhi(w.w); } }
        const float cj = (MODE == 0) ? cbuf[(size_t)bh * SEQ + j] : 0.f;
        for (int qq = 0; qq < 16; ++qq) { const int i = i0 + qq; float s = 0.f;
#pragma unroll
            for (int d = 0; d < 128; ++d) s += qs[qq][d] * kr[d];
            s *= scale; bool ok;
            if (MODE == 0) { s += cbuf[(size_t)bh * SEQ + i] - cj; ok = j <= i; }
            else { const int dd = i - j; s += lut[dd < 0 ? 0 : (dd > 128 ? 128 : dd)]; ok = (ch == own) ? (j <= i) : (((selm[qq] >> ch) & 1u) != 0u); }
            sc[qq][t] = ok ? s : -__builtin_inff(); }
        __syncthreads();
        float cm = -__builtin_inff();
        for (int c = 0; c < 16; ++c) cm = fmaxf(cm, sc[q][dg + 16 * c]);
#pragma unroll
        for (int off = 1; off < 16; off <<= 1) cm = fmaxf(cm, __shfl_xor(cm, off));
        const float mnew = fmaxf(mrun, cm), alpha = expf(mrun - mnew);
        float ps = 0.f; float pv[16];
        for (int c = 0; c < 16; ++c) { pv[c] = expf(sc[q][dg + 16 * c] - mnew); ps += pv[c]; }
#pragma unroll
        for (int off = 1; off < 16; off <<= 1) ps += __shfl_xor(ps, off);
        lrun = lrun * alpha + ps; mrun = mnew;
        __syncthreads();
        for (int c = 0; c < 16; ++c) sc[q][dg + 16 * c] = pv[c];
        __syncthreads();
        for (int c = 0; c < 8; ++c) o[c] *= alpha;
        for (int jj = 0; jj < 256; ++jj) { const float p = sc[q][jj]; const u32x4 w = *(const u32x4*)(Vp + (size_t)(ch * 256 + jj) * HD + 8 * dg);
            o[0] += p * bflo(w.x); o[1] += p * bfhi(w.x); o[2] += p * bflo(w.y); o[3] += p * bfhi(w.y); o[4] += p * bflo(w.z); o[5] += p * bfhi(w.z); o[6] += p * bflo(w.w); o[7] += p * bfhi(w.w); }
        __syncthreads();
    }
    const float il = 1.0f / lrun;
    u32x4 w; w.x = cvt_pk_bf16(o[0] * il, o[1] * il); w.y = cvt_pk_bf16(o[2] * il, o[3] * il); w.z = cvt_pk_bf16(o[4] * il, o[5] * il); w.w = cvt_pk_bf16(o[6] * il, o[7] * il);
    *(u32x4*)(AO + (size_t)(b * SEQ + i0 + q) * DM + MODE * GWID + h * HD + 8 * dg) = w;
}

extern "C" void kernel_launch(void* const* d_in, const int* in_sizes, int n_in, void* d_out, int out_size, void* d_ws, size_t ws_size, hipStream_t stream) {
    static int grid = 0;
    if (grid == 0) {
        if (n_in != 17 || out_size != T * DM || ws_size < WS_END) { fprintf(stderr, "kernel_launch: unexpected shapes (n_in %d out %d ws %zu)\n", n_in, out_size, ws_size); grid = -1; return; }
        int dev = 0, cus = 0;
        if (hipGetDevice(&dev) != hipSuccess || hipDeviceGetAttribute(&cus, hipDeviceAttributeMultiprocessorCount, dev) != hipSuccess) { grid = -1; return; }
        if (hipFuncSetAttribute((const void*)fwd, hipFuncAttributeMaxDynamicSharedMemorySize, LDS_BYTES) != hipSuccess) { fprintf(stderr, "kernel_launch: hipFuncSetAttribute failed\n"); grid = -1; return; }
        int per_cu = 0;
        if (hipOccupancyMaxActiveBlocksPerMultiprocessor(&per_cu, (const void*)fwd, NTHR, LDS_BYTES) != hipSuccess || per_cu < 1) fprintf(stderr, "kernel_launch: occupancy query reports %d\n", per_cu);
        (void)hipGetLastError();
        grid = cus > 0 ? cus : 256;
    }
    if (grid < 0) return;
    (void)hipMemsetAsync((char*)d_ws + WS_CTL, 0, CTL_ZERO_BYTES, stream);
    Args a{};
    for (int i = 0; i < 17; ++i) a.in[i] = (const float*)d_in[i];
    a.out = (float*)d_out; a.ws = (unsigned char*)d_ws;
#ifdef MK_PER_PHASE
    for (int ph = 0; ph < NPHASE; ++ph) { a.ph_lo = ph; a.ph_hi = ph + 1; hipLaunchKernelGGL(fwd, dim3(grid), dim3(NTHR), LDS_BYTES, stream, a); }
#else
    a.ph_lo = 0; a.ph_hi = NPHASE;
    hipLaunchKernelGGL(fwd, dim3(grid), dim3(NTHR), LDS_BYTES, stream, a);
#endif
}
```

```cpp
#include <hip/hip_runtime.h>
#include <cstdio>
#include <cstdint>

#define GAS __attribute__((address_space(1)))
#define LAS __attribute__((address_space(3)))
typedef unsigned short bf16;
typedef short bf16x8 __attribute__((ext_vector_type(8)));
typedef float f32x4 __attribute__((ext_vector_type(4)));
typedef float f32x2 __attribute__((ext_vector_type(2)));
typedef unsigned u32x4 __attribute__((ext_vector_type(4)));
typedef unsigned u32x2 __attribute__((ext_vector_type(2)));
typedef int i32x4 __attribute__((ext_vector_type(4)));
typedef int i32x8 __attribute__((ext_vector_type(8)));

constexpr int BATCH = 4, SEQ = 4096, DM = 2048, T = BATCH * SEQ, NH = 8, HD = 128, GWID = 1024, NQKV = 6144, WIN_LD = 6152;
constexpr int NE = 16, DE = 512, ECAP = 16384, MAXTILES = 144, NRC = 32  ;
constexpr float EPS = 1e-6f;
constexpr int NWAVES = 8, NTHR = 512;
constexpr float SC_WGU = 32.f, SC_WD = 16.f, SC_HID = 16.f;
#ifndef QMASK
#define QMASK 0x27
#endif
#ifndef WO_FP8
#define WO_FP8 1
#endif
constexpr int NQ8 = ((QMASK >> 0) & 1) + ((QMASK >> 1) & 1) + ((QMASK >> 2) & 1) + ((QMASK >> 3) & 1) + ((QMASK >> 4) & 1) + ((QMASK >> 5) & 1), NQ16 = 6 - NQ8;
constexpr float SC_WIN = 32.f, SC_AO = 16.f, SC_WO = 32.f, SC_Y = 16.f;
__host__ __device__ constexpr int grp_rank(int w) { int c = 0; for (int i = 0; i < w; ++i) if (((QMASK >> i) & 1) == ((QMASK >> w) & 1)) ++c; return c; }
__device__ __forceinline__ int grp_nth_rank(int w) { int c = 0;
#pragma unroll
    for (int i = 0; i < 6; ++i) if (i < w && (((QMASK >> i) & 1) == ((QMASK >> w) & 1))) ++c; return c; }
__device__ __forceinline__ int grp_nth(int li, bool q8) { int r = 0, c = 0;
#pragma unroll
    for (int w = 0; w < 6; ++w) { const bool is8 = ((QMASK >> w) & 1) != 0; if (is8 == q8) { if (c == li) r = w; ++c; } } return r; }

constexpr size_t MiB = 1u << 20, KiB = 1u << 10;
constexpr size_t WS_CTL = 0, CTL_ZERO_BYTES = 1 * MiB;
constexpr size_t WS_WQKV = 2 * MiB;
constexpr size_t WS_WQ8 = 448 * MiB;
constexpr size_t WS_WO = 26 * MiB;
constexpr size_t WS_WGU = 34 * MiB;
constexpr size_t WS_WD = 98 * MiB;
constexpr size_t WS_WR = 130 * MiB;
constexpr size_t WS_LF = 130 * MiB + 256 * KiB;
constexpr size_t WS_C = 131 * MiB;
constexpr size_t WS_KMEAN = 131 * MiB + 512 * KiB;
constexpr size_t WS_TOKREC = 132 * MiB;
constexpr size_t WS_LIST = 133 * MiB;
constexpr size_t WS_RSR = 134 * MiB;
constexpr size_t WS_RSW = 135 * MiB;
constexpr size_t WS_SSQ = 136 * MiB;
constexpr size_t WS_A = 138 * MiB;
constexpr size_t WS_QKV = 202 * MiB;
constexpr size_t WS_XB = 202 * MiB;
constexpr size_t WS_Y = 298 * MiB;
constexpr size_t WS_XQ = 266 * MiB;
constexpr size_t WS_HQ = 416 * MiB;
constexpr size_t WS_END = 472 * MiB;
constexpr int CW_TMO = 0, CW_GCNT = 64, CW_BAR = 4096;

constexpr int LCTL_OFF = 0;
constexpr int RING_OFF = 1024, RING_BYTES = 131072;
constexpr int XTRA_OFF = RING_OFF + RING_BYTES;
constexpr int LDS_BYTES = 155648;

#define LDS_WAIT() asm volatile("s_waitcnt lgkmcnt(0)" ::: "memory")
#define VM_WAIT() asm volatile("s_waitcnt vmcnt(0)" ::: "memory")
__device__ __forceinline__ unsigned cvt_pk_bf16(float lo, float hi) { unsigned r; asm volatile("v_cvt_pk_bf16_f32 %0, %1, %2" : "=v"(r) : "v"(lo), "v"(hi)); return r; }
__device__ __forceinline__ unsigned cvt_pk4_fp8(float a, float b, float c, float d) { int w = __builtin_amdgcn_cvt_pk_fp8_f32(a, b, 0, false); w = __builtin_amdgcn_cvt_pk_fp8_f32(c, d, w, true); return (unsigned)w; }
__device__ __forceinline__ float bf2f(unsigned short b) { return __uint_as_float((unsigned)b << 16); }
__device__ __forceinline__ float bflo(unsigned w) { return __uint_as_float(w << 16); }
__device__ __forceinline__ float bfhi(unsigned w) { return __uint_as_float(w & 0xffff0000u); }
__device__ __forceinline__ float wave_sum(float v) {
#pragma unroll
    for (int o = 1; o < 64; o <<= 1) v += __shfl_xor(v, o);
    return v;
}

__device__ __forceinline__ int ltid() { int t = threadIdx.x; asm volatile("" : "+v"(t)); return t; }
namespace pg8 {
typedef unsigned short bf16_t;
constexpr int BM = 256, BK = 64, HALF = 128, HTB = HALF * BK * 2, STAGE_BYTES = 8 * HTB, NXCD = 8, WGM = 8;
__host__ __device__ __forceinline__ int lds_byte(int r, int c) { const int st = (r >> 4) * 2 + (c >> 5), rr = r & 15, cc = c & 31, ob = rr * 64 + cc * 2; return st * 1024 + (ob ^ (((ob >> 9) & 1) << 5)); }
__host__ __device__ __forceinline__ void stage_rc(int b, int& R, int& C) { const int st = b / 1024, sb = b % 1024, swz = sb ^ (((sb >> 9) & 1) << 5); R = (st >> 1) * 16 + swz / 64; C = (st & 1) * 32 + (swz % 64) / 2; }
__host__ __device__ __forceinline__ int perm32(int rho) { const int n = rho >> 4, i = rho & 15; return 8 * (i >> 2) + 4 * n + (i & 3); }

struct Unit { int pm, pn; };
struct Gemm { const bf16_t* A; const bf16_t* Bt; int M, N, K; };

struct StaticOrder {
    int nM, nN, nwg, G, c;
    __host__ __device__ void init(int M, int N, int G_, int c_) { nM = M / BM; nN = N / BM; nwg = nM * nN; G = G_; c = c_; }
    __host__ __device__ bool next(int i, Unit& u) const {
        const long L = (long)i * G + c; if (L >= nwg) return false;
        int wgid = (int)L; { const int q = nwg / NXCD, r = nwg % NXCD, xcd = wgid % NXCD, off = wgid / NXCD; wgid = (xcd < r ? xcd * (q + 1) : r * (q + 1) + (xcd - r) * q) + off; }
        const int nig = WGM * nN, gid = wgid / nig, fm = gid * WGM, gsz = (nM - fm) < WGM ? (nM - fm) : WGM;
        u.pm = fm + ((wgid % nig) % gsz); u.pn = (wgid % nig) / gsz; return true;
    }
    __device__ __forceinline__ int arow(const Unit&, int) const { return 0; }
};

template <class Epi, class Sched, bool ALIGN_EPI, bool GATHER, bool FP8 = false>
__device__ __forceinline__ void gemm_phase(LAS unsigned char* lds, const Gemm g, const Sched& S, Epi& E) {
    const int tid = ltid(), wid = __builtin_amdgcn_readfirstlane(tid >> 6), lane = tid & 63, wr = wid >> 2, wc = wid & 3, fr = lane & 15, fq = lane >> 4;
    const int RB = FP8 ? g.K : 2 * g.K  , nt = RB / (BK * 2);
    unsigned voffA[2], voffB[2];
#pragma unroll
    for (int i = 0; i < 2; ++i) { int R, C; stage_rc(tid * 16 + i * 8192, R, C); const int Rb = Epi::PERM ? ((R & ~31) + perm32(R & 31)) : R;
        voffA[i] = (unsigned)(R * RB + C * 2); voffB[i] = (unsigned)(Rb * RB + C * 2); }
    const size_t kstep = (size_t)(BK * 2);
    const size_t hstep = (size_t)HALF * RB;
    const size_t tstep = 2 * hstep;
    const unsigned ldsw = (unsigned)wid * 1024u;
    const int aoff = lds_byte(wr * 64 + fr, fq * 8), boff = lds_byte(wc * 32 + fr, fq * 8);
    const unsigned ldsu = (unsigned)(uintptr_t)lds; const unsigned abase = ldsu + (unsigned)aoff, bbase = ldsu + 4u * HTB + (unsigned)boff;
#define PG8_SA(b, h) (((b) * 2 + (h)) * HTB)
#define PG8_SB(b, h) ((4 + (b) * 2 + (h)) * HTB)
#define PG8_GLDS(gbase, voff32, ldsdst) asm volatile("s_mov_b32 m0, %2\n\ts_nop 0\n\tglobal_load_lds_dwordx4 %0, %1" :: "v"(voff32), "s"(gbase), "s"(ldsdst) : "memory", "m0")
#define PG8_STAGE(bufoff, gbase, voff) do { _Pragma("unroll") for (int _i = 0; _i < 2; ++_i) PG8_GLDS((const char*)(gbase), (voff)[_i], ldsu + (unsigned)((bufoff) + _i * 8192) + ldsw); } while (0)
#define PG8_STAGE_A(bufoff, gbase, h, VV) do { if constexpr (GATHER) { PG8_STAGE(bufoff, gbase, (VV)[h]); } else { PG8_STAGE(bufoff, (gbase) + (h) * hstep, voffA); } } while (0)
#define PG8_STAGE_A2(bufoff, gbase, h) do { if constexpr (GATHER) { if (last) PG8_STAGE(bufoff, gbase, nv[h]); else PG8_STAGE(bufoff, gbase, cv[h]); } else { PG8_STAGE(bufoff, (gbase) + (h) * hstep, voffA); } } while (0)
#define PG8_DSR(dst, base, off) asm volatile("ds_read_b128 %0, %1 offset:%2" : "=v"(dst) : "v"(base), "i"(off) : "memory")
#define PG8_LDA(dst, b, h) do { if constexpr (FP8) { _Pragma("unroll") for (int m = 0; m < 4; ++m) { i32x4 lo_, hi_; PG8_DSR(lo_, abase, PG8_SA(b, h) + m * 2048); PG8_DSR(hi_, abase, PG8_SA(b, h) + m * 2048 + 1024); dst##8[m] = __builtin_shufflevector(lo_, hi_, 0, 1, 2, 3, 4, 5, 6, 7); } } \
        else { _Pragma("unroll") for (int m = 0; m < 4; ++m) _Pragma("unroll") for (int k = 0; k < 2; ++k) PG8_DSR(dst[m][k], abase, PG8_SA(b, h) + m * 2048 + k * 1024); } } while (0)
#define PG8_LDB(dst, b, h) do { if constexpr (FP8) { _Pragma("unroll") for (int n = 0; n < 2; ++n) { i32x4 lo_, hi_; PG8_DSR(lo_, bbase, PG8_SA(b, h) + n * 2048); PG8_DSR(hi_, bbase, PG8_SA(b, h) + n * 2048 + 1024); dst##8[n] = __builtin_shufflevector(lo_, hi_, 0, 1, 2, 3, 4, 5, 6, 7); } } \
        else { _Pragma("unroll") for (int n = 0; n < 2; ++n) _Pragma("unroll") for (int k = 0; k < 2; ++k) PG8_DSR(dst[n][k], bbase, PG8_SA(b, h) + n * 2048 + k * 1024); } } while (0)
#define PG8_MMA(ai, bj, At, Bt) do { __builtin_amdgcn_s_setprio(1); _Pragma("unroll") for (int m = 0; m < 4; ++m) _Pragma("unroll") for (int n = 0; n < 2; ++n) { \
        if constexpr (FP8) acc[ai][bj][m][n] = __builtin_amdgcn_mfma_scale_f32_16x16x128_f8f6f4(Bt##8[n], At##8[m], acc[ai][bj][m][n], 0, 0, 0, 0, 0, 0); \
        else { _Pragma("unroll") for (int k = 0; k < 2; ++k) acc[ai][bj][m][n] = __builtin_amdgcn_mfma_f32_16x16x32_bf16(Bt[n][k], At[m][k], acc[ai][bj][m][n], 0, 0, 0); } } __builtin_amdgcn_s_setprio(0); } while (0)
#define PG8_WAIT_V(n) asm volatile("s_waitcnt vmcnt(" #n ")" ::: "memory")
#define PG8_WAIT_L(n) asm volatile("s_waitcnt lgkmcnt(" #n ")" ::: "memory")
#define PG8_BAR __builtin_amdgcn_s_barrier()
#define PG8_SCHED __builtin_amdgcn_sched_barrier(0)
    Unit cur, nxt; int ui = 0;
    if (!S.next(0, cur)) return;
    f32x4 acc[2][2][4][2];
#pragma unroll
    for (int a = 0; a < 2; ++a)
#pragma unroll
        for (int b = 0; b < 2; ++b)
#pragma unroll
            for (int m = 0; m < 4; ++m)
#pragma unroll
                for (int n = 0; n < 2; ++n) acc[a][b][m][n] = (f32x4){0.f, 0.f, 0.f, 0.f};
    bf16x8 At[4][2], B0[2][2], B1[2][2];
    i32x8 At8[4], B08[2], B18[2];
    unsigned cv[2][2], nv[2][2];
#define PG8_GOFF(dst, unit) do { const int t2_ = ltid(); _Pragma("unroll") for (int i_ = 0; i_ < 2; ++i_) { int R_, C_; stage_rc(t2_ * 16 + i_ * 8192, R_, C_); \
        _Pragma("unroll") for (int h_ = 0; h_ < 2; ++h_) dst[h_][i_] = (unsigned)S.arow(unit, h_ * HALF + R_) * (unsigned)RB + (unsigned)C_ * 2u; } } while (0)
    if constexpr (GATHER) {
        PG8_GOFF(cv, cur);
#pragma unroll
        for (int h = 0; h < 2; ++h)
#pragma unroll
            for (int i = 0; i < 2; ++i) nv[h][i] = cv[h][i];
    } else {
#pragma unroll
        for (int h = 0; h < 2; ++h)
#pragma unroll
            for (int i = 0; i < 2; ++i) { cv[h][i] = 0u; nv[h][i] = 0u; }
    }
    const char* cA = GATHER ? (const char*)g.A : (const char*)g.A + (size_t)cur.pm * tstep; const char* cB = (const char*)g.Bt + (size_t)cur.pn * tstep;
    PG8_STAGE(PG8_SB(0, 0), cB, voffB); PG8_STAGE(PG8_SB(0, 1), cB + hstep, voffB); PG8_STAGE_A(PG8_SA(0, 0), cA, 0, cv); PG8_STAGE_A(PG8_SA(0, 1), cA, 1, cv);
    if (wr == 1) PG8_BAR;
    PG8_WAIT_V(2); PG8_BAR;
    PG8_STAGE(PG8_SB(1, 0), cB + kstep, voffB); PG8_STAGE_A(PG8_SA(1, 0), cA + kstep, 0, cv); PG8_STAGE(PG8_SB(1, 1), cB + hstep + kstep, voffB);
    PG8_WAIT_V(6); PG8_BAR;
    for (;;) {
        if constexpr (Epi::MIDK) E.begin(cur, wr, fr);
        const bool has_next = S.next(ui + 1, nxt);
        const char* nA = GATHER ? (const char*)g.A : (has_next ? (const char*)g.A + (size_t)nxt.pm * tstep : cA); const char* nB = has_next ? (const char*)g.Bt + (size_t)nxt.pn * tstep : cB;
        if constexpr (GATHER) {
            if (has_next) PG8_GOFF(nv, nxt);
        }
#pragma nounroll
        for (int t = 0; t < nt; t += 2) {
            const bool last = (t == nt - 2);
            if constexpr (Epi::MIDK) { if (t == (nt >> 1)) E.midk(acc); }
            const char* a1 = cA + (size_t)(t + 1) * kstep;
            const char* a2 = last ? nA : cA + (size_t)(t + 2) * kstep; const char* b2 = last ? nB : cB + (size_t)(t + 2) * kstep;
            const char* a3 = a2 + kstep; const char* b3 = b2 + kstep;
            PG8_LDB(B0, 0, 0); PG8_LDB(B1, 0, 1); PG8_SCHED; PG8_LDA(At, 0, 0); PG8_STAGE_A(PG8_SA(1, 1), a1, 1, cv);
            PG8_WAIT_V(8); PG8_WAIT_L(0); PG8_BAR; PG8_SCHED; PG8_MMA(0, 0, At, B0); PG8_MMA(0, 1, At, B1); PG8_BAR; PG8_SCHED;
            PG8_LDA(At, 0, 1); PG8_STAGE(PG8_SB(0, 0), b2, voffB); PG8_STAGE(PG8_SB(0, 1), b2 + hstep, voffB); PG8_STAGE_A2(PG8_SA(0, 0), a2, 0);
            PG8_WAIT_V(8); PG8_WAIT_L(0); PG8_BAR; PG8_SCHED; PG8_MMA(1, 0, At, B0); PG8_MMA(1, 1, At, B1); PG8_BAR; PG8_SCHED;
            PG8_LDB(B0, 1, 0); PG8_LDB(B1, 1, 1); PG8_SCHED; PG8_LDA(At, 1, 0); PG8_STAGE_A2(PG8_SA(0, 1), a2, 1);
            PG8_WAIT_V(8); PG8_WAIT_L(0); PG8_BAR; PG8_SCHED; PG8_MMA(0, 0, At, B0); PG8_MMA(0, 1, At, B1); PG8_BAR; PG8_SCHED;
            PG8_LDA(At, 1, 1); PG8_STAGE(PG8_SB(1, 0), b3, voffB); PG8_STAGE(PG8_SB(1, 1), b3 + hstep, voffB); PG8_STAGE_A2(PG8_SA(1, 0), a3, 0);
            PG8_WAIT_V(8); PG8_WAIT_L(0); PG8_BAR; PG8_SCHED; PG8_MMA(1, 0, At, B0); PG8_MMA(1, 1, At, B1); PG8_BAR; PG8_SCHED;
        }
        if constexpr (ALIGN_EPI) { if (wr == 0) PG8_BAR; }
        { const int l_ = ltid() & 63; E(acc, cur, wr, wc, l_ & 15, l_ >> 4); }
        if (!has_next) break;
#pragma unroll
        for (int a = 0; a < 2; ++a)
#pragma unroll
            for (int b = 0; b < 2; ++b)
#pragma unroll
                for (int m = 0; m < 4; ++m)
#pragma unroll
                    for (int n = 0; n < 2; ++n) acc[a][b][m][n] = (f32x4){0.f, 0.f, 0.f, 0.f};
        cur = nxt; cA = nA; cB = nB; ++ui;
#pragma unroll
        for (int h = 0; h < 2; ++h)
#pragma unroll
            for (int i = 0; i < 2; ++i) cv[h][i] = nv[h][i];
        if constexpr (ALIGN_EPI) { if (wr == 1) PG8_BAR; }
    }
    PG8_WAIT_V(0);
    if constexpr (!ALIGN_EPI) { if (wr == 0) PG8_BAR; }
    PG8_BAR;
#undef PG8_SA
#undef PG8_SB
#undef PG8_STAGE
#undef PG8_STAGE_A
#undef PG8_STAGE_A2
#undef PG8_LDA
#undef PG8_LDB
#undef PG8_MMA
#undef PG8_GOFF
#undef PG8_GLDS
#undef PG8_DSR
#undef PG8_WAIT_V
#undef PG8_WAIT_L
#undef PG8_BAR
#undef PG8_SCHED
}
}


namespace att {
constexpr int D = 128, NW = 8, QBLK = 32, KVBLK = 64, QB = 256;
constexpr int SHM_V = 16384, SHM_K = 16384;
constexpr int OFF_WS = 2 * SHM_V + 2 * SHM_K, OFF_KBF = OFF_WS + NW * 256, OFF_LUT = OFF_KBF + 16384, LDS_ATT = OFF_LUT + 2304;
constexpr float SCALE = 0.08838834764831845f, ISCALE = 11.313708498984761f, THR = 8.f;
typedef short s16x4 __attribute__((ext_vector_type(4)));
typedef float f32x16 __attribute__((ext_vector_type(16)));
#define KSWZ(row, colB) ((row) * 256 + ((colB) ^ (((row) & 7) << 4)))
#define SBAR() __builtin_amdgcn_sched_barrier(0)
__device__ __forceinline__ int v_st(int k, int c) { const int kk = (k & ~0xC) | ((k & 4) << 1) | ((k & 8) >> 1); return ((kk >> 3) * 4 + (c >> 5)) * 512 + ((kk & 7) * 32 + (c & 31)) * 2; }
__device__ __forceinline__ int v_rd_base(int lane) { return ((lane & 3) << 3) | (((lane >> 2) & 3) << 6) | (((lane >> 4) & 1) << 5) | (((lane >> 5) & 1) << 8); }
constexpr int v_rd_off(int d0, int ks, int half) { return d0 * 512 + ks * 4096 + half * 2048; }
__device__ __forceinline__ int crow(int r, int hi) { return (r & 3) + 8 * (r >> 2) + 4 * hi; }
__device__ __forceinline__ unsigned cvtpk(float lo, float hi) { unsigned r; asm volatile("v_cvt_pk_bf16_f32 %0, %1, %2" : "=v"(r) : "v"(lo), "v"(hi)); return r; }
__device__ __forceinline__ void mask_tile(f32x16& p0, f32x16& p1, int dq) {
    const float NEG = -__builtin_inff();
#pragma unroll
    for (int r = 0; r < 16; ++r) { const int c = (r & 3) + 8 * (r >> 2);
        if (dq - c < 0) p0[r] = NEG;
        if (dq - c - 32 < 0) p1[r] = NEG; }
}
__device__ __forceinline__ void partialSM(f32x16& p0, f32x16& p1, float& m_reg, float& mn, float& alpha) {
    float pmax = p0[0]; for (int r = 1; r < 16; ++r) pmax = fmaxf(pmax, p0[r]); for (int r = 0; r < 16; ++r) pmax = fmaxf(pmax, p1[r]);
    { auto rr = __builtin_amdgcn_permlane32_swap(__float_as_uint(pmax), __float_as_uint(pmax), false, false);
      pmax = fmaxf(__uint_as_float(rr[0]), __uint_as_float(rr[1])); }
    constexpr float C2 = 1.4426950408889634f * SCALE;
    if (__builtin_expect(__all((pmax - m_reg) * SCALE <= THR), 1)) { mn = m_reg; alpha = 1.f; }
    else { mn = fmaxf(m_reg, pmax); alpha = __builtin_amdgcn_exp2f((m_reg - mn) * C2); m_reg = mn; }
    const float mnL = -mn * C2;
    for (int r = 0; r < 16; ++r) p0[r] = fmaf(p0[r], C2, mnL); for (int r = 0; r < 16; ++r) p1[r] = fmaf(p1[r], C2, mnL);
    for (int r = 0; r < 16; ++r) p0[r] = __builtin_amdgcn_exp2f(p0[r]);
}
__device__ __forceinline__ void finishSM(f32x16& p0, f32x16& p1, float alpha, float& l_reg, bf16x8& pa0, bf16x8& pa1, bf16x8& pa2, bf16x8& pa3) {
    for (int r = 0; r < 16; ++r) p1[r] = __builtin_amdgcn_exp2f(p1[r]);
    float ps = 0; for (int r = 0; r < 16; ++r) ps += p0[r]; for (int r = 0; r < 16; ++r) ps += p1[r];
    { auto rr = __builtin_amdgcn_permlane32_swap(__float_as_uint(ps), __float_as_uint(ps), false, false);
      ps = __uint_as_float(rr[0]) + __uint_as_float(rr[1]); }
    l_reg = l_reg * alpha + ps;
#define PK4(P, B_, OUT) do { unsigned a0 = cvtpk(P[B_+0], P[B_+1]), a1 = cvtpk(P[B_+2], P[B_+3]);                          \
        unsigned b0 = cvtpk(P[B_+4], P[B_+5]), b1 = cvtpk(P[B_+6], P[B_+7]);                                             \
        auto r0 = __builtin_amdgcn_permlane32_swap(a0, b0, false, false); auto r1 = __builtin_amdgcn_permlane32_swap(a1, b1, false, false); \
        u32x4 w = {r0[0], r1[0], r0[1], r1[1]}; OUT = *reinterpret_cast<bf16x8*>(&w); } while (0)
    PK4(p0, 0, pa0); PK4(p0, 8, pa1); PK4(p1, 0, pa2); PK4(p1, 8, pa3);
#undef PK4
}
struct InitCtx {
    const LAS float* kbl;
    int own, qlo, qpos4;
    unsigned sel;
};
template <int KB, int MODE>
__device__ __forceinline__ void qkt(f32x16& p0, f32x16& p1, const char* K_lds, int r32, int hi, const bf16x8* qr, const InitCtx& ic, int kbase) {
    if (MODE == 0) {
        const LAS float* kb = ic.kbl + kbase;
#pragma unroll
        for (int i = 0; i < 4; ++i) { const f32x4 a = *(const LAS f32x4*)(kb + 8 * i), b = *(const LAS f32x4*)(kb + 32 + 8 * i);
            p0[4 * i] = a[0]; p0[4 * i + 1] = a[1]; p0[4 * i + 2] = a[2]; p0[4 * i + 3] = a[3]; p1[4 * i] = b[0]; p1[4 * i + 1] = b[1]; p1[4 * i + 2] = b[2]; p1[4 * i + 3] = b[3]; }
    } else {
        const int jb = kbase >> 8; const bool rowok = (jb >= ic.own) || (((ic.sel >> jb) & 1u) != 0u);
        int B = ic.qpos4 - kbase + 256 - 59; B = B > 384 ? 384 : B; B = rowok ? B : 512; asm volatile("" : "+v"(B));
        const LAS float* lp = ic.kbl + B;
#pragma unroll
        for (int r = 0; r < 16; ++r) { const int c = (r & 3) + 8 * (r >> 2); p0[r] = lp[59 - c]; p1[r] = lp[59 - c - 32]; }
    }
    const char* kb[4];
#pragma unroll
    for (int dd = 0; dd < 4; ++dd) kb[dd] = K_lds + KB * SHM_K + KSWZ(r32, (dd * 16 + hi * 8) * 2);
#pragma unroll
    for (int d0 = 0; d0 < 8; ++d0) { const char* a = kb[d0 & 3] + (d0 >> 2) * 128;
        bf16x8 b0 = *reinterpret_cast<const bf16x8*>(a);
        bf16x8 b1 = *reinterpret_cast<const bf16x8*>(a + 32 * 256);
        p0 = __builtin_amdgcn_mfma_f32_32x32x16_bf16(b0, qr[d0], p0, 0, 0, 0);
        p1 = __builtin_amdgcn_mfma_f32_32x32x16_bf16(b1, qr[d0], p1, 0, 0, 0); }
}
template <int VB>
__device__ __forceinline__ void pv_tile(f32x16* o, int vb0, bf16x8 pa0, bf16x8 pa1, bf16x8 pa2, bf16x8 pa3) {
#define TRRD(dst, off) asm volatile("ds_read_b64_tr_b16 %0, %1 offset:%2" : "=&v"(dst) : "v"(vb0), "i"(off) : "memory")
#define PV_D0(d0) do { s16x4 l0, l1, l2, l3, h0, h1, h2, h3; constexpr int b_ = VB * SHM_V + v_rd_off(d0, 0, 0); \
        TRRD(l0, b_); TRRD(h0, b_ + 2048); TRRD(l1, b_ + 4096); TRRD(h1, b_ + 6144); TRRD(l2, b_ + 8192); TRRD(h2, b_ + 10240); TRRD(l3, b_ + 12288); TRRD(h3, b_ + 14336); \
        asm volatile("s_waitcnt lgkmcnt(0)" ::: "memory"); SBAR();   \
        o[d0] = __builtin_amdgcn_mfma_f32_32x32x16_bf16(pa0, (bf16x8){l0[0], l0[1], l0[2], l0[3], h0[0], h0[1], h0[2], h0[3]}, o[d0], 0, 0, 0);   \
        o[d0] = __builtin_amdgcn_mfma_f32_32x32x16_bf16(pa1, (bf16x8){l1[0], l1[1], l1[2], l1[3], h1[0], h1[1], h1[2], h1[3]}, o[d0], 0, 0, 0);   \
        o[d0] = __builtin_amdgcn_mfma_f32_32x32x16_bf16(pa2, (bf16x8){l2[0], l2[1], l2[2], l2[3], h2[0], h2[1], h2[2], h2[3]}, o[d0], 0, 0, 0);   \
        o[d0] = __builtin_amdgcn_mfma_f32_32x32x16_bf16(pa3, (bf16x8){l3[0], l3[1], l3[2], l3[3], h3[0], h3[1], h3[2], h3[3]}, o[d0], 0, 0, 0); } while (0)
    PV_D0(0); PV_D0(1); PV_D0(2); PV_D0(3);
#undef PV_D0
#undef TRRD
}
struct BlockRef { const bf16* Q; const bf16* K; const bf16* V; unsigned char* O; float* SS; int P0; int bh; };
struct Seam { bf16x8 qr[8]; bf16x8 st_v0, st_v1, st_k0, st_k1; };
#define ROW(p, k0, rr) ((p) + (size_t)((k0) + (rr)) * D + sc)
#define VMW() asm volatile("s_waitcnt vmcnt(0)" ::: "memory")
#define VMWN(n) asm volatile("s_waitcnt vmcnt(%0)" :: "i"(n) : "memory")
#define LD8(p) (*reinterpret_cast<const bf16x8*>(p))
#define SLOAD_H(Kp, Vp, k0) do { S.st_v0 = LD8(ROW(Vp, k0, sr)); S.st_v1 = LD8(ROW(Vp, k0, 32 + sr));              \
                         S.st_k0 = LD8(ROW(Kp, k0, sr)); S.st_k1 = LD8(ROW(Kp, k0, 32 + sr)); } while (0)
#define SWRITE_HK(bf) do { *(bf16x8*)(K_lds + (bf) * SHM_K + kws) = S.st_k0; *(bf16x8*)(K_lds + (bf) * SHM_K + kws + 32 * 256) = S.st_k1; } while (0)
#define SWRITE_HV(bf) do { *(bf16x8*)(V_lds + (bf) * SHM_V + vst0) = S.st_v0; *(bf16x8*)(V_lds + (bf) * SHM_V + vst1) = S.st_v1; } while (0)
#define SWRITE_H(bf) do { SWRITE_HV(bf); SWRITE_HK(bf); } while (0)
__device__ __forceinline__ void attn_prime(const BlockRef& cur, char* lds, Seam& S) {
    const int tid = ltid(), wid = __builtin_amdgcn_readfirstlane(tid >> 6), lane = tid & 63, r32 = lane & 31, hi = lane >> 5;
    const int sr = tid >> 4, sc = (tid & 15) * 8, kws = KSWZ(sr, sc * 2); char* K_lds = lds + 2 * SHM_V;
    for (int d0 = 0; d0 < 8; ++d0) S.qr[d0] = LD8(cur.Q + (size_t)(wid * QBLK + r32) * D + d0 * 16 + hi * 8);
    SLOAD_H(cur.K, cur.V, 0); VMW(); SWRITE_HK(0);
    __syncthreads();
}
template <int MODE>
__device__ __forceinline__ void attn_block(const BlockRef& cur, const BlockRef& nxt, LAS unsigned char* L, Seam& S, const float* cbuf, const bf16* kmean, const float* rel_bias) {
    char* lds = (char*)L;
    const int tid = ltid(), wid = __builtin_amdgcn_readfirstlane(tid >> 6), lane = tid & 63, r32 = lane & 31, hi = lane >> 5;
    const int NT = (cur.P0 + QB) / KVBLK;
    const int qlo = cur.P0 + wid * QBLK, qm = qlo + r32 - 4 * hi;
    char* V_lds = lds; char* K_lds = lds + 2 * SHM_V;
    float* ws = (float*)(lds + OFF_WS) + wid * 64; float* li_l = ws, * al_l = ws + 32;
    float m_reg = -1e30f, l_reg = 0; f32x16 o[4] = {};
    const int sr = tid >> 4, sc = (tid & 15) * 8, vst0 = v_st(sr, sc), vst1 = v_st(32 + sr, sc), kws = KSWZ(sr, sc * 2);
    const int vb0 = (int)(uintptr_t)V_lds + v_rd_base(lane);
    const bf16* Kh = cur.K; const bf16* Vh = cur.V;
    InitCtx ic; ic.own = cur.P0 >> 8; ic.qlo = qlo; ic.qpos4 = qm; ic.sel = 0u;
    const int h = cur.bh & 7;
    if (MODE == 0) {
        LAS float* kbf = (LAS float*)(L + OFF_KBF);
        const float* cs = cbuf + (size_t)cur.bh * SEQ; const float cref = cs[cur.P0];
        for (int j = tid; j < cur.P0 + QB; j += NTHR) kbf[j] = (cref - cs[j]) * ISCALE;
        ic.kbl = kbf + 4 * hi;
    } else {
        LAS float* lutX = (LAS float*)(L + OFF_LUT);
        { int d = tid - 256; if (d < 0) d = 0; if (d > 128) d = 128; int bk; if (d < 16) bk = d; else { bk = 16 + (int)(logf((float)d / 16.0f) / 2.0794415416798357f * 16.0f); if (bk > 31) bk = 31; }
          lutX[tid] = rel_bias[h * 32 + bk] * ISCALE; if (tid < 64) lutX[512 + tid] = -__builtin_inff(); }
        ic.kbl = lutX;
        f32x16 g = {};
        const bf16* km = kmean + ((size_t)cur.bh * 16 + (r32 & 15)) * 128 + hi * 8;
#pragma unroll
        for (int d0 = 0; d0 < 8; ++d0) { bf16x8 a = LD8(km + d0 * 16); if (r32 >= 16) a = (bf16x8){0, 0, 0, 0, 0, 0, 0, 0}; g = __builtin_amdgcn_mfma_f32_32x32x16_bf16(a, S.qr[d0], g, 0, 0, 0); }
        float gt[16];
#pragma unroll
        for (int n = 0; n < 16; ++n) { const int hh = (n >> 2) & 1, r = (n & 3) + 4 * (n >> 3); const float mine = g[r], oth = __shfl_xor(mine, 32); gt[n] = (hh == hi) ? mine : oth; }
        unsigned sel = 0u;
#pragma unroll
        for (int k = 0; k < 3; ++k) { float best = -__builtin_inff(); int bi = 16;
#pragma unroll
            for (int n = 0; n < 16; ++n) { const bool ok = (n < ic.own) && (((sel >> n) & 1u) == 0u) && (gt[n] > best); best = ok ? gt[n] : best; bi = ok ? n : bi; }
            if (bi < 16) sel |= 1u << bi; }
        ic.sel = sel;
    }
    __syncthreads();
#define RESC(a) do { if (__any((a) < 1.f)) { if (hi == 0) al_l[r32] = (a); asm volatile("s_waitcnt lgkmcnt(0)" ::: "memory");              \
                     for (int d_ = 0; d_ < 4; ++d_) for (int r = 0; r < 16; ++r) o[d_][r] *= al_l[crow(r, hi)]; } } while (0)
#define KBASE(t) ((t) * KVBLK)
#define MASKT(P0_, P1_, t) do { const int kb_ = KBASE(t); if (kb_ + KVBLK - 1 > qlo) mask_tile(P0_, P1_, qm - kb_); } while (0)
    constexpr int NQL = 8;
#define SEAM_K0() do { VMWN(NQL); SWRITE_HK(0); SBAR(); } while (0)
    f32x16 pA0, pA1, pB0, pB1; float mnA, mnB, alA, alB; bf16x8 pa0, pa1, pa2, pa3;
    SWRITE_HV(0); SBAR();
    if (NT > 1) { SLOAD_H(Kh, Vh, KBASE(1)); }
    SBAR(); qkt<0, MODE>(pA0, pA1, K_lds, r32, hi, S.qr, ic, KBASE(0));
    MASKT(pA0, pA1, 0); partialSM(pA0, pA1, m_reg, mnA, alA);
    if (NT > 1) { VMW(); SWRITE_H(1); }
    __syncthreads();
#define HALF_STEP(PX0, PX1, mnX, alX, PY0, PY1, alY, t, KB, VB, SB) do {                                                      \
        SBAR(); qkt<KB, MODE>(PX0, PX1, K_lds, r32, hi, S.qr, ic, KBASE(t));                                             \
        finishSM(PY0, PY1, alY, l_reg, pa0, pa1, pa2, pa3); SBAR();                                                           \
        if ((t) + 1 < NT) { SLOAD_H(Kh, Vh, KBASE((t) + 1)); SBAR(); }                                               \
        pv_tile<VB>(o, vb0, pa0, pa1, pa2, pa3); MASKT(PX0, PX1, (t)); partialSM(PX0, PX1, m_reg, mnX, alX);                                        \
        __syncthreads();                                                                                                      \
        if ((t) + 1 < NT) { VMW(); SWRITE_H(SB); }                                                                          \
        RESC(alX); __syncthreads(); } while (0)
    for (int t = 1; t + 1 < NT; t += 2) {
        HALF_STEP(pB0, pB1, mnB, alB, pA0, pA1, alA, t, 1, 0, 0);
        HALF_STEP(pA0, pA1, mnA, alA, pB0, pB1, alB, t + 1, 0, 1, 1);
    }
    const bool even = (NT & 1) == 0;
    if (even) { SBAR(); qkt<1, MODE>(pB0, pB1, K_lds, r32, hi, S.qr, ic, KBASE(NT - 1)); SBAR(); }
    SLOAD_H(nxt.K, nxt.V, 0); SBAR();
#pragma unroll
    for (int d0 = 0; d0 < 8; ++d0) S.qr[d0] = LD8(nxt.Q + (size_t)(wid * QBLK + r32) * D + d0 * 16 + hi * 8);
    SBAR();
    finishSM(pA0, pA1, alA, l_reg, pa0, pa1, pa2, pa3); SBAR();
    pv_tile<0>(o, vb0, pa0, pa1, pa2, pa3);
    if (even) { MASKT(pB0, pB1, NT - 1); partialSM(pB0, pB1, m_reg, mnB, alB); __syncthreads(); RESC(alB);
        finishSM(pB0, pB1, alB, l_reg, pa0, pa1, pa2, pa3); SBAR(); pv_tile<1>(o, vb0, pa0, pa1, pa2, pa3); }
    SBAR(); SEAM_K0();
    if (hi == 0) li_l[r32] = l_reg; asm volatile("s_waitcnt lgkmcnt(0)" ::: "memory");
    float rli[16];
#pragma unroll
    for (int r = 0; r < 16; ++r) rli[r] = __builtin_amdgcn_rcpf(li_l[crow(r, hi)]);
    unsigned char* Ow = cur.O + (size_t)(wid * QBLK) * DM * (WO_FP8 ? 1 : 2); float* Sw = cur.SS + (size_t)(wid * QBLK) * 16;
#define DPPF(x, ctrl) __builtin_bit_cast(float, __builtin_amdgcn_mov_dpp(__builtin_bit_cast(int, (x)), (ctrl), 0xF, 0xF, true))
#pragma unroll
    for (int r = 0; r < 16; ++r) { const int orow = crow(r, hi); float sq = 0.f;
#pragma unroll
        for (int d0 = 0; d0 < 4; ++d0) { const float v = o[d0][r] * rli[r]; sq += v * v;
            if (WO_FP8) { const float vs = v * SC_AO, q1 = DPPF(vs, 0xB1), q2 = DPPF(vs, 0x4E), q3 = DPPF(q1, 0x4E);
                if ((r32 & 3) == 0) *(unsigned*)(Ow + (size_t)orow * DM + d0 * 32 + r32) = cvt_pk4_fp8(vs, q1, q2, q3); }
            else { const float vn = DPPF(v, 0xB1);
                if ((r32 & 1) == 0) *(unsigned*)(Ow + ((size_t)orow * DM + d0 * 32 + r32) * 2) = cvtpk(v, vn); } }
        sq += DPPF(sq, 0xB1); sq += DPPF(sq, 0x4E); sq += DPPF(sq, 0x124); sq += DPPF(sq, 0x128); sq += __shfl_xor(sq, 16);
        if (r32 == 0) Sw[(size_t)orow * 16] = sq; }
#undef DPPF
    __syncthreads();
#undef RESC
#undef KBASE
#undef MASKT
#undef SEAM_K0
#undef HALF_STEP
}
#undef ROW
#undef VMW
#undef VMWN
#undef LD8
#undef SLOAD_H
#undef SWRITE_HK
#undef SWRITE_HV
#undef SWRITE_H
#undef KSWZ
#undef SBAR
}

#define XB_TMO      128
#define XB_XCNT(j)  (256  + 64 * (j))
#define XB_XSUB(j)  (1280 + 64 * (j))
#define XB_XGEN(j)  (2304 + 64 * (j))
#define XB_TOP      3328
#define XB_TOPGEN   3392
#define XCD_BAR_WORDS 3456
#define XB_SPIN_CAP (1u << 18)
__device__ __forceinline__ unsigned xb_ld(unsigned* p)              { return __hip_atomic_load(p, __ATOMIC_RELAXED, __HIP_MEMORY_SCOPE_AGENT); }
__device__ __forceinline__ unsigned xb_add(unsigned* p, unsigned v) { return __hip_atomic_fetch_add(p, v, __ATOMIC_RELAXED, __HIP_MEMORY_SCOPE_AGENT); }
__device__ __forceinline__ unsigned xb_xcc_id() { return (unsigned)__builtin_amdgcn_s_getreg((3 << 11) | 20) & 0xFu; }
#define XB_SPIN(cond, bar) do { unsigned _sp = 0; while (cond) { __builtin_amdgcn_s_sleep(1); \
    if ((++_sp & 255u) == 0u) { if (xb_ld(&(bar)[XB_TMO])) break; if (_sp > XB_SPIN_CAP) { atomicAdd(&(bar)[XB_TMO], 1u); break; } } } } while (0)
struct XcdBarrier { unsigned* bar; unsigned x; volatile LAS unsigned* st; };
__device__ __forceinline__ XcdBarrier xcd_barrier_post(unsigned* bar, volatile LAS unsigned* st) {
    XcdBarrier b; b.bar = bar; b.x = xb_xcc_id(); b.st = st;
    if (threadIdx.x == 0) (void)xb_add(&bar[XB_XCNT(b.x)], 1u);
    return b;
}
__device__ __forceinline__ void xcd_barrier_complete(unsigned* bar, unsigned x, unsigned& nloc, unsigned& nx) {
    const unsigned G = gridDim.x * gridDim.y * gridDim.z;
    unsigned sum, cnt, mine, sp = 0u;
    for (;;) {
        sum = 0u; cnt = 0u; mine = 0u;
#pragma unroll
        for (unsigned j = 0; j < 16; ++j) { const unsigned c = xb_ld(&bar[XB_XCNT(j)]); sum += c; cnt += (c > 0u) ? 1u : 0u; mine = (j == x) ? c : mine; }
        if (sum == G) break;
        __builtin_amdgcn_s_sleep(1);
        if ((++sp & 255u) == 0u) { if (xb_ld(&bar[XB_TMO])) break; if (sp > XB_SPIN_CAP) { atomicAdd(&bar[XB_TMO], 1u); break; } }
    }
    nloc = mine > 0u ? mine : 1u; nx = cnt > 0u ? cnt : 1u;
}
__device__ __forceinline__ void xcd_barrier(const XcdBarrier& b) {
    asm volatile("s_waitcnt vmcnt(0)" ::: "memory");
    __syncthreads();
    if (threadIdx.x == 0) {
        unsigned* bar = b.bar;
        __builtin_amdgcn_s_waitcnt(0);
        unsigned nloc = b.st[0], nx = b.st[1];
        if (nloc == 0u) { xcd_barrier_complete(bar, b.x, nloc, nx); b.st[0] = nloc; b.st[1] = nx; }
        const unsigned old = xb_add(&bar[XB_XSUB(b.x)], 1u);
        const unsigned gen = old / nloc;
        if (old + 1u == (gen + 1u) * nloc) {
            __builtin_amdgcn_fence(__ATOMIC_RELEASE, "agent");
            asm volatile("s_waitcnt vmcnt(0)" ::: "memory");
            const unsigned og = xb_add(&bar[XB_TOP], 1u);
            const unsigned tg = og / nx;
            if (og + 1u == (tg + 1u) * nx) xb_add(&bar[XB_TOPGEN], 1u);
            else XB_SPIN(xb_ld(&bar[XB_TOPGEN]) == tg, bar);
            __builtin_amdgcn_fence(__ATOMIC_ACQUIRE, "agent");
            xb_add(&bar[XB_XGEN(b.x)], 1u);
            asm volatile("s_waitcnt vmcnt(0)" ::: "memory");
        } else {
            XB_SPIN(xb_ld(&bar[XB_XGEN(b.x)]) == gen, bar);
            __builtin_amdgcn_fence(__ATOMIC_ACQUIRE, "agent");
            asm volatile("s_waitcnt vmcnt(0)" ::: "memory");
        }
    }
    __syncthreads();
}

struct Args { const float* in[17]; float* out; unsigned char* ws; int ph_lo, ph_hi; };
typedef const __attribute__((address_space(4))) Args* KArgP;
struct Frame {
    LAS unsigned char* lds; unsigned* ctl; unsigned char* ws;
    int tid, lane, wave, G, bx;
    KArgP ka;
};
#define INP(k) (F.ka->in[k])
__device__ __forceinline__ void phase_begin(Frame& F) {
    F.tid = ltid(); F.lane = F.tid & 63; F.wave = __builtin_amdgcn_readfirstlane(F.tid >> 6);
    KArgP p = (KArgP)__builtin_amdgcn_kernarg_segment_ptr(); asm volatile("" : "+s"(p)); F.ka = p;
}

template <bool Q8> struct EpiQKV {
    static constexpr bool PERM = true, MIDK = false;
    bf16* qkv;
    __device__ __forceinline__ void operator()(const f32x4 (&acc)[2][2][4][2], const pg8::Unit& u, int wr, int wc, int fr, int fq) const {
        const int which = grp_nth(u.pn >> 2, Q8), hp = u.pn & 3, b = (u.pm * 256) >> 12, s0 = (u.pm * 256) & 4095; const float sc = Q8 ? (1.0f / SC_WIN) : 1.0f;
#pragma unroll
        for (int ai = 0; ai < 2; ++ai)
#pragma unroll
            for (int m = 0; m < 4; ++m) { const int s = s0 + ai * 128 + wr * 64 + m * 16 + fr;
#pragma unroll
                for (int bj = 0; bj < 2; ++bj) { const int head = hp * 2 + bj;
                    bf16* dst = qkv + ((((size_t)(which * 4 + b) * 8 + head) * 4096 + s) * 128 + wc * 32 + 8 * fq);
                    const f32x4 v0 = acc[ai][bj][m][0] * sc, v1 = acc[ai][bj][m][1] * sc;
                    u32x4 w; w.x = cvt_pk_bf16(v0[0], v0[1]); w.y = cvt_pk_bf16(v0[2], v0[3]); w.z = cvt_pk_bf16(v1[0], v1[1]); w.w = cvt_pk_bf16(v1[2], v1[3]);
                    *(u32x4*)dst = w; } }
    }
};
struct EpiRes {
    static constexpr bool PERM = true, MIDK = true;
    const float* x; bf16* xb; unsigned char* xq; const float* ssqp;
    LAS float* tab; int par;
    __device__ __forceinline__ void begin(const pg8::Unit& u, int wr, int fr) {
        (void)wr; (void)fr; par ^= 1;
        const int t = ltid();
        if (t < 256) { const f32x4* p = (const f32x4*)(ssqp + (size_t)(u.pm * 256 + t) * 16); const f32x4 a = p[0], b = p[1], c = p[2], d = p[3];
            const float sf = ((a[0] + a[1]) + (a[2] + a[3])) + ((b[0] + b[1]) + (b[2] + b[3])), sm = ((c[0] + c[1]) + (c[2] + c[3])) + ((d[0] + d[1]) + (d[2] + d[3]));
            const float qf = sqrtf(sf * (1.0f / GWID) + EPS), qm = sqrtf(sm * (1.0f / GWID) + EPS);
            tab[par * 512 + t] = qm / qf; tab[par * 512 + 256 + t] = (WO_FP8 ? 1.0f / (SC_AO * SC_WO) : 1.0f) / qm; }
    }
    __device__ __forceinline__ void midk(f32x4 (&acc)[2][2][4][2]) const {
        const int t = ltid(), r0 = ((t >> 8) & 1) * 64 + (t & 15);
#pragma unroll
        for (int ai = 0; ai < 2; ++ai)
#pragma unroll
            for (int m = 0; m < 4; ++m) { const float rt = tab[par * 512 + ai * 128 + m * 16 + r0];
#pragma unroll
                for (int bj = 0; bj < 2; ++bj)
#pragma unroll
                    for (int n = 0; n < 2; ++n) acc[ai][bj][m][n] *= rt; }
    }
    __device__ __forceinline__ void operator()(const f32x4 (&acc)[2][2][4][2], const pg8::Unit& u, int wr, int wc, int fr, int fq) const {
        asm volatile("" : "+v"(fr), "+v"(fq));
        const int row0 = u.pm * 256 + wr * 64 + fr, col0 = u.pn * 256 + wc * 32 + 8 * fq;
        float rsm[2][4];
#pragma unroll
        for (int ai = 0; ai < 2; ++ai)
#pragma unroll
            for (int m = 0; m < 4; ++m) rsm[ai][m] = tab[par * 512 + 256 + ai * 128 + wr * 64 + m * 16 + fr];
#pragma unroll
        for (int ai = 0; ai < 2; ++ai) {
            f32x4 xv[4][2][2];
#pragma unroll
            for (int m = 0; m < 4; ++m)
#pragma unroll
                for (int bj = 0; bj < 2; ++bj)
#pragma unroll
                    for (int n = 0; n < 2; ++n) xv[m][bj][n] = *(const f32x4*)(x + (size_t)(row0 + ai * 128 + m * 16) * DM + col0 + bj * 128 + 4 * n);
#pragma unroll
            for (int m = 0; m < 4; ++m)
#pragma unroll
                for (int bj = 0; bj < 2; ++bj) { const float sc = rsm[ai][m]; const f32x4 v0 = xv[m][bj][0] + acc[ai][bj][m][0] * sc, v1 = xv[m][bj][1] + acc[ai][bj][m][1] * sc;
                    u32x4 w; w.x = cvt_pk_bf16(v0[0], v0[1]); w.y = cvt_pk_bf16(v0[2], v0[3]); w.z = cvt_pk_bf16(v1[0], v1[1]); w.w = cvt_pk_bf16(v1[2], v1[3]);
                    *(u32x4*)(xb + (size_t)(row0 + ai * 128 + m * 16) * DM + col0 + bj * 128) = w;
                    u32x2 q8; q8.x = cvt_pk4_fp8(v0[0], v0[1], v0[2], v0[3]); q8.y = cvt_pk4_fp8(v1[0], v1[1], v1[2], v1[3]);
                    *(u32x2*)(xq + (size_t)(row0 + ai * 128 + m * 16) * DM + col0 + bj * 128) = q8; }
        }
    }
};
struct MoeOrder {
    int G, c, ncol; const LAS int* tt;
    __device__ __forceinline__ bool next(int i, pg8::Unit& u) const {
        const int nt = __builtin_amdgcn_readfirstlane(tt[0]); const long L = (long)i * G + c; if (L >= (long)nt * ncol) return false;
        const int t = (int)(L / ncol), pnl = (int)(L % ncol); const int e = __builtin_amdgcn_readfirstlane(tt[16 + t]) & 0xff;
        u.pm = t; u.pn = e * ncol + pnl; return true;
    }
};
struct MoeGather : MoeOrder {
    const int* list;
    __device__ __forceinline__ int arow(const pg8::Unit& u, int r) const {
        const int w = __builtin_amdgcn_readfirstlane(tt[16 + u.pm]); const int e = w & 0xff, rb = w >> 8; const int cnt = __builtin_amdgcn_readfirstlane(tt[256 + e]);
        const int pos = rb * 256 + r; int tok = 0; if (pos < cnt) tok = list[e * ECAP + pos]; return tok;
    }
};
struct MoePlain : MoeOrder { __device__ __forceinline__ int arow(const pg8::Unit&, int) const { return 0; } };
struct EpiHid {
    static constexpr bool PERM = true, MIDK = false;
    unsigned char* hid; const float* rsr; const float* rsw; const LAS int* tt;
    __device__ __forceinline__ void operator()(const f32x4 (&acc)[2][2][4][2], const pg8::Unit& u, int wr, int wc, int fr, int fq) const {
        const int w = __builtin_amdgcn_readfirstlane(tt[16 + u.pm]); const int e = w & 0xff, rb = w >> 8, pnl = u.pn & 3; const int cnt = __builtin_amdgcn_readfirstlane(tt[256 + e]);
#pragma unroll
        for (int ai = 0; ai < 2; ++ai)
#pragma unroll
            for (int m = 0; m < 4; ++m) { const int r = ai * 128 + wr * 64 + m * 16 + fr, pos = rb * 256 + r; float rs = 0.f, cw = 0.f;
                if (pos < cnt) { rs = rsr[e * ECAP + pos] * (1.0f / SC_WGU); cw = rsw[e * ECAP + pos] * SC_HID; }
                float o[8];
#pragma unroll
                for (int n = 0; n < 2; ++n)
#pragma unroll
                    for (int j = 0; j < 4; ++j) { const float gv = acc[ai][0][m][n][j] * rs, uv = acc[ai][1][m][n][j] * rs; o[n * 4 + j] = gv / (1.f + __expf(-gv)) * uv * cw; }
                u32x2 pk; pk.x = cvt_pk4_fp8(o[0], o[1], o[2], o[3]); pk.y = cvt_pk4_fp8(o[4], o[5], o[6], o[7]);
                *(u32x2*)(hid + (size_t)(u.pm * 256 + r) * DE + pnl * 128 + wc * 32 + 8 * fq) = pk; }
    }
};
struct EpiY {
    static constexpr bool PERM = true, MIDK = false;
    unsigned char* y;
    __device__ __forceinline__ void operator()(const f32x4 (&acc)[2][2][4][2], const pg8::Unit& u, int wr, int wc, int fr, int fq) const {
        const int pnl = u.pn & 7; constexpr float sc = SC_Y / (SC_HID * SC_WD);
#pragma unroll
        for (int ai = 0; ai < 2; ++ai)
#pragma unroll
            for (int m = 0; m < 4; ++m) { unsigned char* rowp = y + (size_t)(u.pm * 256 + ai * 128 + wr * 64 + m * 16 + fr) * DM + pnl * 256 + wc * 32 + 8 * fq;
#pragma unroll
                for (int bj = 0; bj < 2; ++bj) { const f32x4 v0 = acc[ai][bj][m][0] * sc, v1 = acc[ai][bj][m][1] * sc;
                    u32x2 w; w.x = cvt_pk4_fp8(v0[0], v0[1], v0[2], v0[3]); w.y = cvt_pk4_fp8(v1[0], v1[1], v1[2], v1[3]);
                    *(u32x2*)(rowp + bj * 128) = w; } }
    }
};

__device__ __forceinline__ void tr_load(const float* src, int ldw, LAS float* scr, int lane) {
    f32x4 v[8]; const int kr = lane >> 3, n4 = 4 * (lane & 7);
#pragma unroll
    for (int i = 0; i < 8; ++i) v[i] = *(const f32x4*)(src + (size_t)(kr + 8 * i) * ldw + n4);
#pragma unroll
    for (int i = 0; i < 8; ++i) { LAS float* d = scr + (kr + 8 * i) * 33 + n4; d[0] = v[i][0]; d[1] = v[i][1]; d[2] = v[i][2]; d[3] = v[i][3]; }
}
__device__ __forceinline__ void tr_item(const float* src, int ldw, const float* gs, bf16* dst, int ldd, LAS float* scr, int lane) {
    tr_load(src, ldw, scr, lane);
    const int c = lane & 7;
    f32x4 g0 = (f32x4){1.f, 1.f, 1.f, 1.f}, g1 = g0;
    if (gs) { g0 = *(const f32x4*)(gs + 8 * c); g1 = *(const f32x4*)(gs + 8 * c + 4); }
    LDS_WAIT(); asm volatile("" ::: "memory");
#pragma unroll
    for (int j = 0; j < 4; ++j) { const int n = (lane >> 3) + 8 * j; const LAS float* s = scr + (8 * c) * 33 + n;
        u32x4 o; o.x = cvt_pk_bf16(s[0 * 33] * g0[0], s[1 * 33] * g0[1]); o.y = cvt_pk_bf16(s[2 * 33] * g0[2], s[3 * 33] * g0[3]);
        o.z = cvt_pk_bf16(s[4 * 33] * g1[0], s[5 * 33] * g1[1]); o.w = cvt_pk_bf16(s[6 * 33] * g1[2], s[7 * 33] * g1[3]);
        *(u32x4*)(dst + (size_t)n * ldd + 8 * c) = o; }
    LDS_WAIT(); asm volatile("" ::: "memory");
}
__device__ __forceinline__ void tr_item_q(const float* src, int ldw, const float* gs, float scale, unsigned char* dst, int ldd, LAS float* scr, int lane) {
    tr_load(src, ldw, scr, lane);
    const int c = lane & 7;
    f32x4 g0 = (f32x4){scale, scale, scale, scale}, g1 = g0;
    if (gs) { g0 = *(const f32x4*)(gs + 8 * c) * scale; g1 = *(const f32x4*)(gs + 8 * c + 4) * scale; }
    LDS_WAIT(); asm volatile("" ::: "memory");
#pragma unroll
    for (int j = 0; j < 4; ++j) { const int n = (lane >> 3) + 8 * j; const LAS float* s = scr + (8 * c) * 33 + n;
        u32x2 o; o.x = cvt_pk4_fp8(s[0 * 33] * g0[0], s[1 * 33] * g0[1], s[2 * 33] * g0[2], s[3 * 33] * g0[3]);
        o.y = cvt_pk4_fp8(s[4 * 33] * g1[0], s[5 * 33] * g1[1], s[6 * 33] * g1[2], s[7 * 33] * g1[3]);
        *(u32x2*)(dst + (size_t)n * ldd + 8 * c) = o; }
    LDS_WAIT(); asm volatile("" ::: "memory");
}
__device__ __forceinline__ void p0_prologue(Frame& F) {
    const float* x = INP(0); const float* g_attn = INP(1); const float* w_in = INP(2); const float* b_forget = INP(3);
    const float* g_fox = INP(4); const float* g_moba = INP(5); const float* w_out = INP(7); const float* g_ffn = INP(8);
    const float* w_gr = INP(9); const float* w_er = INP(11); const float* w_gate = INP(13); const float* w_up = INP(14); const float* w_down = INP(15);
    bf16* Wqkv = (bf16*)(F.ws + WS_WQKV); unsigned char* Wq8 = F.ws + WS_WQ8; bf16* Wo = (bf16*)(F.ws + WS_WO); unsigned char* Hq = F.ws + WS_HQ; unsigned char* Wgu = F.ws + WS_WGU; unsigned char* Wd = F.ws + WS_WD; bf16* Wr = (bf16*)(F.ws + WS_WR);
    bf16* Hb = (bf16*)(F.ws + WS_A); float* lf = (float*)(F.ws + WS_LF);
    LAS float* scr = (LAS float*)(F.lds + RING_OFF + F.wave * 8704);
    LAS float* wfgT = (LAS float*)(F.lds + RING_OFF + 8 * 8704);
    const int gw = F.bx * NWAVES + F.wave, NGW = F.G * NWAVES;
    for (int idx = F.tid; idx < 2048 * 8; idx += NTHR) { const int k = idx >> 3, hh = idx & 7; wfgT[hh * 2048 + k] = w_in[(size_t)k * WIN_LD + NQKV + hh] * g_attn[k]; }
    constexpr int I_IN = 32 * 192, I_O = 32 * 64, I_G = 16 * 32 * 16, I_D = 16 * 8 * 64, NITEMS = I_IN + I_O + 2 * I_G + I_D;
    for (int it = gw; it < NITEMS; it += NGW) {
        int r = it;
        if (r < I_IN) { const int kb = r / 192, nb = r % 192; const int w = nb >> 5, lrow = grp_nth_rank(w) * 1024 + 32 * (nb & 31); const float* src = w_in + (size_t)(64 * kb) * WIN_LD + 32 * nb;
            if ((QMASK >> w) & 1) tr_item_q(src, WIN_LD, g_attn + 64 * kb, SC_WIN, Wq8 + (size_t)lrow * DM + 64 * kb, DM, scr, F.lane);
            else tr_item(src, WIN_LD, g_attn + 64 * kb, Wqkv + (size_t)lrow * DM + 64 * kb, DM, scr, F.lane);
            continue; } r -= I_IN;
        if (r < I_O) { const int kb = r / 64, nb = r % 64; const int k0 = 64 * kb; const float* gs = (k0 < GWID) ? g_fox + k0 : g_moba + (k0 - GWID);
            if (WO_FP8) tr_item_q(w_out + (size_t)k0 * DM + 32 * nb, DM, gs, SC_WO, (unsigned char*)Wo + (size_t)(32 * nb) * DM + k0, DM, scr, F.lane);
            else tr_item(w_out + (size_t)k0 * DM + 32 * nb, DM, gs, Wo + (size_t)(32 * nb) * DM + k0, DM, scr, F.lane);
            continue; } r -= I_O;
        if (r < 2 * I_G) { const int up = r >= I_G; if (up) r -= I_G; const int e = r / 512, rr = r % 512, kb = rr / 16, nb = rr % 16; const int f0 = 32 * nb, tt = f0 >> 7, within = f0 & 127;
            const float* W = (up ? w_up : w_gate) + (size_t)e * DM * DE;
            tr_item_q(W + (size_t)(64 * kb) * DE + f0, DE, g_ffn + 64 * kb, SC_WGU, Wgu + ((size_t)e * 1024 + tt * 256 + up * 128 + within) * DM + 64 * kb, DM, scr, F.lane); continue; } r -= 2 * I_G;
        { const int e = r / 512, rr = r % 512, kb = rr / 64, nb = rr % 64;
            tr_item_q(w_down + (size_t)e * DE * DM + (size_t)(64 * kb) * DM + 32 * nb, DM, nullptr, SC_WD, Wd + ((size_t)e * DM + 32 * nb) * DE + 64 * kb, DE, scr, F.lane); }
    }
    for (int idx = (F.bx * NTHR + F.tid); idx < NRC * DM; idx += F.G * NTHR) { const int n = idx >> 11, k = idx & 2047;
        float v = 0.f; if (n < 4) v = w_gr[k * 4 + n]; else if (n < 20) v = w_er[k * 16 + (n - 4)];
        Wr[idx] = (bf16)(cvt_pk_bf16(v * g_ffn[k], 0.f) & 0xffffu); }
    __syncthreads();
    f32x4 vn[8];
    if (gw < T) { const f32x4* xr0 = (const f32x4*)(x + (size_t)gw * DM) + F.lane;
#pragma unroll
        for (int j = 0; j < 8; ++j) vn[j] = xr0[64 * j]; }
    for (int m = gw; m < T; m += NGW) {
        f32x4 v[8]; float ss = 0.f;
#pragma unroll
        for (int j = 0; j < 8; ++j) v[j] = vn[j];
        { const int mn = (m + NGW < T) ? m + NGW : m; const f32x4* xrn = (const f32x4*)(x + (size_t)mn * DM) + F.lane;
#pragma unroll
          for (int j = 0; j < 8; ++j) vn[j] = xrn[64 * j]; }
#pragma unroll
        for (int j = 0; j < 8; ++j) ss += (v[j][0] * v[j][0] + v[j][1] * v[j][1]) + (v[j][2] * v[j][2] + v[j][3] * v[j][3]);
        float fl[8];
#pragma unroll
        for (int hh = 0; hh < 8; ++hh) { float a = 0.f;
#pragma unroll
            for (int j = 0; j < 8; ++j) { const f32x4 w = *(const LAS f32x4*)(wfgT + hh * 2048 + 256 * j + 4 * F.lane); a += (v[j][0] * w[0] + v[j][1] * w[1]) + (v[j][2] * w[2] + v[j][3] * w[3]); }
            fl[hh] = a; }
        ss = wave_sum(ss); const float rstd = 1.0f / sqrtf(ss * (1.0f / DM) + EPS);
#pragma unroll
        for (int hh = 0; hh < 8; ++hh) fl[hh] = wave_sum(fl[hh]) * rstd;
        u32x2* o8 = (u32x2*)(Hb + (size_t)m * DM) + F.lane;
#pragma unroll
        for (int j = 0; j < 8; ++j) { u32x2 w; w.x = cvt_pk_bf16(v[j][0] * rstd, v[j][1] * rstd); w.y = cvt_pk_bf16(v[j][2] * rstd, v[j][3] * rstd); o8[64 * j] = w;
            if (NQ8 > 0) ((unsigned*)(Hq + (size_t)m * DM))[64 * j + F.lane] = cvt_pk4_fp8(v[j][0] * rstd, v[j][1] * rstd, v[j][2] * rstd, v[j][3] * rstd); }
        if (F.lane < 8) { float z = fl[0];
#pragma unroll
            for (int hh = 1; hh < 8; ++hh) z = (F.lane == hh) ? fl[hh] : z;
            z += b_forget[F.lane];
            const float ls = fminf(z, 0.f) - log1pf(expf(-fabsf(z)));
            const int b = m >> 12, s = m & 4095; lf[(size_t)(b * 8 + F.lane) * SEQ + s] = ls; }
    }
}

__device__ __forceinline__ void p2_kmean_cumsum(Frame& F) {
    const bf16* mk = (const bf16*)(F.ws + WS_QKV) + (size_t)4 * 32 * SEQ * HD;
    bf16* kmean = (bf16*)(F.ws + WS_KMEAN);
    LAS float* part = (LAS float*)(F.lds + RING_OFF);
    for (int item = F.bx; item < 512; item += F.G) {
        const bf16* base = mk + ((size_t)item * 256 + F.wave * 32) * HD + 2 * F.lane;
        float a0 = 0.f, a1 = 0.f;
#pragma unroll 8
        for (int r = 0; r < 32; ++r) { const unsigned w = *(const unsigned*)(base + (size_t)r * HD); a0 += bflo(w); a1 += bfhi(w); }
        part[F.wave * 128 + 2 * F.lane] = a0; part[F.wave * 128 + 2 * F.lane + 1] = a1;
        __syncthreads();
        if (F.tid < 128) { float s = 0.f;
#pragma unroll
            for (int w = 0; w < 8; ++w) s += part[w * 128 + F.tid];
            kmean[(size_t)item * 128 + F.tid] = (bf16)(cvt_pk_bf16(s * (1.0f / 256.0f), 0.f) & 0xffffu); }
        __syncthreads();
    }
    if (F.bx < 32 && F.wave == 0) {
        const float* src = (const float*)(F.ws + WS_LF) + (size_t)F.bx * SEQ + 64 * F.lane; float* dst = (float*)(F.ws + WS_C) + (size_t)F.bx * SEQ + 64 * F.lane;
        f32x4 v[16]; float run = 0.f;
#pragma unroll
        for (int j = 0; j < 16; ++j) { v[j] = *(const f32x4*)(src + 4 * j);
            v[j][0] += run; v[j][1] += v[j][0]; v[j][2] += v[j][1]; v[j][3] += v[j][2]; run = v[j][3]; }
        float incl = run;
#pragma unroll
        for (int o = 1; o < 64; o <<= 1) { const float t = __shfl_up(incl, o); if (F.lane >= o) incl += t; }
        const float excl = incl - run;
#pragma unroll
        for (int j = 0; j < 16; ++j) { f32x4 w = v[j]; w[0] += excl; w[1] += excl; w[2] += excl; w[3] += excl; *(f32x4*)(dst + 4 * j) = w; }
    }
}

__device__ __forceinline__ void p4_outnorm(Frame& F) {
    bf16* AO = (bf16*)(F.ws + WS_A);
    const int gw = F.bx * NWAVES + F.wave, NGW = F.G * NWAVES;
    for (int m = gw; m < T; m += NGW) {
        u32x4* rp = (u32x4*)(AO + (size_t)m * DM) + F.lane;
        u32x4 v[4]; float ss[2] = {0.f, 0.f};
#pragma unroll
        for (int j = 0; j < 4; ++j) { v[j] = rp[64 * j];
#pragma unroll
            for (int q = 0; q < 4; ++q) { const float a = bflo(v[j][q]), b = bfhi(v[j][q]); ss[j >> 1] += a * a + b * b; } }
        const float r0 = 1.0f / sqrtf(wave_sum(ss[0]) * (1.0f / GWID) + EPS), r1 = 1.0f / sqrtf(wave_sum(ss[1]) * (1.0f / GWID) + EPS);
#pragma unroll
        for (int j = 0; j < 4; ++j) { const float r = (j < 2) ? r0 : r1; u32x4 o;
#pragma unroll
            for (int q = 0; q < 4; ++q) o[q] = cvt_pk_bf16(bflo(v[j][q]) * r, bfhi(v[j][q]) * r);
            rp[64 * j] = o; }
    }
}

__device__ __forceinline__ void p6_route(Frame& F) {
    const bf16* xb = (const bf16*)(F.ws + WS_XB); const bf16* Wr = (const bf16*)(F.ws + WS_WR);
    const float* bg = INP(10); const float* be = INP(12);
    int* tokrec = (int*)(F.ws + WS_TOKREC); int* list = (int*)(F.ws + WS_LIST); float* rsr = (float*)(F.ws + WS_RSR); float* rsw = (float*)(F.ws + WS_RSW);
    unsigned* gcnt = F.ctl + CW_GCNT;
    LAS float* part = (LAS float*)(F.lds + RING_OFF);
    LAS float* ssq = part + 2 * 64 * 32;
    LAS int* lcnt = (LAS int*)(ssq + 128);
    LAS int* lbase = lcnt + 16;
    const int fr = F.lane & 15, fq = F.lane >> 4, mt = F.wave & 3, kh = F.wave >> 2;
    for (int blk = F.bx; blk < T / 64; blk += F.G) {
        const int tok0 = blk * 64;
        if (F.tid < 16) lcnt[F.tid] = 0;
        const bf16* pa = xb + (size_t)(tok0 + 16 * mt + fr) * DM + 1024 * kh + 8 * fq;
        const bf16* pb0 = Wr + (size_t)fr * DM + 1024 * kh + 8 * fq; const bf16* pb1 = pb0 + (size_t)16 * DM;
        f32x4 acc0 = (f32x4){0.f, 0.f, 0.f, 0.f}, acc1 = acc0; float sq = 0.f;
#pragma unroll 4
        for (int s = 0; s < 32; ++s) { const bf16x8 a = *(const bf16x8*)(pa + 32 * s), b0 = *(const bf16x8*)(pb0 + 32 * s), b1 = *(const bf16x8*)(pb1 + 32 * s);
#pragma unroll
            for (int j = 0; j < 8; ++j) { const float f = bf2f((unsigned short)a[j]); sq += f * f; }
            acc0 = __builtin_amdgcn_mfma_f32_16x16x32_bf16(a, b0, acc0, 0, 0, 0); acc1 = __builtin_amdgcn_mfma_f32_16x16x32_bf16(a, b1, acc1, 0, 0, 0); }
        sq += __shfl_xor(sq, 16); sq += __shfl_xor(sq, 32);
#pragma unroll
        for (int i = 0; i < 4; ++i) { part[(kh * 64 + 16 * mt + 4 * fq + i) * 32 + fr] = acc0[i]; part[(kh * 64 + 16 * mt + 4 * fq + i) * 32 + 16 + fr] = acc1[i]; }
        if (fq == 0) ssq[kh * 64 + 16 * mt + fr] = sq;
        __syncthreads();
        int e1 = 0, e2 = 0, rk1 = 0, rk2 = 0; float w1 = 0.f, w2 = 0.f, rstd = 0.f;
        if (F.tid < 64) { const int t = F.tid;
            rstd = 1.0f / sqrtf((ssq[t] + ssq[64 + t]) * (1.0f / DM) + EPS);
            float gl[4]; int grp = 0;
#pragma unroll
            for (int j = 0; j < 4; ++j) gl[j] = (part[t * 32 + j] + part[(64 + t) * 32 + j]) * rstd + bg[j];
#pragma unroll
            for (int j = 1; j < 4; ++j) if (gl[j] > gl[grp]) grp = j;
            float gmax = gl[0];
#pragma unroll
            for (int j = 1; j < 4; ++j) gmax = fmaxf(gmax, gl[j]);
            float gden = 0.f;
#pragma unroll
            for (int j = 0; j < 4; ++j) gden += expf(gl[j] - gmax);
            const float pgrp = 1.0f / gden;
            float el[4];
#pragma unroll
            for (int j = 0; j < 4; ++j) el[j] = (part[t * 32 + 4 + 4 * grp + j] + part[(64 + t) * 32 + 4 + 4 * grp + j]) * rstd + be[4 * grp + j];
            int i1 = 0;
#pragma unroll
            for (int j = 1; j < 4; ++j) if (el[j] > el[i1]) i1 = j;
            int i2 = (i1 == 0) ? 1 : 0;
#pragma unroll
            for (int j = 0; j < 4; ++j) if (j != i1 && j != i2 && el[j] > el[i2]) i2 = j;
            const float p2 = expf(el[i2] - el[i1]);
            w1 = pgrp / (1.0f + p2); w2 = pgrp * p2 / (1.0f + p2);
            e1 = 4 * grp + i1; e2 = 4 * grp + i2;
            rk1 = __hip_atomic_fetch_add(&lcnt[e1], 1, __ATOMIC_RELAXED, __HIP_MEMORY_SCOPE_WORKGROUP); rk2 = __hip_atomic_fetch_add(&lcnt[e2], 1, __ATOMIC_RELAXED, __HIP_MEMORY_SCOPE_WORKGROUP);
        }
        __syncthreads();
        if (F.tid < 16) lbase[F.tid] = (int)__hip_atomic_fetch_add(gcnt + F.tid, (unsigned)lcnt[F.tid], __ATOMIC_RELAXED, __HIP_MEMORY_SCOPE_AGENT);
        __syncthreads();
        if (F.tid < 64) { const int tok = tok0 + F.tid; const int p1 = lbase[e1] + rk1, p2 = lbase[e2] + rk2;
            list[e1 * ECAP + p1] = tok; rsr[e1 * ECAP + p1] = rstd; rsw[e1 * ECAP + p1] = w1;
            list[e2 * ECAP + p2] = tok; rsr[e2 * ECAP + p2] = rstd; rsw[e2 * ECAP + p2] = w2;
            int4 rec; rec.x = e1; rec.y = p1; rec.z = e2; rec.w = p2; *(int4*)(tokrec + 4 * tok) = rec; }
        __syncthreads();
    }
}
__device__ __forceinline__ void moe_table(Frame& F) {
    LAS int* tt = (LAS int*)(F.lds + XTRA_OFF);
    if (F.tid < NE) { int c = (int)F.ctl[CW_GCNT + F.tid]; if (c > ECAP) c = ECAP; if (c < 0) c = 0; tt[256 + F.tid] = c; }
    __syncthreads();
    if (F.tid == 0) { int t = 0;
        for (int e = 0; e < NE; ++e) { const int c = tt[256 + e]; tt[288 + e] = t; const int n = (c + 255) >> 8;
            for (int rb = 0; rb < n && t < MAXTILES; ++rb) tt[16 + t++] = e | (rb << 8); }
        tt[0] = t; }
    __syncthreads();
}

__device__ __forceinline__ void p9_final(Frame& F) {
    const LAS int* tt = (const LAS int*)(F.lds + XTRA_OFF);
    const int* tokrec = (const int*)(F.ws + WS_TOKREC); const unsigned char* Y = F.ws + WS_Y; const bf16* XB = (const bf16*)(F.ws + WS_XB); const float* gfin = INP(16);
    const int gw = F.bx * NWAVES + F.wave, NGW = F.G * NWAVES;
    f32x4 g[8];
#pragma unroll
    for (int j = 0; j < 8; ++j) g[j] = *((const f32x4*)gfin + 64 * j + F.lane);
#define P9_ROWS(rec, m_, X, A, B) do { const int e1 = __builtin_amdgcn_readfirstlane((rec).x), p1 = __builtin_amdgcn_readfirstlane((rec).y), e2 = __builtin_amdgcn_readfirstlane((rec).z), p2 = __builtin_amdgcn_readfirstlane((rec).w); \
        const size_t r1 = (size_t)tt[288 + (e1 & 15)] * 256 + p1, r2 = (size_t)tt[288 + (e2 & 15)] * 256 + p2; \
        const u32x2* x1 = (const u32x2*)(XB + (size_t)(m_) * DM) + F.lane; const unsigned* y1 = (const unsigned*)(Y + r1 * DM) + F.lane; const unsigned* y2 = (const unsigned*)(Y + r2 * DM) + F.lane; \
        _Pragma("unroll") for (int j = 0; j < 8; ++j) { X[j] = x1[64 * j]; A[j] = (int)y1[64 * j]; B[j] = (int)y2[64 * j]; } } while (0)
    if (gw >= T) return;
    int4 rec1 = *(const int4*)(tokrec + 4 * gw);
    int4 rec2 = *(const int4*)(tokrec + 4 * ((gw + NGW < T) ? gw + NGW : gw));
    u32x2 X0[8]; int A0[8], B0[8];
    P9_ROWS(rec1, gw, X0, A0, B0);
    for (int m = gw; m < T; m += NGW) {
        const int mn = (m + NGW < T) ? m + NGW : m, mnn = (m + 2 * NGW < T) ? m + 2 * NGW : mn;
        const int4 recN = rec2; rec2 = *(const int4*)(tokrec + 4 * mnn);
        u32x2 X1[8]; int A1[8], B1[8];
        P9_ROWS(recN, mn, X1, A1, B1);
        f32x4 v[8]; float ss = 0.f; constexpr float is = 1.0f / SC_Y;
#pragma unroll
        for (int j = 0; j < 8; ++j) { const u32x2 c = X0[j]; const int a = A0[j], b = B0[j];
            v[j][0] = bflo(c.x) + (__builtin_amdgcn_cvt_f32_fp8(a, 0) + __builtin_amdgcn_cvt_f32_fp8(b, 0)) * is; v[j][1] = bfhi(c.x) + (__builtin_amdgcn_cvt_f32_fp8(a, 1) + __builtin_amdgcn_cvt_f32_fp8(b, 1)) * is;
            v[j][2] = bflo(c.y) + (__builtin_amdgcn_cvt_f32_fp8(a, 2) + __builtin_amdgcn_cvt_f32_fp8(b, 2)) * is; v[j][3] = bfhi(c.y) + (__builtin_amdgcn_cvt_f32_fp8(a, 3) + __builtin_amdgcn_cvt_f32_fp8(b, 3)) * is;
            ss += (v[j][0] * v[j][0] + v[j][1] * v[j][1]) + (v[j][2] * v[j][2] + v[j][3] * v[j][3]); }
        const float rstd = 1.0f / sqrtf(wave_sum(ss) * (1.0f / DM) + EPS);
        f32x4* xr = (f32x4*)(F.ka->out + (size_t)m * DM) + F.lane;
#pragma unroll
        for (int j = 0; j < 8; ++j) { f32x4 o; o[0] = v[j][0] * rstd * g[j][0]; o[1] = v[j][1] * rstd * g[j][1]; o[2] = v[j][2] * rstd * g[j][2]; o[3] = v[j][3] * rstd * g[j][3]; xr[64 * j] = o; }
#pragma unroll
        for (int j = 0; j < 8; ++j) { X0[j] = X1[j]; A0[j] = A1[j]; B0[j] = B1[j]; }
    }
#undef P9_ROWS
}

constexpr int NPHASE = 10;
#ifndef REPMASK
#define REPMASK 0
#endif
#define NREP(k) (1 + ((REPMASK >> (k)) & 1))
__global__ void __launch_bounds__(NTHR, 2) fwd(Args args) {
    extern __shared__ __attribute__((aligned(16))) unsigned char lds_raw[];
    Frame F;
    F.lds = (LAS unsigned char*)lds_raw; F.ws = args.ws; F.ctl = (unsigned*)(args.ws + WS_CTL);
    F.G = gridDim.x; F.bx = blockIdx.x; phase_begin(F);
    for (int u = F.tid; u < 256; u += NTHR) ((LAS unsigned*)(F.lds + LCTL_OFF))[u] = 0u;
    __syncthreads();
    const int lo = args.ph_lo, hi = args.ph_hi;
    const bool multi = (hi - lo) > 1;
    XcdBarrier bar; bar.bar = F.ctl + CW_BAR; bar.x = 0; bar.st = (volatile LAS unsigned*)(F.lds + LCTL_OFF);
    if (multi) bar = xcd_barrier_post(F.ctl + CW_BAR, (volatile LAS unsigned*)(F.lds + LCTL_OFF));
#define IN(k) (lo <= (k) && (k) < hi)
#define SEAM(k) do { if (IN(k) && IN((k) + 1 + ((k) == 3))) xcd_barrier(bar); } while (0)

    if (IN(0)) _Pragma("nounroll") for (int rep_ = 0; rep_ < NREP(0); ++rep_) { if (rep_) xcd_barrier(bar); phase_begin(F); p0_prologue(F); } SEAM(0);
    if (IN(1)) _Pragma("nounroll") for (int rep_ = 0; rep_ < NREP(1); ++rep_) { if (rep_) xcd_barrier(bar); phase_begin(F);
        if (NQ16 > 0) { pg8::Gemm g{(const bf16*)(F.ws + WS_A), (const bf16*)(F.ws + WS_WQKV), T, NQ16 * 1024, DM}; pg8::StaticOrder S; S.init(T, NQ16 * 1024, F.G, F.bx);
            EpiQKV<false> E{(bf16*)(F.ws + WS_QKV)};
            pg8::gemm_phase<EpiQKV<false>, pg8::StaticOrder, true, false, false>(F.lds + RING_OFF, g, S, E); }
        if (NQ8 > 0) { pg8::Gemm g{(const bf16*)(F.ws + WS_HQ), (const bf16*)(F.ws + WS_WQ8), T, NQ8 * 1024, DM}; pg8::StaticOrder S; S.init(T, NQ8 * 1024, F.G, F.bx);
            EpiQKV<true> E{(bf16*)(F.ws + WS_QKV)};
            pg8::gemm_phase<EpiQKV<true>, pg8::StaticOrder, true, false, true>(F.lds + RING_OFF, g, S, E); }
    } SEAM(1);
    if (IN(2)) _Pragma("nounroll") for (int rep_ = 0; rep_ < NREP(2); ++rep_) { if (rep_) xcd_barrier(bar); phase_begin(F); p2_kmean_cumsum(F); } SEAM(2);
    if (IN(3)) _Pragma("nounroll") for (int rep_ = 0; rep_ < NREP(3); ++rep_) { if (rep_) xcd_barrier(bar); phase_begin(F);
        static_assert(att::LDS_ATT <= RING_BYTES, "attention LDS");
        const bf16* qkv = (const bf16*)(F.ws + WS_QKV); bf16* AO = (bf16*)(F.ws + WS_A);
        const float* cbuf = (const float*)(F.ws + WS_C); const bf16* kmean = (const bf16*)(F.ws + WS_KMEAN); const float* relb = INP(6); float* SSQ = (float*)(F.ws + WS_SSQ);
#define MKREF(R, grp, bh_, qb_) do { const int _bh = (bh_), _qb = (qb_), _g = (grp); \
            R.Q = qkv + ((size_t)(_g * 3 + 0) * 32 + _bh) * SEQ * HD + (size_t)_qb * 256 * HD; R.K = qkv + ((size_t)(_g * 3 + 1) * 32 + _bh) * SEQ * HD; R.V = qkv + ((size_t)(_g * 3 + 2) * 32 + _bh) * SEQ * HD; \
            R.O = (unsigned char*)AO + (((size_t)(_bh >> 3) * SEQ + _qb * 256) * DM + _g * GWID + (_bh & 7) * HD) * (WO_FP8 ? 1 : 2); R.SS = SSQ + ((size_t)(_bh >> 3) * SEQ + _qb * 256) * 16 + _g * 8 + (_bh & 7); R.P0 = _qb * 256; R.bh = _bh; } while (0)
        const int vcu = (F.G % 8 == 0) ? (F.bx % 8) * (F.G / 8) + F.bx / 8 : F.bx;
        att::Seam S; att::BlockRef cur, nxt;
        if (vcu < 256) { MKREF(cur, 0, vcu >> 3, vcu & 7); att::attn_prime(cur, (char*)lds_raw + RING_OFF, S); }
        for (int L = vcu; L < 256; L += F.G) {
            const int bh = L >> 3, s = L & 7; const bool more = (L + F.G) < 256; const int Ln = more ? L + F.G : L;
#pragma nounroll
            for (int u = 0; u < 2; ++u) {
                MKREF(cur, 0, bh, u ? 15 - s : s); if (u == 0) MKREF(nxt, 0, bh, 15 - s); else MKREF(nxt, 1, bh, s);
#ifndef NO_M0
                att::attn_block<0>(cur, nxt, F.lds + RING_OFF, S, cbuf, kmean, relb);
#endif
            }
#pragma nounroll
            for (int u = 0; u < 2; ++u) {
                MKREF(cur, 1, bh, u ? 15 - s : s); if (u == 0) MKREF(nxt, 1, bh, 15 - s); else if (more) MKREF(nxt, 0, Ln >> 3, Ln & 7); else nxt = cur;
#ifndef NO_M1
                att::attn_block<1>(cur, nxt, F.lds + RING_OFF, S, cbuf, kmean, relb);
#endif
            }
        }
#undef MKREF
    } SEAM(3);
    if (IN(5)) _Pragma("nounroll") for (int rep_ = 0; rep_ < NREP(5); ++rep_) { if (rep_) xcd_barrier(bar); phase_begin(F);
        pg8::Gemm g{(const bf16*)(F.ws + WS_A), (const bf16*)(F.ws + WS_WO), T, DM, DM}; pg8::StaticOrder S; S.init(T, DM, F.G, F.bx);
        EpiRes E; E.x = INP(0); E.xb = (bf16*)(F.ws + WS_XB); E.xq = F.ws + WS_XQ; E.ssqp = (const float*)(F.ws + WS_SSQ); E.tab = (LAS float*)(F.lds + XTRA_OFF); E.par = 1;
        pg8::gemm_phase<EpiRes, pg8::StaticOrder, true, false, WO_FP8 != 0>(F.lds + RING_OFF, g, S, E);
    } SEAM(5);
    if (IN(6)) _Pragma("nounroll") for (int rep_ = 0; rep_ < NREP(6); ++rep_) { if (rep_) xcd_barrier(bar); phase_begin(F); p6_route(F); } SEAM(6);
    if (IN(7)) _Pragma("nounroll") for (int rep_ = 0; rep_ < NREP(7); ++rep_) { if (rep_) xcd_barrier(bar); phase_begin(F);
        moe_table(F);
        const LAS int* tt = (const LAS int*)(F.lds + XTRA_OFF);
        pg8::Gemm g{(const bf16*)(F.ws + WS_XQ), (const bf16*)(F.ws + WS_WGU), MAXTILES * 256, NE * 1024, DM};
        MoeGather S; S.G = F.G; S.c = F.bx; S.ncol = 4; S.tt = tt; S.list = (const int*)(F.ws + WS_LIST);
        EpiHid E{F.ws + WS_A, (const float*)(F.ws + WS_RSR), (const float*)(F.ws + WS_RSW), tt};
        pg8::gemm_phase<EpiHid, MoeGather, true, true, true>(F.lds + RING_OFF, g, S, E);
    } SEAM(7);
    if (IN(8)) _Pragma("nounroll") for (int rep_ = 0; rep_ < NREP(8); ++rep_) { if (rep_) xcd_barrier(bar); phase_begin(F);
        moe_table(F);
        const LAS int* tt = (const LAS int*)(F.lds + XTRA_OFF);
        pg8::Gemm g{(const bf16*)(F.ws + WS_A), (const bf16*)(F.ws + WS_WD), MAXTILES * 256, NE * DM, DE};
        MoePlain S; S.G = F.G; S.c = F.bx; S.ncol = 8; S.tt = tt;
        EpiY E{F.ws + WS_Y};
        pg8::gemm_phase<EpiY, MoePlain, true, false, true>(F.lds + RING_OFF, g, S, E);
    } SEAM(8);
    if (IN(9)) _Pragma("nounroll") for (int rep_ = 0; rep_ < NREP(9); ++rep_) { if (rep_) xcd_barrier(bar); phase_begin(F); moe_table(F); p9_final(F); }
#undef IN
#undef SEAM
}

template <int MODE>
__global__ void __launch_bounds__(256) naive_attn(unsigned char* ws, const float* rel_bias) {
    const bf16* qkv = (const bf16*)(ws + WS_QKV); const float* cbuf = (const float*)(ws + WS_C); const bf16* kmean = (const bf16*)(ws + WS_KMEAN); bf16* AO = (bf16*)(ws + WS_A);
    __shared__ float qs[16][128]; __shared__ float sc[16][256]; __shared__ float gsc[16][16]; __shared__ unsigned selm[16]; __shared__ float lut[132];
    const int t = threadIdx.x, bh = blockIdx.y, b = bh >> 3, h = bh & 7, i0 = blockIdx.x * 16;
    const bf16* Q = qkv + ((size_t)(MODE * 3 + 0) * 32 + bh) * SEQ * HD; const bf16* Kp = qkv + ((size_t)(MODE * 3 + 1) * 32 + bh) * SEQ * HD; const bf16* Vp = qkv + ((size_t)(MODE * 3 + 2) * 32 + bh) * SEQ * HD;
    for (int i = t; i < 16 * 128; i += 256) qs[i >> 7][i & 127] = bf2f(Q[(size_t)(i0 + (i >> 7)) * HD + (i & 127)]);
    const int own = i0 >> 8;
    if (MODE == 1) { for (int d = t; d < 129; d += 256) { int bk; if (d < 16) bk = d; else { bk = 16 + (int)(logf((float)d / 16.0f) / 2.0794415416798357f * 16.0f); if (bk > 31) bk = 31; } lut[d] = rel_bias[h * 32 + bk]; } }
    __syncthreads();
    if (MODE == 1) {
        const int q = t >> 4, n = t & 15; float g = -1e30f;
        if (n < own) { g = 0.f; const bf16* km = kmean + ((size_t)bh * 16 + n) * 128; for (int d = 0; d < 128; ++d) g += qs[q][d] * bf2f(km[d]); }
        gsc[q][n] = g;
        __syncthreads();
        if (t < 16) { unsigned m = 0; const int nsel = own < 3 ? own : 3;
            for (int k = 0; k < nsel; ++k) { int best = -1; float bv = 0.f; for (int n2 = 0; n2 < own; ++n2) if (!((m >> n2) & 1u) && (best < 0 || gsc[t][n2] > bv)) { best = n2; bv = gsc[t][n2]; } if (best >= 0) m |= 1u << best; }
            selm[t] = m; }
        __syncthreads();
    }
    const int q = t >> 4, dg = t & 15;
    float o[8]; for (int c = 0; c < 8; ++c) o[c] = 0.f;
    float mrun = -1e30f, lrun = 0.f;
    const float scale = 0.08838834764831845f;
    const int nch = own + 1;
    for (int ch = 0; ch < nch; ++ch) {
        const int j = ch * 256 + t;
        float kr[128];
        { const u32x4* kp = (const u32x4*)(Kp + (size_t)j * HD);
#pragma unroll
          for (int c = 0; c < 16; ++c) { const u32x4 w = kp[c]; kr[8 * c + 0] = bflo(w.x); kr[8 * c + 1] = bfhi(w.x); kr[8 * c + 2] = bflo(w.y); kr[8 * c + 3] = bfhi(w.y); kr[8 * c + 4] = bflo(w.z); kr[8 * c + 5] = bfhi(w.z); kr[8 * c + 6] = bflo(w.w); kr[8 * c + 7] = bfhi(w.w); } }
        const float cj = (MODE == 0) ? cbuf[(size_t)bh * SEQ + j] : 0.f;
        for (int qq = 0; qq < 16; ++qq) { const int i = i0 + qq; float s = 0.f;
#pragma unroll
            for (int d = 0; d < 128; ++d) s += qs[qq][d] * kr[d];
            s *= scale; bool ok;
            if (MODE == 0) { s += cbuf[(size_t)bh * SEQ + i] - cj; ok = j <= i; }
            else { const int dd = i - j; s += lut[dd < 0 ? 0 : (dd > 128 ? 128 : dd)]; ok = (ch == own) ? (j <= i) : (((selm[qq] >> ch) & 1u) != 0u); }
            sc[qq][t] = ok ? s : -__builtin_inff(); }
        __syncthreads();
        float cm = -__builtin_inff();
        for (int c = 0; c < 16; ++c) cm = fmaxf(cm, sc[q][dg + 16 * c]);
#pragma unroll
        for (int off = 1; off < 16; off <<= 1) cm = fmaxf(cm, __shfl_xor(cm, off));
        const float mnew = fmaxf(mrun, cm), alpha = expf(mrun - mnew);
        float ps = 0.f; float pv[16];
        for (int c = 0; c < 16; ++c) { pv[c] = expf(sc[q][dg + 16 * c] - mnew); ps += pv[c]; }
#pragma unroll
        for (int off = 1; off < 16; off <<= 1) ps += __shfl_xor(ps, off);
        lrun = lrun * alpha + ps; mrun = mnew;
        __syncthreads();
        for (int c = 0; c < 16; ++c) sc[q][dg + 16 * c] = pv[c];
        __syncthreads();
        for (int c = 0; c < 8; ++c) o[c] *= alpha;
        for (int jj = 0; jj < 256; ++jj) { const float p = sc[q][jj]; const u32x4 w = *(const u32x4*)(Vp + (size_t)(ch * 256 + jj) * HD + 8 * dg);
            o[0] += p * bflo(w.x); o[1] += p * bfhi(w.x); o[2] += p * bflo(w.y); o[3] += p * bfhi(w.y); o[4] += p * bflo(w.z); o[5] += p * bfhi(w.z); o[6] += p * bflo(w.w); o[7] += p * bfhi(w.w); }
        __syncthreads();
    }
    const float il = 1.0f / lrun;
    u32x4 w; w.x = cvt_pk_bf16(o[0] * il, o[1] * il); w.y = cvt_pk_bf16(o[2] * il, o[3] * il); w.z = cvt_pk_bf16(o[4] * il, o[5] * il); w.w = cvt_pk_bf16(o[6] * il, o[7] * il);
    *(u32x4*)(AO + (size_t)(b * SEQ + i0 + q) * DM + MODE * GWID + h * HD + 8 * dg) = w;
}

extern "C" void kernel_launch(void* const* d_in, const int* in_sizes, int n_in, void* d_out, int out_size, void* d_ws, size_t ws_size, hipStream_t stream) {
    static int grid = 0;
    if (grid == 0) {
        if (n_in != 17 || out_size != T * DM || ws_size < WS_END) { fprintf(stderr, "kernel_launch: unexpected shapes (n_in %d out %d ws %zu)\n", n_in, out_size, ws_size); grid = -1; return; }
        int dev = 0, cus = 0;
        if (hipGetDevice(&dev) != hipSuccess || hipDeviceGetAttribute(&cus, hipDeviceAttributeMultiprocessorCount, dev) != hipSuccess) { grid = -1; return; }
        if (hipFuncSetAttribute((const void*)fwd, hipFuncAttributeMaxDynamicSharedMemorySize, LDS_BYTES) != hipSuccess) { fprintf(stderr, "kernel_launch: hipFuncSetAttribute failed\n"); grid = -1; return; }
        int per_cu = 0;
        if (hipOccupancyMaxActiveBlocksPerMultiprocessor(&per_cu, (const void*)fwd, NTHR, LDS_BYTES) != hipSuccess || per_cu < 1) fprintf(stderr, "kernel_launch: occupancy query reports %d\n", per_cu);
        (void)hipGetLastError();
        grid = cus > 0 ? cus : 256;
    }
    if (grid < 0) return;
    (void)hipMemsetAsync((char*)d_ws + WS_CTL, 0, CTL_ZERO_BYTES, stream);
    Args a{};
    for (int i = 0; i < 17; ++i) a.in[i] = (const float*)d_in[i];
    a.out = (float*)d_out; a.ws = (unsigned char*)d_ws;
#ifdef MK_PER_PHASE
    for (int ph = 0; ph < NPHASE; ++ph) { a.ph_lo = ph; a.ph_hi = ph + 1; hipLaunchKernelGGL(fwd, dim3(grid), dim3(NTHR), LDS_BYTES, stream, a); }
#else
    a.ph_lo = 0; a.ph_hi = NPHASE;
    hipLaunchKernelGGL(fwd, dim3(grid), dim3(NTHR), LDS_BYTES, stream, a);
#endif
}
```
